# Optimizing an MI355X kernel written in HIP

```python
import math
import jax, jax.numpy as jnp
from jax import lax
import numpy as np

D_MODEL = 1024
BATCH = 2
SEQ = 8192
DEPTH = 2
DEC_BATCH = 32
DEC_SEQ = 1
PAST_LEN = 8192
PAGE_SIZE = 128

D_MIX = D_MODEL
C_CONV = D_MIX // 4
CONV_W = 31
DH = 64
A_WIDTH = D_MIX // 4
H_A = A_WIDTH // DH
MOBA_BLOCK = 256
MOBA_TOPK = 3
Q_CHUNK = 128
NUM_BUCKETS = 32
REL_MAX_DIST = 128
D_INNER = D_MIX // 2
SSM_P = 64
SSM_H = D_INNER // SSM_P
SSM_G = 2
SSM_N = 128
SSM_CONV_W = 4
SSM_CONV_DIM = D_INNER + 2 * SSM_G * SSM_N
SSD_CHUNK = 256
DT_MIN = 0.001
DT_MAX = 0.1
D_FF = 2816

OFF_Q = 2 * C_CONV
OFF_K = OFF_Q + A_WIDTH
OFF_V = OFF_K + A_WIDTH
OFF_Z = OFF_V + A_WIDTH
OFF_XBC = OFF_Z + D_INNER
OFF_DT = OFF_XBC + SSM_CONV_DIM
N_IN = OFF_DT + SSM_H

kernel_name = 'hymba_conformer_moba_ssd_step'


def rmsnorm(x, g, eps=1e-6):
    xf = x.astype(jnp.float32)
    y = xf * lax.rsqrt(jnp.mean(xf * xf, axis=-1, keepdims=True) + eps)
    return (y * g.astype(jnp.float32)).astype(x.dtype)


def layernorm(x, g, b, eps=1e-5):
    xf = x.astype(jnp.float32)
    xc = xf - jnp.mean(xf, axis=-1, keepdims=True)
    var = jnp.mean(xc * xc, axis=-1, keepdims=True)
    return (xc * lax.rsqrt(var + eps) * g.astype(jnp.float32) + b.astype(jnp.float32)).astype(x.dtype)


def swiglu(h, wg, wu, wd):
    return (jax.nn.silu(h @ wg) * (h @ wu)) @ wd


def causal_dwconv(buf, u, w, b):
    width, ch = w.shape
    full = jnp.concatenate([buf.astype(u.dtype), u], axis=1)
    y = lax.conv_general_dilated(full, w[:, None, :].astype(u.dtype), window_strides=(1,),
                                 padding='VALID', dimension_numbers=('NWC', 'WIO', 'NWC'),
                                 feature_group_count=ch)
    return y + b.astype(u.dtype), full[:, full.shape[1] - (width - 1):]


def rel_bucket(dist):
    n = jnp.maximum(dist, 0)
    max_exact = NUM_BUCKETS // 2
    nf = jnp.maximum(n, 1).astype(jnp.float32)
    large = max_exact + (jnp.log(nf / max_exact) / math.log(REL_MAX_DIST / max_exact)
                         * (NUM_BUCKETS - max_exact)).astype(jnp.int32)
    large = jnp.minimum(large, NUM_BUCKETS - 1)
    return jnp.where(n < max_exact, n, large)


def moba_attend(q, qpos, kt, vt, kmean, rel_bias):
    bsz, nq, nh, dh = q.shape
    nblk = kt.shape[2]
    k_sel = min(MOBA_TOPK, nblk)
    cur = qpos // MOBA_BLOCK
    qt = q.transpose(0, 2, 1, 3)
    gate = jnp.einsum('bhqd,bhnd->bhqn', qt.astype(jnp.float32), kmean)
    eligible = jnp.arange(nblk)[None, :] < cur[:, None]
    gate = jnp.where(eligible[None, None], gate, -jnp.inf)
    _, top = lax.top_k(gate, k_sel)
    idx = jnp.concatenate([top, jnp.broadcast_to(cur[None, None, :, None], (bsz, nh, nq, 1))], axis=-1)
    blk_ok = jnp.concatenate([jnp.arange(k_sel)[None, :] < cur[:, None],
                              jnp.ones((nq, 1), dtype=bool)], axis=-1)
    bi = jnp.arange(bsz)[:, None, None, None]
    hi = jnp.arange(nh)[None, :, None, None]
    kg = kt[bi, hi, idx]
    vg = vt[bi, hi, idx]
    kpos = idx[..., None] * MOBA_BLOCK + jnp.arange(MOBA_BLOCK)
    dist = qpos[None, None, :, None, None] - kpos
    mask = blk_ok[None, None, :, :, None] & (dist >= 0)
    bias = rel_bias[rel_bucket(dist), hi[..., None]].astype(jnp.float32)
    logits = jnp.einsum('bhqd,bhqjsd->bhqjs', qt, kg).astype(jnp.float32) * (1.0 / math.sqrt(dh)) + bias
    logits = jnp.where(mask, logits, -jnp.inf)
    p = jax.nn.softmax(logits.reshape(bsz, nh, nq, -1), axis=-1).reshape(logits.shape)
    return jnp.einsum('bhqjs,bhqjsd->bqhd', p.astype(vg.dtype), vg)


def moba_attention(q, pos0, k_all, v_all, rel_bias):
    bsz, t, nh, dh = q.shape
    tk = k_all.shape[1]
    pad = (-tk) % MOBA_BLOCK
    kt = jnp.pad(k_all, ((0, 0), (0, pad), (0, 0), (0, 0))).reshape(bsz, -1, MOBA_BLOCK, nh, dh).transpose(0, 3, 1, 2, 4)
    vt = jnp.pad(v_all, ((0, 0), (0, pad), (0, 0), (0, 0))).reshape(bsz, -1, MOBA_BLOCK, nh, dh).transpose(0, 3, 1, 2, 4)
    kmean = jnp.mean(kt.astype(jnp.float32), axis=3)
    qpos = pos0 + jnp.arange(t, dtype=jnp.int32)
    qc = Q_CHUNK if t % Q_CHUNK == 0 else t
    nqc = t // qc
    if nqc == 1:
        return moba_attend(q, qpos, kt, vt, kmean, rel_bias)
    qs = q.reshape(bsz, nqc, qc, nh, dh).transpose(1, 0, 2, 3, 4)
    ps = qpos.reshape(nqc, qc)
    out = lax.map(lambda a: moba_attend(a[0], a[1], kt, vt, kmean, rel_bias), (qs, ps))
    return out.transpose(1, 0, 2, 3, 4).reshape(bsz, t, nh, dh)


def ssd_scan(x, dt, a, bm, cm, h0):
    bsz, t, nh, hp = x.shape
    rep = nh // bm.shape[2]
    lc = min(SSD_CHUNK, t)
    pad = (-t) % lc
    if pad:
        x = jnp.pad(x, ((0, 0), (0, pad), (0, 0), (0, 0)))
        dt = jnp.pad(dt, ((0, 0), (0, pad), (0, 0)))
        bm = jnp.pad(bm, ((0, 0), (0, pad), (0, 0), (0, 0)))
        cm = jnp.pad(cm, ((0, 0), (0, pad), (0, 0), (0, 0)))
    nc = (t + pad) // lc
    bh = jnp.repeat(bm, rep, axis=2).reshape(bsz, nc, lc, nh, -1)
    ch = jnp.repeat(cm, rep, axis=2).reshape(bsz, nc, lc, nh, -1)
    xdt = (x * dt[..., None].astype(x.dtype)).reshape(bsz, nc, lc, nh, hp)
    acum = jnp.cumsum((dt * a).reshape(bsz, nc, lc, nh), axis=2)
    seg = acum[:, :, :, None, :] - acum[:, :, None, :, :]
    causal = jnp.tril(jnp.ones((lc, lc), dtype=bool))
    decay = jnp.exp(jnp.where(causal[None, None, :, :, None], seg, -jnp.inf))
    scores = jnp.einsum('bclhn,bcshn->bclsh', ch, bh) * decay
    y_intra = jnp.einsum('bclsh,bcshp->bclhp', scores, xdt)
    to_end = jnp.exp(acum[:, :, -1:, :] - acum)
    states = jnp.einsum('bclhn,bclh,bclhp->bchpn', bh, to_end, xdt).astype(jnp.float32)
    chunk_decay = jnp.exp(acum[:, :, -1, :])

    def step(h, inp):
        s, d = inp
        return h * d[:, :, None, None] + s, h

    h_fin, h_in = lax.scan(step, h0.astype(jnp.float32),
                           (states.transpose(1, 0, 2, 3, 4), chunk_decay.transpose(1, 0, 2)))
    h_in = h_in.transpose(1, 0, 2, 3, 4)
    y_inter = jnp.einsum('bclhn,bchpn,bclh->bclhp', ch, h_in, jnp.exp(acum))
    y = (y_intra + y_inter).reshape(bsz, nc * lc, nh, hp)[:, :t]
    return y, h_fin


def layer(x, conv_buf, ssm_conv_buf, ssm_h0, past_k, past_v, rel_bias, lw):
    (ffn1_norm, ffn1_wg, ffn1_wu, ffn1_wd, mix_norm, w_in, w_out, conv_dw_w, conv_dw_b,
     conv_ln_g, conv_ln_b, q_norm_g, k_norm_g, ssm_conv_w, ssm_conv_b, ssm_dt_bias,
     ssm_a_log, ssm_d, ssm_norm_g, ffn2_norm, ffn2_wg, ffn2_wu, ffn2_wd, final_norm) = lw
    x = x + 0.5 * swiglu(rmsnorm(x, ffn1_norm), ffn1_wg, ffn1_wu, ffn1_wd)
    h = rmsnorm(x, mix_norm)
    bsz, t, _ = h.shape
    proj = h @ w_in
    u = proj[..., :C_CONV] * jax.nn.sigmoid(proj[..., C_CONV:OFF_Q])
    c, conv_new = causal_dwconv(conv_buf, u, conv_dw_w, conv_dw_b)
    conv_out = jax.nn.silu(layernorm(c, conv_ln_g, conv_ln_b))
    q = rmsnorm(proj[..., OFF_Q:OFF_K].reshape(bsz, t, H_A, DH), q_norm_g)
    k = rmsnorm(proj[..., OFF_K:OFF_V].reshape(bsz, t, H_A, DH), k_norm_g)
    v = proj[..., OFF_V:OFF_Z].reshape(bsz, t, H_A, DH)
    if past_k is None:
        pos0, k_all, v_all = 0, k, v
    else:
        pos0 = past_k.shape[1]
        k_all = jnp.concatenate([past_k.astype(k.dtype), k], axis=1)
        v_all = jnp.concatenate([past_v.astype(v.dtype), v], axis=1)
    attn_out = moba_attention(q, pos0, k_all, v_all, rel_bias).reshape(bsz, t, A_WIDTH)
    z = proj[..., OFF_Z:OFF_XBC]
    xbc, ssm_conv_new = causal_dwconv(ssm_conv_buf, proj[..., OFF_XBC:OFF_DT], ssm_conv_w, ssm_conv_b)
    xbc = jax.nn.silu(xbc)
    xs = xbc[..., :D_INNER].reshape(bsz, t, SSM_H, SSM_P)
    bm = xbc[..., D_INNER:D_INNER + SSM_G * SSM_N].reshape(bsz, t, SSM_G, SSM_N)
    cm = xbc[..., D_INNER + SSM_G * SSM_N:].reshape(bsz, t, SSM_G, SSM_N)
    dt = jax.nn.softplus(proj[..., OFF_DT:N_IN].astype(jnp.float32) + ssm_dt_bias.astype(jnp.float32))
    a = -jnp.exp(ssm_a_log.astype(jnp.float32))
    y, h_fin = ssd_scan(xs, dt, a, bm, cm, ssm_h0)
    y = (y + ssm_d[:, None] * xs).reshape(bsz, t, D_INNER)
    ssm_out = rmsnorm(y * jax.nn.silu(z), ssm_norm_g)
    mix = jnp.concatenate([conv_out, attn_out.astype(conv_out.dtype), ssm_out.astype(conv_out.dtype)], axis=-1) @ w_out
    x = x + mix.astype(x.dtype)
    x = x + 0.5 * swiglu(rmsnorm(x, ffn2_norm), ffn2_wg, ffn2_wu, ffn2_wd)
    x = rmsnorm(x, final_norm)
    return x, (k, v, conv_new, ssm_conv_new, h_fin)


def setup_inputs(seed: int = 0) -> dict:
    key = jax.random.key(seed)
    ks = iter(jax.random.split(key, 48))
    f32 = jnp.float32

    def nrm(shape, scale):
        return jax.random.normal(next(ks), shape, f32) * scale

    def gain(shape):
        return 1.0 + nrm(shape, 0.02)

    n_pages = PAST_LEN // PAGE_SIZE
    n_pool = (DEC_BATCH * n_pages * 5) // 4
    page_table = jax.random.permutation(next(ks), n_pool)[:DEC_BATCH * n_pages].reshape(DEC_BATCH, n_pages).astype(jnp.int32)
    dt0 = jnp.exp(jax.random.uniform(next(ks), (DEPTH, SSM_H), f32, math.log(DT_MIN), math.log(DT_MAX)))
    dt_bias = dt0 + jnp.log(-jnp.expm1(-dt0))
    a_log = jnp.log(jax.random.uniform(next(ks), (DEPTH, SSM_H), f32, 1.0, 16.0))
    return {
        'x_prompt': nrm((BATCH, SEQ, D_MODEL), 1.0),
        'x_sample': nrm((DEC_BATCH, DEC_SEQ, D_MODEL), 1.0),
        'cache_k': nrm((DEPTH, n_pool, PAGE_SIZE, H_A, DH), 1.0),
        'cache_v': nrm((DEPTH, n_pool, PAGE_SIZE, H_A, DH), 1.0),
        'state_conv': nrm((DEPTH, DEC_BATCH, CONV_W - 1, C_CONV), 0.5),
        'state_ssm_conv': nrm((DEPTH, DEC_BATCH, SSM_CONV_W - 1, SSM_CONV_DIM), 1.0),
        'state_ssm': nrm((DEPTH, DEC_BATCH, SSM_H, SSM_P, SSM_N), 0.5),
        'page_table': page_table,
        'rel_bias': nrm((NUM_BUCKETS, H_A), 0.2),
        'ffn1_norm': gain((DEPTH, D_MODEL)),
        'ffn1_wg': nrm((DEPTH, D_MODEL, D_FF), D_MODEL ** -0.5),
        'ffn1_wu': nrm((DEPTH, D_MODEL, D_FF), D_MODEL ** -0.5),
        'ffn1_wd': nrm((DEPTH, D_FF, D_MODEL), D_FF ** -0.5),
        'mix_norm': gain((DEPTH, D_MODEL)),
        'w_in': nrm((DEPTH, D_MODEL, N_IN), D_MODEL ** -0.5),
        'w_out': nrm((DEPTH, D_MIX, D_MODEL), D_MIX ** -0.5),
        'conv_dw_w': nrm((DEPTH, CONV_W, C_CONV), CONV_W ** -0.5),
        'conv_dw_b': nrm((DEPTH, C_CONV), 0.02),
        'conv_ln_g': gain((DEPTH, C_CONV)),
        'conv_ln_b': nrm((DEPTH, C_CONV), 0.02),
        'q_norm_g': gain((DEPTH, DH)),
        'k_norm_g': gain((DEPTH, DH)),
        'ssm_conv_w': nrm((DEPTH, SSM_CONV_W, SSM_CONV_DIM), SSM_CONV_W ** -0.5),
        'ssm_conv_b': nrm((DEPTH, SSM_CONV_DIM), 0.02),
        'ssm_dt_bias': dt_bias,
        'ssm_a_log': a_log,
        'ssm_d': gain((DEPTH, SSM_H)),
        'ssm_norm_g': gain((DEPTH, D_INNER)),
        'ffn2_norm': gain((DEPTH, D_MODEL)),
        'ffn2_wg': nrm((DEPTH, D_MODEL, D_FF), D_MODEL ** -0.5),
        'ffn2_wu': nrm((DEPTH, D_MODEL, D_FF), D_MODEL ** -0.5),
        'ffn2_wd': nrm((DEPTH, D_FF, D_MODEL), D_FF ** -0.5),
        'final_norm': gain((DEPTH, D_MODEL)),
    }


def reference(x_prompt, x_sample, cache_k, cache_v, state_conv, state_ssm_conv, state_ssm, page_table,
              rel_bias, ffn1_norm, ffn1_wg, ffn1_wu, ffn1_wd, mix_norm, w_in, w_out, conv_dw_w, conv_dw_b,
              conv_ln_g, conv_ln_b, q_norm_g, k_norm_g, ssm_conv_w, ssm_conv_b, ssm_dt_bias, ssm_a_log,
              ssm_d, ssm_norm_g, ffn2_norm, ffn2_wg, ffn2_wu, ffn2_wd, final_norm):
    stacked = (ffn1_norm, ffn1_wg, ffn1_wu, ffn1_wd, mix_norm, w_in, w_out, conv_dw_w, conv_dw_b,
               conv_ln_g, conv_ln_b, q_norm_g, k_norm_g, ssm_conv_w, ssm_conv_b, ssm_dt_bias,
               ssm_a_log, ssm_d, ssm_norm_g, ffn2_norm, ffn2_wg, ffn2_wu, ffn2_wd, final_norm)
    bp = x_prompt.shape[0]
    zc = jnp.zeros((bp, CONV_W - 1, C_CONV), x_prompt.dtype)
    zsc = jnp.zeros((bp, SSM_CONV_W - 1, SSM_CONV_DIM), x_prompt.dtype)
    zh = jnp.zeros((bp, SSM_H, SSM_P, SSM_N), jnp.float32)
    y_p = x_prompt
    st_p = []
    for l in range(DEPTH):
        lw = tuple(w[l] for w in stacked)
        y_p, st = layer(y_p, zc, zsc, zh, None, None, rel_bias, lw)
        st_p.append(st)
    db = x_sample.shape[0]
    past_len = page_table.shape[1] * PAGE_SIZE
    y_s = x_sample
    st_s = []
    for l in range(DEPTH):
        lw = tuple(w[l] for w in stacked)
        past_k = cache_k[l][page_table].reshape(db, past_len, H_A, DH)
        past_v = cache_v[l][page_table].reshape(db, past_len, H_A, DH)
        y_s, st = layer(y_s, state_conv[l], state_ssm_conv[l], state_ssm[l], past_k, past_v, rel_bias, lw)
        st_s.append(st)
    k_p = jnp.stack([s[0] for s in st_p])
    v_p = jnp.stack([s[1] for s in st_p])
    c_p = jnp.stack([s[2] for s in st_p])
    sc_p = jnp.stack([s[3] for s in st_p])
    h_p = jnp.stack([s[4] for s in st_p])
    k_s = jnp.stack([s[0] for s in st_s])
    v_s = jnp.stack([s[1] for s in st_s])
    c_s = jnp.stack([s[2] for s in st_s])
    sc_s = jnp.stack([s[3] for s in st_s])
    h_s = jnp.stack([s[4] for s in st_s])
    return (y_p, y_s, k_p, v_p, c_p, sc_p, h_p, k_s, v_s, c_s, sc_s, h_s)
```

```cpp
#include <hip/hip_runtime.h>
#include <cstdio>
#include <cstdint>
#include <cmath>
namespace pg8 {
#define PG8_LAS __attribute__((address_space(3)))
typedef unsigned short bf16_t;
typedef short bf16x8 __attribute__((ext_vector_type(8)));
typedef float f32x4 __attribute__((ext_vector_type(4)));
typedef unsigned u32x4 __attribute__((ext_vector_type(4)));
constexpr int BM = 256, BK = 64, HALF = 128, HTB = HALF * BK * 2  , STAGE_BYTES = 8 * HTB, NXCD = 8, WGM = 8;

__host__ __device__ __forceinline__ int lds_byte(int r, int c) { const int st = (r >> 4) * 2 + (c >> 5), rr = r & 15, cc = c & 31, ob = rr * 64 + cc * 2; return st * 1024 + (ob ^ (((ob >> 9) & 1) << 5)); }
__host__ __device__ __forceinline__ void stage_rc(int b, int& R, int& C) { const int st = b / 1024, sb = b % 1024, swz = sb ^ (((sb >> 9) & 1) << 5); R = (st >> 1) * 16 + swz / 64; C = (st & 1) * 32 + (swz % 64) / 2; }
__host__ __device__ __forceinline__ int perm32(int rho) { const int n = rho >> 4, i = rho & 15; return 8 * (i >> 2) + 4 * n + (i & 3); }

struct Unit { int pm, pn; };
struct Gemm { const bf16_t* A; const bf16_t* Bt; int M, N, K; };

struct StaticOrder {
    int nM, nN, nwg, G, c;
    __host__ __device__ void init(int M, int N, int G_, int c_) { nM = M / BM; nN = N / BM; nwg = nM * nN; G = G_; c = c_; }
    __host__ __device__ bool next(int i, Unit& u) const {
        const long L = (long)i * G + c; if (L >= nwg) return false;
        int wgid = (int)L; { const int q = nwg / NXCD, r = nwg % NXCD, xcd = wgid % NXCD, off = wgid / NXCD; wgid = (xcd < r ? xcd * (q + 1) : r * (q + 1) + (xcd - r) * q) + off; }
        const int nig = WGM * nN, gid = wgid / nig, fm = gid * WGM, gsz = (nM - fm) < WGM ? (nM - fm) : WGM;
        u.pm = fm + ((wgid % nig) % gsz); u.pn = (wgid % nig) / gsz; return true;
    }
    __device__ __forceinline__ void a_ready(const Unit&) const {}
    __device__ __forceinline__ void done(const Unit&) const {}
};

__device__ __forceinline__ unsigned cvt_pk_bf16(float lo, float hi) { unsigned r; asm volatile("v_cvt_pk_bf16_f32 %0, %1, %2" : "=v"(r) : "v"(lo), "v"(hi)); return r; }
typedef float f32x2 __attribute__((ext_vector_type(2)));
template <class Epi, class Sched, bool ALIGN_EPI = false, bool SP2 = false>
__device__ __forceinline__ void gemm_phase(PG8_LAS unsigned char* lds, const Gemm g, const Sched& S, const Epi& E, int wave_id) {
    unsigned ones_ = ~0u; asm volatile("" : "+s"(ones_)); int tid = wave_id * 64 + (int)__builtin_amdgcn_mbcnt_hi(ones_, __builtin_amdgcn_mbcnt_lo(ones_, 0u)); asm volatile("" : "+v"(tid));
    const int wid = __builtin_amdgcn_readfirstlane(tid >> 6), lane = tid & 63, wr = wid >> 2, wc = wid & 3, fr = lane & 15, fq = lane >> 4;
    const int K = g.K, nt = K / BK;
    unsigned voffA[2], voffB[2];
#pragma unroll
    for (int i = 0; i < 2; ++i) { int R, C; stage_rc(tid * 16 + i * 8192, R, C); const int Rb = Epi::PERM ? ((R & ~31) + perm32(R & 31)) : R;
        voffA[i] = (unsigned)(R * K + C) * 2u; voffB[i] = (unsigned)(Rb * K + C) * 2u; }
    const size_t kstep = (size_t)(BK * 2);
    const size_t hstep = (size_t)HALF * K * 2;
    const size_t tstep = 2 * hstep;
    const unsigned ldsw = (unsigned)wid * 1024u;
    const int aoff = lds_byte(wr * 64 + fr, fq * 8), boff = lds_byte(wc * 32 + fr, fq * 8);
#define PG8_SA(b, h) (((b) * 2 + (h)) * HTB)
#define PG8_SB(b, h) ((4 + (b) * 2 + (h)) * HTB)
#define PG8_STAGE(bufoff, gbase, voff) do { _Pragma("unroll") for (int _i = 0; _i < 2; ++_i) \
        __builtin_amdgcn_global_load_lds((const unsigned*)((const char*)(gbase) + (voff)[_i]), (PG8_LAS unsigned*)(lds + (bufoff) + ldsw + _i * 8192), 16, 0, 0); } while (0)
#define PG8_LDA(dst, b, h) do { _Pragma("unroll") for (int m = 0; m < 4; ++m) _Pragma("unroll") for (int k = 0; k < 2; ++k) dst[m][k] = *(const PG8_LAS bf16x8*)(lds + PG8_SA(b, h) + aoff + m * 2048 + k * 1024); } while (0)
#define PG8_LDB(dst, b, h) do { _Pragma("unroll") for (int n = 0; n < 2; ++n) _Pragma("unroll") for (int k = 0; k < 2; ++k) dst[n][k] = *(const PG8_LAS bf16x8*)(lds + PG8_SB(b, h) + boff + n * 2048 + k * 1024); } while (0)
#define PG8_MMA(ai, bj, At, Bt) do { __builtin_amdgcn_s_setprio(1); _Pragma("unroll") for (int m = 0; m < 4; ++m) _Pragma("unroll") for (int n = 0; n < 2; ++n) _Pragma("unroll") for (int k = 0; k < 2; ++k) \
        acc[ai][bj][m][n] = __builtin_amdgcn_mfma_f32_16x16x32_bf16(Bt[n][k], At[m][k], acc[ai][bj][m][n], 0, 0, 0); __builtin_amdgcn_s_setprio(0); } while (0)
#define PG8_WAIT_V(n) asm volatile("s_waitcnt vmcnt(" #n ")" ::: "memory")
#define PG8_WAIT_L(n) asm volatile("s_waitcnt lgkmcnt(" #n ")" ::: "memory")
#define PG8_BAR __builtin_amdgcn_s_barrier()
#define PG8_SCHED __builtin_amdgcn_sched_barrier(0)
    Unit cur, nxt; int ui = 0;
    if (!S.next(0, cur)) return;
    f32x4 acc[2][2][4][2];
#pragma unroll
    for (int a = 0; a < 2; ++a)
#pragma unroll
        for (int b = 0; b < 2; ++b)
#pragma unroll
            for (int m = 0; m < 4; ++m)
#pragma unroll
                for (int n = 0; n < 2; ++n) acc[a][b][m][n] = (f32x4){0.f, 0.f, 0.f, 0.f};
    bf16x8 At[4][2], B0[2][2], B1[2][2];
    const char* cA = (const char*)g.A + (size_t)cur.pm * tstep; const char* cB = (const char*)g.Bt + (size_t)cur.pn * tstep;
    S.a_ready(cur);
    if constexpr (SP2) {
        PG8_STAGE(PG8_SB(0, 0), cB, voffB); PG8_STAGE(PG8_SB(0, 1), cB + hstep, voffB); PG8_STAGE(PG8_SA(0, 0), cA, voffA); PG8_STAGE(PG8_SA(0, 1), cA + hstep, voffA);
        if (wr == 1) PG8_BAR;
        PG8_WAIT_V(2); PG8_BAR;
        PG8_STAGE(PG8_SB(1, 0), cB + kstep, voffB); PG8_STAGE(PG8_SA(1, 0), cA + kstep, voffA); PG8_STAGE(PG8_SB(1, 1), cB + hstep + kstep, voffB);
        PG8_WAIT_V(6); PG8_BAR;
    } else {
        PG8_STAGE(PG8_SB(0, 0), cB, voffB); PG8_STAGE(PG8_SA(0, 0), cA, voffA); PG8_STAGE(PG8_SB(0, 1), cB + hstep, voffB); PG8_STAGE(PG8_SA(0, 1), cA + hstep, voffA);
        if (wr == 1) PG8_BAR;
        PG8_WAIT_V(4); PG8_BAR;
        PG8_STAGE(PG8_SB(1, 0), cB + kstep, voffB); PG8_STAGE(PG8_SA(1, 0), cA + kstep, voffA); PG8_STAGE(PG8_SB(1, 1), cB + hstep + kstep, voffB);
        PG8_WAIT_V(6); PG8_BAR;
    }
    for (;;) {
        const bool has_next = S.next(ui + 1, nxt);
        const char* nA = has_next ? (const char*)g.A + (size_t)nxt.pm * tstep : cA; const char* nB = has_next ? (const char*)g.Bt + (size_t)nxt.pn * tstep : cB;
        for (int t = 0; t < nt; t += 2) {
            const bool last = (t == nt - 2);
            const char* a1 = cA + (size_t)(t + 1) * kstep;
            const char* a2 = last ? nA : cA + (size_t)(t + 2) * kstep; const char* b2 = last ? nB : cB + (size_t)(t + 2) * kstep;
            const char* a3 = a2 + kstep; const char* b3 = b2 + kstep;
            if (last && has_next) S.a_ready(nxt);
            if constexpr (SP2) {
            PG8_LDB(B0, 0, 0); PG8_LDB(B1, 0, 1); PG8_SCHED; PG8_LDA(At, 0, 0); PG8_STAGE(PG8_SA(1, 1), a1 + hstep, voffA);
            PG8_WAIT_V(8); PG8_WAIT_L(0); PG8_BAR; PG8_MMA(0, 0, At, B0); PG8_MMA(0, 1, At, B1); PG8_BAR; PG8_SCHED;
            PG8_LDA(At, 0, 1); PG8_STAGE(PG8_SB(0, 0), b2, voffB); PG8_STAGE(PG8_SB(0, 1), b2 + hstep, voffB); PG8_STAGE(PG8_SA(0, 0), a2, voffA);
            PG8_WAIT_V(8); PG8_WAIT_L(0); PG8_BAR; PG8_MMA(1, 0, At, B0); PG8_MMA(1, 1, At, B1); PG8_BAR; PG8_SCHED;
            PG8_LDB(B0, 1, 0); PG8_LDB(B1, 1, 1); PG8_SCHED; PG8_LDA(At, 1, 0); PG8_STAGE(PG8_SA(0, 1), a2 + hstep, voffA);
            PG8_WAIT_V(8); PG8_WAIT_L(0); PG8_BAR; PG8_MMA(0, 0, At, B0); PG8_MMA(0, 1, At, B1); PG8_BAR; PG8_SCHED;
            PG8_LDA(At, 1, 1); PG8_STAGE(PG8_SB(1, 0), b3, voffB); PG8_STAGE(PG8_SB(1, 1), b3 + hstep, voffB); PG8_STAGE(PG8_SA(1, 0), a3, voffA);
            PG8_WAIT_V(8); PG8_WAIT_L(0); PG8_BAR; PG8_MMA(1, 0, At, B0); PG8_MMA(1, 1, At, B1); PG8_BAR; PG8_SCHED;
            } else {
            PG8_LDB(B0, 0, 0); PG8_SCHED; PG8_LDA(At, 0, 0); PG8_STAGE(PG8_SA(1, 1), a1 + hstep, voffA);
            PG8_WAIT_L(8); PG8_BAR; PG8_WAIT_L(0); PG8_MMA(0, 0, At, B0); PG8_BAR; PG8_SCHED;
            PG8_LDB(B1, 0, 1); PG8_STAGE(PG8_SB(0, 0), b2, voffB);
            PG8_BAR; PG8_WAIT_L(0); PG8_MMA(0, 1, At, B1); PG8_BAR;
            PG8_LDA(At, 0, 1); PG8_STAGE(PG8_SA(0, 0), a2, voffA);
            PG8_BAR; PG8_WAIT_L(0); PG8_MMA(1, 0, At, B0); PG8_BAR; PG8_SCHED;
            PG8_STAGE(PG8_SB(0, 1), b2 + hstep, voffB);
            PG8_WAIT_V(6); PG8_BAR; PG8_MMA(1, 1, At, B1); PG8_BAR;
            PG8_LDB(B0, 1, 0); PG8_SCHED; PG8_LDA(At, 1, 0); PG8_STAGE(PG8_SA(0, 1), a2 + hstep, voffA);
            PG8_WAIT_L(8); PG8_BAR; PG8_WAIT_L(0); PG8_MMA(0, 0, At, B0); PG8_BAR; PG8_SCHED;
            PG8_LDB(B1, 1, 1); PG8_STAGE(PG8_SB(1, 0), b3, voffB);
            PG8_BAR; PG8_WAIT_L(0); PG8_MMA(0, 1, At, B1); PG8_BAR;
            PG8_LDA(At, 1, 1); PG8_STAGE(PG8_SA(1, 0), a3, voffA);
            PG8_BAR; PG8_WAIT_L(0); PG8_MMA(1, 0, At, B0); PG8_BAR; PG8_SCHED;
            PG8_STAGE(PG8_SB(1, 1), b3 + hstep, voffB);
            PG8_WAIT_V(6); PG8_BAR; PG8_MMA(1, 1, At, B1); PG8_BAR;
            }
        }
        if constexpr (ALIGN_EPI) { if (wr == 0) PG8_BAR; }
        if constexpr (!Epi::AFTER_DRAIN) { E(acc, cur, wr, wc, fr, fq, ui); S.done(cur); }
        if (!has_next) break;
#pragma unroll
        for (int a = 0; a < 2; ++a)
#pragma unroll
            for (int b = 0; b < 2; ++b)
#pragma unroll
                for (int m = 0; m < 4; ++m)
#pragma unroll
                    for (int n = 0; n < 2; ++n) acc[a][b][m][n] = (f32x4){0.f, 0.f, 0.f, 0.f};
        cur = nxt; cA = nA; cB = nB; ++ui;
        if constexpr (ALIGN_EPI) { if (wr == 1) PG8_BAR; }
    }
    PG8_WAIT_V(0);
    if constexpr (!ALIGN_EPI) { if (wr == 0) PG8_BAR; }
    PG8_BAR;
    if constexpr (Epi::AFTER_DRAIN) { E.fused(acc, cur, wr, wc, fr, fq, lds, wid, lane); S.done(cur); }
#undef PG8_SA
#undef PG8_SB
#undef PG8_STAGE
#undef PG8_LDA
#undef PG8_LDB
#undef PG8_MMA
#undef PG8_WAIT_V
#undef PG8_WAIT_L
#undef PG8_BAR
#undef PG8_SCHED
}
}
#define LAS __attribute__((address_space(3)))
#define XB_TMO      128
#define XB_XCNT(j)  (256  + 64 * (j))
#define XB_XSUB(j)  (1280 + 64 * (j))
#define XB_XGEN(j)  (2304 + 64 * (j))
#define XB_TOP      3328
#define XB_TOPGEN   3392
#define XCD_BAR_WORDS 3456
#define XB_SPIN_CAP (1u << 18)

__device__ __forceinline__ unsigned xb_ld(unsigned* p)              { return __hip_atomic_load(p, __ATOMIC_RELAXED, __HIP_MEMORY_SCOPE_AGENT); }
__device__ __forceinline__ unsigned xb_add(unsigned* p, unsigned v) { return __hip_atomic_fetch_add(p, v, __ATOMIC_RELAXED, __HIP_MEMORY_SCOPE_AGENT); }
__device__ __forceinline__ unsigned xb_xcc_id() { return (unsigned)__builtin_amdgcn_s_getreg((3 << 11) | 20) & 0xFu; }
#define XB_SPIN(cond, bar) do { unsigned _sp = 0; while (cond) { __builtin_amdgcn_s_sleep(1); \
    if ((++_sp & 255u) == 0u) { if (xb_ld(&(bar)[XB_TMO])) break; if (_sp > XB_SPIN_CAP) { atomicAdd(&(bar)[XB_TMO], 1u); break; } } } } while (0)

struct XcdBarrier {
    unsigned* bar; unsigned x;
    volatile LAS unsigned* st;
};

__device__ __forceinline__ XcdBarrier xcd_barrier_post(unsigned* bar, volatile LAS unsigned* st) {
    XcdBarrier b; b.bar = bar; b.x = xb_xcc_id(); b.st = st;
    if (threadIdx.x == 0) (void)xb_add(&bar[XB_XCNT(b.x)], 1u);
    return b;
}
__device__ __forceinline__ void xcd_barrier_complete(unsigned* bar, unsigned x, unsigned& nloc, unsigned& nx) {
    const unsigned G = gridDim.x * gridDim.y * gridDim.z;
    unsigned sum, cnt, mine, sp = 0u;
    for (;;) {
        sum = 0u; cnt = 0u; mine = 0u;
#pragma unroll
        for (unsigned j = 0; j < 16; ++j) { const unsigned c = xb_ld(&bar[XB_XCNT(j)]); sum += c; cnt += (c > 0u) ? 1u : 0u; mine = (j == x) ? c : mine; }
        if (sum == G) break;
        __builtin_amdgcn_s_sleep(1);
        if ((++sp & 255u) == 0u) { if (xb_ld(&bar[XB_TMO])) break; if (sp > XB_SPIN_CAP) { atomicAdd(&bar[XB_TMO], 1u); break; } }
    }
    nloc = mine > 0u ? mine : 1u; nx = cnt > 0u ? cnt : 1u;
}

__device__ __forceinline__ void xcd_barrier(const XcdBarrier& b) {
    asm volatile("s_waitcnt vmcnt(0)" ::: "memory");
    __syncthreads();
    if (threadIdx.x == 0) {
        unsigned* bar = b.bar; asm volatile("" : "+s"(bar)); unsigned bx = b.x; asm volatile("" : "+s"(bx));
        __builtin_amdgcn_s_waitcnt(0);
        unsigned nloc = b.st[0], nx = b.st[1];
        if (nloc == 0u) { xcd_barrier_complete(bar, bx, nloc, nx); b.st[0] = nloc; b.st[1] = nx; }
        const unsigned old = xb_add(&bar[XB_XSUB(bx)], 1u);
        const unsigned gen = old / nloc;
        if (old + 1u == (gen + 1u) * nloc) {
            __builtin_amdgcn_fence(__ATOMIC_RELEASE, "agent");
            asm volatile("s_waitcnt vmcnt(0)" ::: "memory");
            const unsigned og = xb_add(&bar[XB_TOP], 1u);
            const unsigned tg = og / nx;
            if (og + 1u == (tg + 1u) * nx) xb_add(&bar[XB_TOPGEN], 1u);
            else XB_SPIN(xb_ld(&bar[XB_TOPGEN]) == tg, bar);
            __builtin_amdgcn_fence(__ATOMIC_ACQUIRE, "agent");
            xb_add(&bar[XB_XGEN(bx)], 1u);
            asm volatile("s_waitcnt vmcnt(0)" ::: "memory");
        } else {
            XB_SPIN(xb_ld(&bar[XB_XGEN(bx)]) == gen, bar);
            __builtin_amdgcn_fence(__ATOMIC_ACQUIRE, "agent");
            asm volatile("s_waitcnt vmcnt(0)" ::: "memory");
        }
    }
    __syncthreads();
}
#undef LAS
#define GAS __attribute__((address_space(1)))
#define LAS __attribute__((address_space(3)))
namespace mk {
typedef unsigned short bf16_t;
typedef short bf16x8 __attribute__((ext_vector_type(8)));
typedef float f32x4 __attribute__((ext_vector_type(4)));
typedef float f32x2 __attribute__((ext_vector_type(2)));
typedef unsigned u32x4 __attribute__((ext_vector_type(4)));
typedef unsigned u32x2 __attribute__((ext_vector_type(2)));

constexpr int D = 1024, MPR = 16384, MS = 32, MT = MPR + MS, MP = 16640  , SEQ = 8192, FF = 2816, NIN = 2824;
constexpr int NWAVES = 8, NTHR = 512;
constexpr int NPAGES = 64, NPOOL = 2560;
constexpr size_t CACHE_L = (size_t)NPOOL * 128 * 256;
constexpr size_t O_YP = 0, O_YS = O_YP + (size_t)MPR * D, O_KP = O_YS + (size_t)MS * D, O_VP = O_KP + (size_t)2 * MPR * 256,
                 O_CP = O_VP + (size_t)2 * MPR * 256, O_SCP = O_CP + 2 * 2 * 30 * 256, O_HP = O_SCP + 2 * 2 * 3 * 1024,
                 O_KS = O_HP + (size_t)2 * 2 * 8 * 64 * 128, O_VS = O_KS + 2 * 32 * 256, O_CS = O_VS + 2 * 32 * 256,
                 O_SCS = O_CS + 2 * 32 * 30 * 256, O_HS = O_SCS + 2 * 32 * 3 * 1024, O_END = O_HS + (size_t)2 * 32 * 8 * 64 * 128;

constexpr size_t al(size_t x) { return (x + 4095) & ~(size_t)4095; }
constexpr size_t WS_CTL = 0, CTL_ZERO_BYTES = 1u << 20;
constexpr size_t WS_WGU = CTL_ZERO_BYTES;
constexpr size_t SZ_WGU = (size_t)5632 * 1024 * 2;
constexpr size_t WS_WD = WS_WGU + 4 * SZ_WGU;
constexpr size_t SZ_WD = (size_t)1024 * 2816 * 2;
constexpr size_t WS_WIN = WS_WD + 4 * SZ_WD;
constexpr size_t SZ_WIN = (size_t)2816 * 1024 * 2;
constexpr size_t WS_WOUT = WS_WIN + 2 * SZ_WIN;
constexpr size_t SZ_WOUT = (size_t)1024 * 1024 * 2;
constexpr size_t WS_WDT = WS_WOUT + 2 * SZ_WOUT;
constexpr size_t WS_WDTB = WS_WDT + 2 * 1024 * 8 * 4;
constexpr size_t WS_BT = WS_WDTB + 2 * 16 * 1024 * 2;
constexpr size_t WS_KMS = al(WS_BT + 4096);
constexpr size_t WS_KMP = WS_KMS + (size_t)2 * 1024 * 256 * 4;
constexpr size_t WS_XA = al(WS_KMP + 64 * 256 * 4);
constexpr size_t WS_XB = WS_XA + (size_t)MP * D * 4;
constexpr size_t WS_SSQ = WS_XB + (size_t)MP * D * 2;
constexpr size_t WS_SSQ3 = WS_SSQ + (size_t)MP * 16 * 4;
constexpr size_t WS_SSQ3G = WS_SSQ3 + (size_t)MP * 16 * 4;
constexpr size_t WS_ACT = WS_SSQ3G + (size_t)MP * 16 * 4;
constexpr size_t WS_U = WS_ACT + (size_t)MP * FF * 2;
constexpr size_t WS_QB = WS_U + (size_t)MP * 256 * 4;
constexpr size_t WS_KB = WS_QB + (size_t)MP * 256 * 2;
constexpr size_t WS_VB = WS_KB + (size_t)MP * 256 * 2;
constexpr size_t WS_ZS = WS_VB + (size_t)MP * 256 * 2;
constexpr size_t WS_XR = WS_ZS + (size_t)MP * 512 * 2;
constexpr size_t WS_XC = WS_XR + (size_t)MP * 1024 * 2;
constexpr size_t WS_DT = WS_XC + (size_t)MP * 1024 * 2;
constexpr size_t WS_ACUM = WS_DT + (size_t)MP * 8 * 4;
constexpr size_t WS_TOT = WS_ACUM + (size_t)MP * 8 * 4;
constexpr size_t WS_CT = WS_TOT + 256 * 8 * 4;
constexpr size_t WS_MIX = WS_CT + 64 * 8 * 4;
constexpr size_t WS_Y = WS_MIX + (size_t)MP * 1024 * 2;
constexpr size_t WS_SEL = WS_Y + (size_t)MP * 512 * 4;
constexpr size_t WS_ST = WS_SEL + (size_t)MP * 4 * 4;
constexpr size_t WS_HIN = WS_ST + (size_t)2 * 32 * 8 * 64 * 128 * 4;
constexpr size_t WS_PART = WS_HIN + (size_t)2 * 32 * 8 * 64 * 128 * 2;
constexpr size_t WS_END = al(WS_PART + (size_t)MPR * 16 * 68 * 4);
static_assert(WS_KB == WS_QB + (size_t)MP * 256 * 2 && WS_VB == WS_KB + (size_t)MP * 256 * 2, "QB | KB | VB consecutive");
constexpr int CW_BAR = 4096;

constexpr int RING_BYTES = 131072;
constexpr int MISC_OFF = RING_BYTES + 16384;
constexpr int LDS_BYTES = MISC_OFF + 256;

struct Args {
    const float* in[33];
    float* out; unsigned char* ws;
    int ph_lo, ph_hi, li, pad;
};

__device__ __forceinline__ float wsum(float v) {
#pragma unroll
    for (int o = 1; o < 64; o <<= 1) v += __shfl_xor(v, o);
    return v;
}
__device__ __forceinline__ unsigned pk2(float lo, float hi) { unsigned r; asm volatile("v_cvt_pk_bf16_f32 %0, %1, %2" : "=v"(r) : "v"(lo), "v"(hi)); return r; }
__device__ __forceinline__ float bflo(unsigned u) { return __uint_as_float(u << 16); }
__device__ __forceinline__ float bfhi(unsigned u) { return __uint_as_float(u & 0xffff0000u); }
__device__ __forceinline__ float bf1(bf16_t h) { return __uint_as_float((unsigned)h << 16); }
__device__ __forceinline__ float fexp(float x) { return __builtin_amdgcn_exp2f(x * 1.4426950408889634f); }
__device__ __forceinline__ float fsigm(float x) { return __builtin_amdgcn_rcpf(1.f + fexp(-x)); }
__device__ __forceinline__ float fsilu(float x) { return x * fsigm(x); }
__device__ __forceinline__ float rstd16(const float* p) {
    const f32x4 a = *(const f32x4*)p, b = *(const f32x4*)(p + 4), c = *(const f32x4*)(p + 8), d = *(const f32x4*)(p + 12);
    const float s = ((a.x + a.y) + (a.z + a.w)) + ((b.x + b.y) + (b.z + b.w)) + ((c.x + c.y) + (c.z + c.w)) + ((d.x + d.y) + (d.z + d.w));
    return rsqrtf(s * (1.f / 1024.f) + 1e-6f);
}
__device__ __forceinline__ float rstd16s(const float* p, float sc) {
    const f32x4 a = *(const f32x4*)p, b = *(const f32x4*)(p + 4), c = *(const f32x4*)(p + 8), d = *(const f32x4*)(p + 12);
    const float s = ((a.x + a.y) + (a.z + a.w)) + ((b.x + b.y) + (b.z + b.w)) + ((c.x + c.y) + (c.z + c.w)) + ((d.x + d.y) + (d.z + d.w));
    return rsqrtf(sc * s * (1.f / 1024.f) + 1e-6f);
}
constexpr int RT_MAXU = 7;
template <class Sched> __device__ __forceinline__ void rstd_table(const Sched& S, const float* SSQ, const float* SSQG, LAS float* tab, int tid) {
    const int rl = tid >> 1, hf = tid & 1;
    f32x4 a[RT_MAXU][2], g[RT_MAXU][2]; bool ok[RT_MAXU];
#pragma unroll
    for (int i = 0; i < RT_MAXU; ++i) { pg8::Unit u; ok[i] = S.next(i, u);
        if (ok[i]) { const size_t o = ((size_t)u.pm * 256 + rl) * 16 + 8 * hf; a[i][0] = *(const f32x4*)(SSQ + o); a[i][1] = *(const f32x4*)(SSQ + o + 4);
            if (SSQG) { g[i][0] = *(const f32x4*)(SSQG + o); g[i][1] = *(const f32x4*)(SSQG + o + 4); } } }
#pragma unroll
    for (int i = 0; i < RT_MAXU; ++i) if (ok[i]) {
        float s = ((a[i][0].x + a[i][0].y) + (a[i][0].z + a[i][0].w)) + ((a[i][1].x + a[i][1].y) + (a[i][1].z + a[i][1].w)); s += __shfl_xor(s, 1);
        float rs = rsqrtf(s * (1.f / 1024.f) + 1e-6f);
        if (SSQG) { float sg = ((g[i][0].x + g[i][0].y) + (g[i][0].z + g[i][0].w)) + ((g[i][1].x + g[i][1].y) + (g[i][1].z + g[i][1].w)); sg += __shfl_xor(sg, 1); rs = rs * rsqrtf(rs * rs * sg * (1.f / 1024.f) + 1e-6f); }
        if (hf == 0) tab[i * 256 + rl] = rs; }
    __syncthreads();
}
struct EpiGU {
    static constexpr bool PERM = true, AFTER_DRAIN = false;
    bf16_t* ACT; const LAS float* rtab;
    __device__ __forceinline__ void operator()(const f32x4 (&acc)[2][2][4][2], const pg8::Unit& u, int wr, int wc, int fr, int fq, int ui) const {
        const int row0 = u.pm * 256 + wr * 64 + fr, col = u.pn * 128 + wc * 32 + 8 * fq;
#pragma unroll
        for (int ai = 0; ai < 2; ++ai)
#pragma unroll
            for (int m = 0; m < 4; ++m) {
                const int row = row0 + ai * 128 + m * 16;
                const float rs = rtab[ui * 256 + (row - u.pm * 256)];
                const float rs2 = rs * rs, cexp = -1.4426950408889634f * rs;
                float a[8];
#pragma unroll
                for (int n = 0; n < 2; ++n)
#pragma unroll
                    for (int j = 0; j < 4; ++j) { const float ag = acc[ai][0][m][n][j], au = acc[ai][1][m][n][j];
                        a[n * 4 + j] = (ag * au) * (rs2 * __builtin_amdgcn_rcpf(1.f + __builtin_amdgcn_exp2f(ag * cexp))); }
                u32x4 w; w.x = pk2(a[0], a[1]); w.y = pk2(a[2], a[3]); w.z = pk2(a[4], a[5]); w.w = pk2(a[6], a[7]);
                *(u32x4*)(ACT + (size_t)row * FF + col) = w;
            }
    }
};
struct EpiRes {
    static constexpr bool PERM = true, AFTER_DRAIN = false;
    const float* xp; const float* xs; bf16_t* XB; float* SSQ; float alpha; const float* nssq; const float* gsc; float* SSQG;
    __device__ __forceinline__ void operator()(const f32x4 (&acc)[2][2][4][2], const pg8::Unit& u, int wr, int wc, int fr, int fq, int ui) const {
        const int rowb = u.pm * 256 + wr * 64, colb = u.pn * 256 + wc * 32 + 8 * fq;
        f32x4 gs[2][2];
#pragma unroll
        for (int bj = 0; bj < 2; ++bj) { gs[bj][0] = gsc ? *(const f32x4*)(gsc + colb + bj * 128) : (f32x4){1.f, 1.f, 1.f, 1.f}; gs[bj][1] = gsc ? *(const f32x4*)(gsc + colb + bj * 128 + 4) : (f32x4){1.f, 1.f, 1.f, 1.f}; }
#pragma unroll
        for (int am = 0; am < 4; ++am) { const int ai = am >> 1, m0 = (am & 1) * 2;
            f32x4 o[2][2][2]; float rn[2];
            if (xp) {
#pragma unroll
                for (int mm = 0; mm < 2; ++mm) { const int row = rowb + ai * 128 + (m0 + mm) * 16 + fr; rn[mm] = 1.f; const float* src = (row < MPR) ? xp + (size_t)row * D : xs + (size_t)(row - MPR) * D;
#pragma unroll
                    for (int bj = 0; bj < 2; ++bj) { o[mm][bj][0] = *(const f32x4*)(src + colb + bj * 128); o[mm][bj][1] = *(const f32x4*)(src + colb + bj * 128 + 4); } }
                asm volatile("" : "+v"(o[0][0][0]), "+v"(o[0][0][1]), "+v"(o[0][1][0]), "+v"(o[0][1][1]), "+v"(o[1][0][0]), "+v"(o[1][0][1]), "+v"(o[1][1][0]), "+v"(o[1][1][1]));
            } else {
                u32x4 wv[2][2];
#pragma unroll
                for (int mm = 0; mm < 2; ++mm) { const int row = rowb + ai * 128 + (m0 + mm) * 16 + fr; rn[mm] = nssq ? rstd16(nssq + (size_t)row * 16) : 1.f;
#pragma unroll
                    for (int bj = 0; bj < 2; ++bj) wv[mm][bj] = *(const u32x4*)(XB + (size_t)row * D + colb + bj * 128); }
                asm volatile("" : "+v"(wv[0][0]), "+v"(wv[0][1]), "+v"(wv[1][0]), "+v"(wv[1][1]), "+v"(rn[0]), "+v"(rn[1]));
#pragma unroll
                for (int mm = 0; mm < 2; ++mm)
#pragma unroll
                    for (int bj = 0; bj < 2; ++bj) { const u32x4 w = wv[mm][bj]; o[mm][bj][0] = (f32x4){bflo(w.x), bfhi(w.x), bflo(w.y), bfhi(w.y)}; o[mm][bj][1] = (f32x4){bflo(w.z), bfhi(w.z), bflo(w.w), bfhi(w.w)}; }
            }
#pragma unroll
            for (int mm = 0; mm < 2; ++mm) { const int m = m0 + mm, row = rowb + ai * 128 + m * 16 + fr; float ss = 0.f, sg = 0.f;
#pragma unroll
                for (int bj = 0; bj < 2; ++bj) { const int c = colb + bj * 128;
                    const f32x4 n0 = o[mm][bj][0] * rn[mm] + alpha * acc[ai][bj][m][0], n1 = o[mm][bj][1] * rn[mm] + alpha * acc[ai][bj][m][1];
                    ss += (n0.x * n0.x + n0.y * n0.y) + (n0.z * n0.z + n0.w * n0.w) + (n1.x * n1.x + n1.y * n1.y) + (n1.z * n1.z + n1.w * n1.w);
                    const f32x4 b0 = n0 * gs[bj][0], b1 = n1 * gs[bj][1];
                    sg += (b0.x * b0.x + b0.y * b0.y) + (b0.z * b0.z + b0.w * b0.w) + (b1.x * b1.x + b1.y * b1.y) + (b1.z * b1.z + b1.w * b1.w);
                    u32x4 w; w.x = pk2(b0.x, b0.y); w.y = pk2(b0.z, b0.w); w.z = pk2(b1.x, b1.y); w.w = pk2(b1.z, b1.w);
                    *(u32x4*)(XB + (size_t)row * D + c) = w; }
                ss += __shfl_xor(ss, 16); ss += __shfl_xor(ss, 32);
                if (fq == 0) SSQ[(size_t)row * 16 + u.pn * 4 + wc] = ss;
                if (gsc) { sg += __shfl_xor(sg, 16); sg += __shfl_xor(sg, 32); if (fq == 0) SSQG[(size_t)row * 16 + u.pn * 4 + wc] = sg; } }
        }
    }
};
struct EpiWin {
    static constexpr bool PERM = true, AFTER_DRAIN = false;
    const LAS float* rtab; float* U; bf16_t* QB; bf16_t* ZS; bf16_t* XR;
    float* okp; float* oks;
    const float* gq; const float* gk;
    __device__ __forceinline__ void operator()(const f32x4 (&acc)[2][2][4][2], const pg8::Unit& u, int wr, int wc, int fr, int fq, int ui) const {
        const int rowb = u.pm * 256 + wr * 64; const int pn = u.pn;
        if (pn < 2) {
#pragma unroll
            for (int ai = 0; ai < 2; ++ai)
#pragma unroll
                for (int m = 0; m < 4; ++m) { const int row = rowb + ai * 128 + m * 16 + fr; const float rs = rtab[ui * 256 + (row - u.pm * 256)];
                    float* dst = U + (size_t)row * 256 + pn * 128 + wc * 32 + 8 * fq;
                    const float cexp = -1.4426950408889634f * rs;
#pragma unroll
                    for (int n = 0; n < 2; ++n) { const f32x4 a = acc[ai][0][m][n], g = acc[ai][1][m][n]; f32x4 o;
                        o.x = a.x * (rs * __builtin_amdgcn_rcpf(1.f + __builtin_amdgcn_exp2f(g.x * cexp))); o.y = a.y * (rs * __builtin_amdgcn_rcpf(1.f + __builtin_amdgcn_exp2f(g.y * cexp)));
                        o.z = a.z * (rs * __builtin_amdgcn_rcpf(1.f + __builtin_amdgcn_exp2f(g.z * cexp))); o.w = a.w * (rs * __builtin_amdgcn_rcpf(1.f + __builtin_amdgcn_exp2f(g.w * cexp))); *(f32x4*)(dst + 4 * n) = o; } }
        } else if (pn < 5) {
            f32x4 gv[2][2];
#pragma unroll
            for (int bj = 0; bj < 2; ++bj)
#pragma unroll
                for (int n = 0; n < 2; ++n) gv[bj][n] = (pn == 4) ? (f32x4){1.f, 1.f, 1.f, 1.f} : *(const f32x4*)((pn == 2 ? gq : gk) + 32 * bj + 8 * fq + 4 * n);
#pragma unroll
            for (int ai = 0; ai < 2; ++ai)
#pragma unroll
                for (int m = 0; m < 4; ++m) { const int rb = rowb + ai * 128 + m * 16, row = rb + fr; const float rs = rtab[ui * 256 + (row - u.pm * 256)];
                    f32x4 v[2][2]; float ss = 0.f;
#pragma unroll
                    for (int bj = 0; bj < 2; ++bj)
#pragma unroll
                        for (int n = 0; n < 2; ++n) { v[bj][n] = rs * acc[ai][bj][m][n]; ss += (v[bj][n].x * v[bj][n].x + v[bj][n].y * v[bj][n].y) + (v[bj][n].z * v[bj][n].z + v[bj][n].w * v[bj][n].w); }
                    ss += __shfl_xor(ss, 16); ss += __shfl_xor(ss, 32);
                    float sc = 1.f;
                    if (pn != 4) sc = rsqrtf(ss * (1.f / 64.f) + 1e-6f);
                    const float sq = (pn == 2) ? sc * (0.125f * 1.4426950408889634f) : sc;
                    bf16_t* bdst = QB + (size_t)(pn - 2) * ((size_t)MP * 256) + (size_t)row * 256 + wc * 64 + 8 * fq;
                    float* fdst = nullptr;
                    if (pn != 2 && rb < MT) fdst = (row < MPR) ? okp + (size_t)(pn - 3) * (O_VP - O_KP) + (size_t)row * 256 + wc * 64 + 8 * fq : oks + (size_t)(pn - 3) * (O_VS - O_KS) + (size_t)(row - MPR) * 256 + wc * 64 + 8 * fq;
#pragma unroll
                    for (int bj = 0; bj < 2; ++bj) { const f32x4 a = v[bj][0] * gv[bj][0] * sq, b = v[bj][1] * gv[bj][1] * sq;
                        u32x4 w; w.x = pk2(a.x, a.y); w.y = pk2(a.z, a.w); w.z = pk2(b.x, b.y); w.w = pk2(b.z, b.w);
                        *(u32x4*)(bdst + 32 * bj) = w;
                        if (fdst) { *(f32x4*)(fdst + 32 * bj) = a; *(f32x4*)(fdst + 32 * bj + 4) = b; } } }
        } else {
            const bool isz = pn < 7; bf16_t* base = isz ? ZS : XR; const int ld = isz ? 512 : 1024; const int c0 = (isz ? (pn - 5) : (pn - 7)) * 256 + wc * 32 + 8 * fq;
#pragma unroll
            for (int ai = 0; ai < 2; ++ai)
#pragma unroll
                for (int m = 0; m < 4; ++m) { const int row = rowb + ai * 128 + m * 16 + fr; const float rs = rtab[ui * 256 + (row - u.pm * 256)];
                    const float cexp = -1.4426950408889634f * rs;
#pragma unroll
                    for (int bj = 0; bj < 2; ++bj) { f32x4 a = acc[ai][bj][m][0], b = acc[ai][bj][m][1];
                        if (isz) { a.x *= rs * __builtin_amdgcn_rcpf(1.f + __builtin_amdgcn_exp2f(a.x * cexp)); a.y *= rs * __builtin_amdgcn_rcpf(1.f + __builtin_amdgcn_exp2f(a.y * cexp)); a.z *= rs * __builtin_amdgcn_rcpf(1.f + __builtin_amdgcn_exp2f(a.z * cexp)); a.w *= rs * __builtin_amdgcn_rcpf(1.f + __builtin_amdgcn_exp2f(a.w * cexp));
                                   b.x *= rs * __builtin_amdgcn_rcpf(1.f + __builtin_amdgcn_exp2f(b.x * cexp)); b.y *= rs * __builtin_amdgcn_rcpf(1.f + __builtin_amdgcn_exp2f(b.y * cexp)); b.z *= rs * __builtin_amdgcn_rcpf(1.f + __builtin_amdgcn_exp2f(b.z * cexp)); b.w *= rs * __builtin_amdgcn_rcpf(1.f + __builtin_amdgcn_exp2f(b.w * cexp)); }
                        else { a = a * rs; b = b * rs; }
                        u32x4 w; w.x = pk2(a.x, a.y); w.y = pk2(a.z, a.w); w.z = pk2(b.x, b.y); w.w = pk2(b.z, b.w);
                        *(u32x4*)(base + (size_t)row * ld + c0 + 128 * bj) = w; } }
        }
    }
};
__device__ __forceinline__ void tr_item(const float* __restrict__ W, int ldw, int col0, int k0, const float* __restrict__ gain, bf16_t* __restrict__ dst, int K, int row0, LAS float* scr, int lane) {
    const int kr = lane >> 3, c4 = lane & 7;
    f32x4 v[8]; float gg[8];
#pragma unroll
    for (int i = 0; i < 8; ++i) { v[i] = __builtin_nontemporal_load((const f32x4*)(W + (size_t)(k0 + 8 * i + kr) * ldw + col0 + 4 * c4)); gg[i] = gain ? gain[k0 + 8 * i + kr] : 1.f; }
    asm volatile("" : "+v"(v[0]), "+v"(v[1]), "+v"(v[2]), "+v"(v[3]), "+v"(v[4]), "+v"(v[5]), "+v"(v[6]), "+v"(v[7]), "+v"(gg[0]), "+v"(gg[1]), "+v"(gg[2]), "+v"(gg[3]), "+v"(gg[4]), "+v"(gg[5]), "+v"(gg[6]), "+v"(gg[7]));
#pragma unroll
    for (int i = 0; i < 8; ++i) { const int kk = 8 * i + kr; LAS float* s = scr + kk * 33 + 4 * c4;
        s[0] = v[i].x * gg[i]; s[1] = v[i].y * gg[i]; s[2] = v[i].z * gg[i]; s[3] = v[i].w * gg[i]; }
    asm volatile("s_waitcnt lgkmcnt(0)" ::: "memory");
    const int c = lane & 7;
#pragma unroll
    for (int j = 0; j < 4; ++j) { const int n = (lane >> 3) + 8 * j; const LAS float* s = scr + (8 * c) * 33 + n;
        u32x4 o; o.x = pk2(s[0 * 33], s[1 * 33]); o.y = pk2(s[2 * 33], s[3 * 33]); o.z = pk2(s[4 * 33], s[5 * 33]); o.w = pk2(s[6 * 33], s[7 * 33]);
        *(u32x4*)(dst + (size_t)(row0 + n) * K + k0 + 8 * c) = o; }
    asm volatile("s_waitcnt lgkmcnt(0)" ::: "memory");
}
constexpr int IT_GU = 16 * 176, IT_WD = 44 * 32, IT_WIN = 16 * 88, IT_WOUT = 16 * 32;
constexpr int IT_TOTAL = 4 * IT_GU + 4 * IT_WD + 2 * IT_WIN + 2 * IT_WOUT;
__device__ __forceinline__ void p0_weights(const Args& a, LAS unsigned char* lds, int gw, int ngw, int wave, int lane_in) { int lane = lane_in;
    LAS float* scr = (LAS float*)(lds + wave * 16384);
    unsigned char* ws = a.ws;
    for (int it = gw; it < 4 * IT_GU; it += ngw) { const int mat = it / IT_GU, r = it % IT_GU; const int l = mat >> 1, f = mat & 1, kb = r / 176, gidx = r % 176, pn = gidx >> 3, gi = gidx & 7, bj = gi >> 2, wc = gi & 3;
        const float* W = (f ? (bj ? a.in[30] : a.in[29]) : (bj ? a.in[11] : a.in[10])) + (size_t)l * D * FF;
        tr_item(W, FF, 128 * pn + 32 * wc, 64 * kb, (f ? a.in[28] : a.in[9]) + l * D, (bf16_t*)(ws + WS_WGU + mat * SZ_WGU), D, 32 * gidx, scr, lane); }
    asm volatile("" : "+v"(lane));
    for (int it = gw; it < 4 * IT_WD; it += ngw) { const int mat = it / IT_WD, r = it % IT_WD; const int l = mat >> 1, f = mat & 1, kb = r / 32, gidx = r % 32;
        tr_item((f ? a.in[31] : a.in[12]) + (size_t)l * FF * D, D, 32 * gidx, 64 * kb, nullptr, (bf16_t*)(ws + WS_WD + mat * SZ_WD), FF, 32 * gidx, scr, lane); }
    asm volatile("" : "+v"(lane));
    for (int it = gw; it < 2 * IT_WIN; it += ngw) { const int l = it / IT_WIN, r = it % IT_WIN; const int kb = r / 88, gidx = r % 88, pn = gidx >> 3, gi = gidx & 7, bj = gi >> 2, wc = gi & 3;
        int col0;
        if (pn < 2) col0 = (bj ? 256 : 0) + 128 * pn + 32 * wc; else if (pn < 5) col0 = 512 + 256 * (pn - 2) + 64 * wc + 32 * bj; else col0 = 1280 + 256 * (pn - 5) + 32 * gi;
        tr_item(a.in[14] + (size_t)l * D * NIN, NIN, col0, 64 * kb, a.in[13] + l * D, (bf16_t*)(ws + WS_WIN + l * SZ_WIN), D, 32 * gidx, scr, lane); }
    asm volatile("" : "+v"(lane));
    for (int it = gw; it < 2 * IT_WOUT; it += ngw) { const int l = it / IT_WOUT, r = it % IT_WOUT; const int kb = r / 32, gidx = r % 32;
        tr_item(a.in[15] + (size_t)l * D * D, D, 32 * gidx, 64 * kb, nullptr, (bf16_t*)(ws + WS_WOUT + l * SZ_WOUT), D, 32 * gidx, scr, lane); }
}
__device__ __forceinline__ void p0_rows(const Args& a, int gw, int ngw, int lane) {
    unsigned char* ws = a.ws; bf16_t* XB = (bf16_t*)(ws + WS_XB); float* SSQ = (float*)(ws + WS_SSQ);
    for (int m0 = gw; m0 < MP; m0 += 4 * ngw) {
        f32x4 xv[4][4];
#pragma unroll
        for (int r = 0; r < 4; ++r) { const int m = m0 + r * ngw; if (m < MT) { const float* x = (m < MPR) ? a.in[0] + (size_t)m * D : a.in[1] + (size_t)(m - MPR) * D;
#pragma unroll
            for (int j = 0; j < 4; ++j) xv[r][j] = __builtin_nontemporal_load((const f32x4*)(x + 4 * lane + 256 * j)); } }
#pragma unroll
        for (int r = 0; r < 4; ++r) { const int m = m0 + r * ngw; if (m >= MP) continue;
            if (m < MT) { float s = 0.f;
#pragma unroll
                for (int j = 0; j < 4; ++j) { const f32x4 v = xv[r][j]; s += (v.x * v.x + v.y * v.y) + (v.z * v.z + v.w * v.w);
                    u32x2 w; w.x = pk2(v.x, v.y); w.y = pk2(v.z, v.w); *(u32x2*)(XB + (size_t)m * D + 4 * lane + 256 * j) = w; }
                s = wsum(s); if (lane < 16) SSQ[(size_t)m * 16 + lane] = (lane == 0) ? s : 0.f;
            } else {
#pragma unroll
                for (int j = 0; j < 4; ++j) *(u32x2*)(XB + (size_t)m * D + 4 * lane + 256 * j) = (u32x2){0u, 0u};
                if (lane < 16) SSQ[(size_t)m * 16 + lane] = 0.f; } }
    }
    float* WDT = (float*)(ws + WS_WDT);
    for (int i = gw * 64 + lane; i < 2 * 1024 * 8; i += ngw * 64) { const int l = i >> 13, k = (i >> 3) & 1023, h = i & 7; WDT[i] = a.in[13][l * D + k] * a.in[14][((size_t)l * D + k) * NIN + 2816 + h]; }
    bf16_t* WDTB = (bf16_t*)(ws + WS_WDTB);
    for (int i = gw * 64 + lane; i < 2 * 16 * 1024; i += ngw * 64) { const int l = i >> 14, n = (i >> 10) & 15, k = i & 1023; const float v = (n < 8) ? a.in[13][l * D + k] * a.in[14][((size_t)l * D + k) * NIN + 2816 + n] : 0.f; WDTB[i] = (bf16_t)(pk2(v, 0.f) & 0xffffu); }
    float* BT = (float*)(ws + WS_BT);
    for (int i = gw * 64 + lane; i < 4 * 129; i += ngw * 64) { const int h = i / 129, d = i % 129; int bucket;
        if (d < 16) bucket = d; else { const double v = log((double)d / 16.0) / log(8.0) * 16.0; const int lg = 16 + (int)v; bucket = lg < 31 ? lg : 31; }
        BT[i] = a.in[8][bucket * 4 + h] * 1.4426950408889634f; }
}
__device__ __forceinline__ void colmean_unit(const float* __restrict__ r0, const float* __restrict__ r1, float* __restrict__ out, LAS float* scr, int tid) {
    const int c4 = tid & 63, rg = tid >> 6; f32x4 s = {0.f, 0.f, 0.f, 0.f};
#pragma unroll
    for (int hlf = 0; hlf < 2; ++hlf) { const float* p = (hlf ? r1 : r0) + (size_t)rg * 256 + 4 * c4;
        f32x4 v[16];
#pragma unroll
        for (int r = 0; r < 16; ++r) v[r] = __builtin_nontemporal_load((const f32x4*)(p + (size_t)r * 8 * 256));
#pragma unroll
        for (int r = 0; r < 16; ++r) s += v[r]; }
    *(LAS f32x4*)(scr + rg * 256 + 4 * c4) = s;
    __syncthreads();
    if (tid < 256) { float t = 0.f;
#pragma unroll
        for (int g = 0; g < 8; ++g) t += scr[g * 256 + tid];
        out[tid] = t * (1.f / 256.f); }
    __syncthreads();
}

__device__ __forceinline__ void convA_unit(const Args& a, int l, int unit, LAS unsigned char* lds, int tid) {
    unsigned char* ws = a.ws; const float* U = (const float*)(ws + WS_U); bf16_t* MIX = (bf16_t*)(ws + WS_MIX);
    const int b = unit >> 7, t0 = (unit & 127) * 64, c = tid & 255, half = tid >> 8, tb = t0 + 32 * half;
    const float* wv = a.in[16] + l * 31 * 256 + c; const float bias = a.in[17][l * 256 + c];
    LAS float* T = (LAS float*)lds;
    float win[62], wj[31];
#pragma unroll
    for (int k = 0; k < 62; ++k) { const int t = tb - 30 + k; win[k] = (t >= 0) ? U[(size_t)(b * SEQ + t) * 256 + c] : 0.f; }
#pragma unroll
    for (int j = 0; j < 31; ++j) wj[j] = wv[j * 256];
    asm volatile("" : "+v"(wj[0]), "+v"(wj[1]), "+v"(wj[2]), "+v"(wj[3]), "+v"(wj[4]), "+v"(wj[5]), "+v"(wj[6]), "+v"(wj[7]), "+v"(wj[8]), "+v"(wj[9]), "+v"(wj[10]), "+v"(wj[11]), "+v"(wj[12]), "+v"(wj[13]), "+v"(wj[14]), "+v"(wj[15]),
                 "+v"(wj[16]), "+v"(wj[17]), "+v"(wj[18]), "+v"(wj[19]), "+v"(wj[20]), "+v"(wj[21]), "+v"(wj[22]), "+v"(wj[23]), "+v"(wj[24]), "+v"(wj[25]), "+v"(wj[26]), "+v"(wj[27]), "+v"(wj[28]), "+v"(wj[29]));
    asm volatile("" : "+v"(wj[30]), "+v"(win[0]), "+v"(win[8]), "+v"(win[16]), "+v"(win[24]), "+v"(win[32]), "+v"(win[40]), "+v"(win[48]), "+v"(win[56]), "+v"(win[61]));
    float o[32];
#pragma unroll
    for (int i = 0; i < 32; ++i) o[i] = bias;
#pragma unroll
    for (int j = 0; j < 31; ++j) { const float w = wj[j];
#pragma unroll
        for (int i = 0; i < 32; ++i) o[i] = fmaf(w, win[i + j], o[i]); }
#pragma unroll
    for (int i = 0; i < 32; ++i) T[(32 * half + i) * 260 + c] = o[i];
    __syncthreads();
    const int wave = tid >> 6, lane = tid & 63;
    const f32x4 g = *(const f32x4*)(a.in[18] + l * 256 + 4 * lane), bb = *(const f32x4*)(a.in[19] + l * 256 + 4 * lane);
#pragma unroll
    for (int r = 0; r < 8; ++r) { const int row = 8 * wave + r; f32x4 v = *(const LAS f32x4*)(T + row * 260 + 4 * lane);
        const float mean = wsum((v.x + v.y) + (v.z + v.w)) * (1.f / 256.f); v = v - mean;
        const float rs = rsqrtf(wsum((v.x * v.x + v.y * v.y) + (v.z * v.z + v.w * v.w)) * (1.f / 256.f) + 1e-5f);
        v = v * rs * g + bb; u32x2 w; w.x = pk2(fsilu(v.x), fsilu(v.y)); w.y = pk2(fsilu(v.z), fsilu(v.w));
        *(u32x2*)(MIX + (size_t)(b * SEQ + t0 + row) * D + 4 * lane) = w; }
    if (t0 == SEQ - 64) { float* cp = a.out + O_CP + (size_t)(l * 2 + b) * 30 * 256;
        float cv[15];
#pragma unroll
        for (int i = 0; i < 15; ++i) cv[i] = U[(size_t)(b * SEQ + SEQ - 30) * 256 + tid + NTHR * i];
        asm volatile("" : "+v"(cv[0]), "+v"(cv[1]), "+v"(cv[2]), "+v"(cv[3]), "+v"(cv[4]), "+v"(cv[5]), "+v"(cv[6]), "+v"(cv[7]), "+v"(cv[8]), "+v"(cv[9]), "+v"(cv[10]), "+v"(cv[11]), "+v"(cv[12]), "+v"(cv[13]), "+v"(cv[14]));
#pragma unroll
        for (int i = 0; i < 15; ++i) cp[tid + NTHR * i] = cv[i]; }
    __syncthreads();
}
__device__ __forceinline__ void convA_sample_unit(const Args& a, int l, int sb, LAS unsigned char* lds, int tid) {
    unsigned char* ws = a.ws; const float* U = (const float*)(ws + WS_U); bf16_t* MIX = (bf16_t*)(ws + WS_MIX);
    const int c = tid & 255, half = tid >> 8; const float* wv = a.in[16] + l * 31 * 256 + c;
    const float* st = a.in[4] + ((size_t)l * 32 + sb) * 30 * 256 + c; float* cs = a.out + O_CS + ((size_t)l * 32 + sb) * 30 * 256 + c;
    LAS float* P = (LAS float*)lds;
    const float un = U[(size_t)(MPR + sb) * 256 + c];
    float sv[16], wj[16];
#pragma unroll
    for (int j = 0; j < 16; ++j) { const int jj = 16 * half + j; sv[j] = (jj < 30) ? st[(size_t)jj * 256] : un; wj[j] = (jj < 31) ? wv[jj * 256] : 0.f; }
    float acc = half ? 0.f : a.in[17][l * 256 + c];
    asm volatile("" : "+v"(sv[0]), "+v"(sv[1]), "+v"(sv[2]), "+v"(sv[3]), "+v"(sv[4]), "+v"(sv[5]), "+v"(sv[6]), "+v"(sv[7]), "+v"(sv[8]), "+v"(sv[9]), "+v"(sv[10]), "+v"(sv[11]), "+v"(sv[12]), "+v"(sv[13]), "+v"(sv[14]), "+v"(sv[15]), "+v"(acc));
    asm volatile("" : "+v"(wj[0]), "+v"(wj[1]), "+v"(wj[2]), "+v"(wj[3]), "+v"(wj[4]), "+v"(wj[5]), "+v"(wj[6]), "+v"(wj[7]), "+v"(wj[8]), "+v"(wj[9]), "+v"(wj[10]), "+v"(wj[11]), "+v"(wj[12]), "+v"(wj[13]), "+v"(wj[14]), "+v"(wj[15]));
#pragma unroll
    for (int j = 0; j < 16; ++j) { const int jj = 16 * half + j; if (jj < 31) { acc = fmaf(wj[j], sv[j], acc); if (jj >= 1) cs[(size_t)(jj - 1) * 256] = sv[j]; } }
    P[half * 256 + c] = acc;
    __syncthreads();
    if (tid < 64) { const int lane = tid; f32x4 v = *(const LAS f32x4*)(P + 4 * lane) + *(const LAS f32x4*)(P + 256 + 4 * lane);
        const f32x4 g = *(const f32x4*)(a.in[18] + l * 256 + 4 * lane), bb = *(const f32x4*)(a.in[19] + l * 256 + 4 * lane);
        const float mean = wsum((v.x + v.y) + (v.z + v.w)) * (1.f / 256.f); v = v - mean;
        const float rs = rsqrtf(wsum((v.x * v.x + v.y * v.y) + (v.z * v.z + v.w * v.w)) * (1.f / 256.f) + 1e-5f);
        v = v * rs * g + bb; u32x2 w; w.x = pk2(fsilu(v.x), fsilu(v.y)); w.y = pk2(fsilu(v.z), fsilu(v.w));
        *(u32x2*)(MIX + (size_t)(MPR + sb) * D + 4 * lane) = w; }
    __syncthreads();
}
__device__ __forceinline__ void conv4_unit(const Args& a, int l, int unit, int tid) {
    unsigned char* ws = a.ws; const bf16_t* XR = (const bf16_t*)(ws + WS_XR); bf16_t* XC = (bf16_t*)(ws + WS_XC);
    if (unit < 256) {
        const int c8 = 8 * (tid & 127), rg = tid >> 7, b = unit >> 7, t0 = (unit & 127) * 64 + 16 * rg; const size_t r0 = (size_t)b * SEQ + t0;
        const float* w = a.in[22] + l * 4 * 1024 + c8; const float* bp = a.in[23] + l * 1024 + c8;
        u32x4 raw[19];
#pragma unroll
        for (int i = 0; i < 19; ++i) raw[i] = (t0 + i - 3 >= 0) ? *(const u32x4*)(XR + (r0 + i - 3) * 1024 + c8) : (u32x4){0u, 0u, 0u, 0u};
        float wf[4][8], bf[8];
#pragma unroll
        for (int j = 0; j < 4; ++j) { const f32x4 wa = *(const f32x4*)(w + j * 1024), wb = *(const f32x4*)(w + j * 1024 + 4); wf[j][0] = wa.x; wf[j][1] = wa.y; wf[j][2] = wa.z; wf[j][3] = wa.w; wf[j][4] = wb.x; wf[j][5] = wb.y; wf[j][6] = wb.z; wf[j][7] = wb.w; }
        { const f32x4 ba = *(const f32x4*)bp, bb = *(const f32x4*)(bp + 4); bf[0] = ba.x; bf[1] = ba.y; bf[2] = ba.z; bf[3] = ba.w; bf[4] = bb.x; bf[5] = bb.y; bf[6] = bb.z; bf[7] = bb.w; }
        float win[4][8];
#pragma unroll
        for (int i = 0; i < 3; ++i) { win[i][0] = bflo(raw[i].x); win[i][1] = bfhi(raw[i].x); win[i][2] = bflo(raw[i].y); win[i][3] = bfhi(raw[i].y); win[i][4] = bflo(raw[i].z); win[i][5] = bfhi(raw[i].z); win[i][6] = bflo(raw[i].w); win[i][7] = bfhi(raw[i].w); }
#pragma unroll
        for (int i = 0; i < 16; ++i) { const u32x4 rr = raw[i + 3]; const int s3 = (i + 3) & 3;
            win[s3][0] = bflo(rr.x); win[s3][1] = bfhi(rr.x); win[s3][2] = bflo(rr.y); win[s3][3] = bfhi(rr.y); win[s3][4] = bflo(rr.z); win[s3][5] = bfhi(rr.z); win[s3][6] = bflo(rr.w); win[s3][7] = bfhi(rr.w);
            float o[8];
#pragma unroll
            for (int e = 0; e < 8; ++e) { float v = bf[e];
#pragma unroll
                for (int j = 0; j < 4; ++j) v = fmaf(wf[j][e], win[(i + j) & 3][e], v);
                o[e] = fsilu(v); }
            u32x4 ow; ow.x = pk2(o[0], o[1]); ow.y = pk2(o[2], o[3]); ow.z = pk2(o[4], o[5]); ow.w = pk2(o[6], o[7]);
            *(u32x4*)(XC + (r0 + i) * 1024 + c8) = ow; }
        if (t0 == SEQ - 16) { float* sp = a.out + O_SCP + (size_t)(l * 2 + b) * 3 * 1024 + c8;
#pragma unroll
            for (int i = 0; i < 3; ++i) { const u32x4 rr = raw[16 + i]; *(f32x4*)(sp + i * 1024) = (f32x4){bflo(rr.x), bfhi(rr.x), bflo(rr.y), bfhi(rr.y)}; *(f32x4*)(sp + i * 1024 + 4) = (f32x4){bflo(rr.z), bfhi(rr.z), bflo(rr.w), bfhi(rr.w)}; } }
    } else {
        const int c = 2 * tid; const float* w = a.in[22] + l * 4 * 1024 + c; const f32x2 bias = *(const f32x2*)(a.in[23] + l * 1024 + c);
        const f32x2 w0 = *(const f32x2*)(w), w1 = *(const f32x2*)(w + 1024), w2 = *(const f32x2*)(w + 2048), w3 = *(const f32x2*)(w + 3072);
        const float* st = a.in[5] + (size_t)l * 32 * 3 * 1024 + c; float* so = a.out + O_SCS + (size_t)l * 32 * 3 * 1024 + c;
        f32x2 q3[8], q2[8], q1[8]; unsigned ur[8];
#pragma unroll
        for (int k = 0; k < 8; ++k) { const int sb = 8 * (unit - 256) + k;
            q3[k] = *(const f32x2*)(st + (size_t)(sb * 3 + 0) * 1024); q2[k] = *(const f32x2*)(st + (size_t)(sb * 3 + 1) * 1024); q1[k] = *(const f32x2*)(st + (size_t)(sb * 3 + 2) * 1024);
            ur[k] = *(const unsigned*)(XR + (size_t)(MPR + sb) * 1024 + c); }
#pragma unroll
        for (int k = 0; k < 8; ++k) asm volatile("" : "+v"(q3[k]), "+v"(q2[k]), "+v"(q1[k]), "+v"(ur[k]));
#pragma unroll
        for (int k = 0; k < 8; ++k) { const int sb = 8 * (unit - 256) + k; const f32x2 raw = {bflo(ur[k]), bfhi(ur[k])};
            const f32x2 v = bias + w0 * q3[k] + w1 * q2[k] + w2 * q1[k] + w3 * raw;
            *(unsigned*)(XC + (size_t)(MPR + sb) * 1024 + c) = pk2(fsilu(v.x), fsilu(v.y));
            *(f32x2*)(so + (size_t)(sb * 3 + 0) * 1024) = q2[k]; *(f32x2*)(so + (size_t)(sb * 3 + 1) * 1024) = q1[k]; *(f32x2*)(so + (size_t)(sb * 3 + 2) * 1024) = raw; }
    }
}
__device__ __forceinline__ void dt_row(const Args& a, int l, int row, int lane) {
    unsigned char* ws = a.ws; const bf16_t* XBr = (const bf16_t*)(ws + WS_XB) + (size_t)row * D; const float* WDT = (const float*)(ws + WS_WDT) + l * 1024 * 8;
    float acc[8];
#pragma unroll
    for (int h = 0; h < 8; ++h) acc[h] = 0.f;
#pragma unroll
    for (int j = 0; j < 4; ++j) { const int k = 4 * lane + 256 * j; const u32x2 xw = *(const u32x2*)(XBr + k); const f32x4 x = {bflo(xw.x), bfhi(xw.x), bflo(xw.y), bfhi(xw.y)};
#pragma unroll
        for (int e = 0; e < 4; ++e) { const f32x4 wa = *(const f32x4*)(WDT + (k + e) * 8), wb = *(const f32x4*)(WDT + (k + e) * 8 + 4); const float xv = x[e];
            acc[0] = fmaf(xv, wa.x, acc[0]); acc[1] = fmaf(xv, wa.y, acc[1]); acc[2] = fmaf(xv, wa.z, acc[2]); acc[3] = fmaf(xv, wa.w, acc[3]);
            acc[4] = fmaf(xv, wb.x, acc[4]); acc[5] = fmaf(xv, wb.y, acc[5]); acc[6] = fmaf(xv, wb.z, acc[6]); acc[7] = fmaf(xv, wb.w, acc[7]); } }
    const float rs = rstd16((const float*)(ws + WS_SSQ) + (size_t)row * 16);
    float mine = 0.f;
#pragma unroll
    for (int h = 0; h < 8; ++h) { const float s = wsum(acc[h]); if (lane == h) mine = s; }
    if (lane < 8) { const float x = rs * mine + a.in[24][l * 8 + lane]; ((float*)(ws + WS_DT))[(size_t)row * 8 + lane] = fmaxf(x, 0.f) + log1pf(expf(-fabsf(x))); }
}
__device__ __forceinline__ void final_rows4(const Args& a, int l, int row0, int rstride, int lane) {
    unsigned char* ws = a.ws; const float* g = a.in[32] + l * D;
    u32x2 w[4][4];
#pragma unroll
    for (int r = 0; r < 4; ++r) { const int row = row0 + r * rstride; if (row < MT) {
#pragma unroll
        for (int j = 0; j < 4; ++j) w[r][j] = *(const u32x2*)((const bf16_t*)(ws + WS_XB) + (size_t)row * D + 4 * lane + 256 * j); } }
    f32x4 gg[4];
#pragma unroll
    for (int j = 0; j < 4; ++j) gg[j] = *(const f32x4*)(g + 4 * lane + 256 * j);
#pragma unroll
    for (int r = 0; r < 4; ++r) { const int row = row0 + r * rstride; if (row < MT) { f32x4 v[4]; float s = 0.f;
#pragma unroll
        for (int j = 0; j < 4; ++j) { v[j] = (f32x4){bflo(w[r][j].x), bfhi(w[r][j].x), bflo(w[r][j].y), bfhi(w[r][j].y)}; s += (v[j].x * v[j].x + v[j].y * v[j].y) + (v[j].z * v[j].z + v[j].w * v[j].w); }
        const float rs = rsqrtf(wsum(s) * (1.f / 1024.f) + 1e-6f);
        float* o = row < MPR ? a.out + O_YP + (size_t)row * D : a.out + O_YS + (size_t)(row - MPR) * D;
#pragma unroll
        for (int j = 0; j < 4; ++j) *(f32x4*)(o + 4 * lane + 256 * j) = v[j] * rs * gg[j]; } }
}
__device__ __forceinline__ void attn_simple(const Args& a, int l, int item, LAS float* L, int ht, bf16_t* outp = nullptr) {
    unsigned char* ws = a.ws;
    const bf16_t* QB = (const bf16_t*)(ws + WS_QB); const bf16_t* KB = (const bf16_t*)(ws + WS_KB); const bf16_t* VB = (const bf16_t*)(ws + WS_VB);
    const float* KMP = (const float*)(ws + WS_KMP); const float* KMS = (const float*)(ws + WS_KMS) + (size_t)l * 1024 * 256; const float* BT = (const float*)(ws + WS_BT);
    const float* cachek = a.in[2] + (size_t)l * CACHE_L; const float* cachev = a.in[3] + (size_t)l * CACHE_L; const int* pt = (const int*)a.in[7];
    bf16_t* MIX = outp ? outp : (bf16_t*)(ws + WS_MIX);
    LAS float* qs = L; LAS float* gate = L + 64; LAS int* sel = (LAS int*)(L + 96); LAS float* lg = L + 128; LAS float* red = L + 1152; LAS float* osum = L + 1408;
    const int m = item >> 2, h = item & 3; const bool smp = m >= MPR; const int b = m >> 13, t = m & 8191, sb = m - MPR;
    const int qpos = smp ? 8192 : t, cur = qpos >> 8;
    if (ht < 64) qs[ht] = bf1(QB[(size_t)m * 256 + h * 64 + ht]);
    __syncthreads();
    if (ht < cur) { const float* km = (smp ? KMS + (size_t)(sb * 32 + ht) * 256 : KMP + (size_t)(b * 32 + ht) * 256) + h * 64; float g = 0.f; for (int d = 0; d < 64; ++d) g = fmaf(qs[d], km[d], g); gate[ht] = g; }
    __syncthreads();
    if (ht == 0) { const int cnt = cur < 3 ? cur : 3; int s0 = -1, s1 = -1, s2 = -1;
        for (int j = 0; j < cnt; ++j) { int best = -1; float bv = 0.f;
            for (int n = 0; n < cur; ++n) { if (n == s0 || n == s1) continue; if (best < 0 || gate[n] > bv) { best = n; bv = gate[n]; } }
            if (j == 0) s0 = best; else if (j == 1) s1 = best; else s2 = best; }
        sel[0] = s0; sel[1] = s1; sel[2] = s2; sel[cnt] = cur; sel[4] = cnt; }
    __syncthreads();
    const int cnt = sel[4]; float mx = -INFINITY;
    for (int j = 0; j <= cnt; ++j) { const int blk = sel[j], kpos = blk * 256 + ht; float lgt = -INFINITY;
        if (kpos <= qpos) { float acc = 0.f;
            if (smp && blk < 32) { const float* kp = cachek + ((size_t)pt[sb * NPAGES + (kpos >> 7)] * 128 + (kpos & 127)) * 256 + h * 64;
                for (int d = 0; d < 64; ++d) acc = fmaf(qs[d], kp[d], acc);
            } else { const bf16_t* kp = KB + (size_t)(smp ? m : b * SEQ + kpos) * 256 + h * 64;
                for (int d8 = 0; d8 < 8; ++d8) { const u32x4 w = *(const u32x4*)(kp + 8 * d8);
                    acc = fmaf(qs[8 * d8 + 0], bflo(w.x), acc); acc = fmaf(qs[8 * d8 + 1], bfhi(w.x), acc); acc = fmaf(qs[8 * d8 + 2], bflo(w.y), acc); acc = fmaf(qs[8 * d8 + 3], bfhi(w.y), acc);
                    acc = fmaf(qs[8 * d8 + 4], bflo(w.z), acc); acc = fmaf(qs[8 * d8 + 5], bfhi(w.z), acc); acc = fmaf(qs[8 * d8 + 6], bflo(w.w), acc); acc = fmaf(qs[8 * d8 + 7], bfhi(w.w), acc); } }
            const int dist = qpos - kpos; lgt = acc + BT[h * 129 + (dist < 128 ? dist : 128)]; }
        lg[j * 256 + ht] = lgt; mx = fmaxf(mx, lgt); }
    red[ht] = mx; __syncthreads();
    for (int o = 128; o > 0; o >>= 1) { if (ht < o) red[ht] = fmaxf(red[ht], red[ht + o]); __syncthreads(); }
    mx = red[0]; __syncthreads();
    float ps = 0.f;
    for (int j = 0; j <= cnt; ++j) { const float p = expf(lg[j * 256 + ht] - mx); lg[j * 256 + ht] = p; ps += p; }
    red[ht] = ps; __syncthreads();
    for (int o = 128; o > 0; o >>= 1) { if (ht < o) red[ht] += red[ht + o]; __syncthreads(); }
    const float tot = red[0];
    { const int j = ht >> 6, d = ht & 63; float acc = 0.f;
      if (j <= cnt) { const int blk = sel[j];
        for (int s = 0; s < 256; ++s) { const float p = lg[j * 256 + s]; if (p == 0.f) continue; const int kpos = blk * 256 + s; float v;
            if (smp && blk < 32) v = cachev[((size_t)pt[sb * NPAGES + (kpos >> 7)] * 128 + (kpos & 127)) * 256 + h * 64 + d];
            else v = bf1(VB[(size_t)(smp ? m : b * SEQ + kpos) * 256 + h * 64 + d]);
            acc = fmaf(p, v, acc); } }
      osum[j * 64 + d] = acc; }
    __syncthreads();
    if (ht < 64) { const float o = (osum[ht] + osum[64 + ht] + osum[128 + ht] + osum[192 + ht]) / tot; MIX[(size_t)m * D + 256 + h * 64 + ht] = (bf16_t)(pk2(o, 0.f) & 0xffffu); }
    __syncthreads();
}
__device__ __forceinline__ void ssd_seq_item(const Args& a, int l, int wv, int lane) {
    unsigned char* ws = a.ws; const bf16_t* XC = (const bf16_t*)(ws + WS_XC); const float* DT = (const float*)(ws + WS_DT); float* Y = (float*)(ws + WS_Y);
    const int seq = wv >> 9, h = (wv >> 6) & 7, p = wv & 63, g = h >> 2;
    const float A = -expf(a.in[25][l * 8 + h]);
    const bool smp = seq >= 2; const int T = smp ? 1 : SEQ; const size_t row0 = smp ? (size_t)MPR + (seq - 2) : (size_t)seq * SEQ;
    float h0 = 0.f, h1 = 0.f;
    if (smp) { const float* s = a.in[6] + (size_t)l * 32 * 8 * 64 * 128 + ((size_t)((seq - 2) * 8 + h) * 64 + p) * 128; h0 = s[lane]; h1 = s[lane + 64]; }
    const bf16_t* xc = XC + row0 * 1024; const float* dt = DT + row0 * 8;
    float dtv = dt[h], xv = bf1(xc[h * 64 + p]), b0 = bf1(xc[512 + g * 128 + lane]), b1 = bf1(xc[512 + g * 128 + 64 + lane]), c0 = bf1(xc[768 + g * 128 + lane]), c1 = bf1(xc[768 + g * 128 + 64 + lane]);
    for (int t = 0; t < T; ++t) {
        float ndt = 0.f, nx = 0.f, nb0 = 0.f, nb1 = 0.f, nc0 = 0.f, nc1 = 0.f;
        if (t + 1 < T) { const bf16_t* x2 = xc + (size_t)(t + 1) * 1024; ndt = dt[(size_t)(t + 1) * 8 + h]; nx = bf1(x2[h * 64 + p]); nb0 = bf1(x2[512 + g * 128 + lane]); nb1 = bf1(x2[512 + g * 128 + 64 + lane]); nc0 = bf1(x2[768 + g * 128 + lane]); nc1 = bf1(x2[768 + g * 128 + 64 + lane]); }
        const float dA = expf(dtv * A), xd = dtv * xv;
        h0 = fmaf(h0, dA, xd * b0); h1 = fmaf(h1, dA, xd * b1);
        const float y = wsum(c0 * h0 + c1 * h1);
        if (lane == 0) Y[(row0 + t) * 512 + h * 64 + p] = y;
        dtv = ndt; xv = nx; b0 = nb0; b1 = nb1; c0 = nc0; c1 = nc1;
    }
    float* o = smp ? a.out + O_HS + (size_t)l * 32 * 8 * 64 * 128 + ((size_t)((seq - 2) * 8 + h) * 64 + p) * 128 : a.out + O_HP + (size_t)l * 2 * 8 * 64 * 128 + ((size_t)(seq * 8 + h) * 64 + p) * 128;
    o[lane] = h0; o[lane + 64] = h1;
}
__device__ __forceinline__ void ssm_out_row(const Args& a, int l, int row, int lane) {
    unsigned char* ws = a.ws; const u32x4 yw = *(const u32x4*)((const bf16_t*)(ws + WS_Y) + (size_t)row * 512 + 8 * lane);
    const u32x4 xw = *(const u32x4*)((const bf16_t*)(ws + WS_XC) + (size_t)row * 1024 + 8 * lane), zw = *(const u32x4*)((const bf16_t*)(ws + WS_ZS) + (size_t)row * 512 + 8 * lane);
    const f32x4 y0 = {bflo(yw.x), bfhi(yw.x), bflo(yw.y), bfhi(yw.y)}, y1 = {bflo(yw.z), bfhi(yw.z), bflo(yw.w), bfhi(yw.w)}; const float Dh = a.in[26][l * 8 + (lane >> 3)];
    float v[8];
    v[0] = (y0.x + Dh * bflo(xw.x)) * bflo(zw.x); v[1] = (y0.y + Dh * bfhi(xw.x)) * bfhi(zw.x); v[2] = (y0.z + Dh * bflo(xw.y)) * bflo(zw.y); v[3] = (y0.w + Dh * bfhi(xw.y)) * bfhi(zw.y);
    v[4] = (y1.x + Dh * bflo(xw.z)) * bflo(zw.z); v[5] = (y1.y + Dh * bfhi(xw.z)) * bfhi(zw.z); v[6] = (y1.z + Dh * bflo(xw.w)) * bflo(zw.w); v[7] = (y1.w + Dh * bfhi(xw.w)) * bfhi(zw.w);
    float s = 0.f;
#pragma unroll
    for (int k = 0; k < 8; ++k) s += v[k] * v[k];
    const float rs = rsqrtf(wsum(s) * (1.f / 512.f) + 1e-6f);
    const f32x4 g0 = *(const f32x4*)(a.in[27] + l * 512 + 8 * lane), g1 = *(const f32x4*)(a.in[27] + l * 512 + 8 * lane + 4);
    u32x4 w; w.x = pk2(v[0] * rs * g0.x, v[1] * rs * g0.y); w.y = pk2(v[2] * rs * g0.z, v[3] * rs * g0.w); w.z = pk2(v[4] * rs * g1.x, v[5] * rs * g1.y); w.w = pk2(v[6] * rs * g1.z, v[7] * rs * g1.w);
    *(u32x4*)((bf16_t*)(ws + WS_MIX) + (size_t)row * D + 512 + 8 * lane) = w;
}
#define MFMA16(a, b, c) __builtin_amdgcn_mfma_f32_16x16x32_bf16((a), (b), (c), 0, 0, 0)
__device__ __forceinline__ bf16x8 mk8(u32x4 v) { return __builtin_bit_cast(bf16x8, v); }
__device__ __forceinline__ bf16x8 mk8(u32x2 lo, u32x2 hi) { u32x4 v; v.x = lo.x; v.y = lo.y; v.z = hi.x; v.w = hi.y; return __builtin_bit_cast(bf16x8, v); }

__device__ __forceinline__ void dtslab_unit(const Args& a, int l, int unit, LAS unsigned char* lds, int tid) {
    unsigned char* ws = a.ws; const int lane = tid & 63, wave = __builtin_amdgcn_readfirstlane(tid >> 6), fr = lane & 15, gq = lane >> 4, rt = wave >> 1, kh = wave & 1;
    const size_t r0 = (size_t)unit * 64;
    LAS float* part = (LAS float*)lds;
    LAS float* dAs = part + 1024;
    const bf16_t* WB = (const bf16_t*)(ws + WS_WDTB) + (size_t)l * 16 * 1024 + fr * 1024 + 512 * kh + 8 * gq;
    const bf16_t* xr = (const bf16_t*)(ws + WS_XB) + (r0 + 16 * rt + fr) * D + 512 * kh + 8 * gq;
    u32x4 xa[16], wb[16];
#pragma unroll
    for (int ks = 0; ks < 16; ++ks) { xa[ks] = *(const u32x4*)(xr + 32 * ks); wb[ks] = *(const u32x4*)(WB + 32 * ks); }
    float rs_pre = rstd16((const float*)(ws + WS_SSQ) + (r0 + (tid >> 3)) * 16);
    float dtb_pre = a.in[24][l * 8 + (tid & 7)], alog_pre = a.in[25][l * 8 + (tid & 7)];
    asm volatile("" : "+v"(rs_pre), "+v"(dtb_pre), "+v"(alog_pre));
#pragma unroll
    for (int ks = 0; ks < 16; ks += 4) { asm volatile("" : "+v"(xa[ks]), "+v"(xa[ks + 1]), "+v"(xa[ks + 2]), "+v"(xa[ks + 3]), "+v"(wb[ks]), "+v"(wb[ks + 1]), "+v"(wb[ks + 2]), "+v"(wb[ks + 3])); }
    f32x4 acc = {0.f, 0.f, 0.f, 0.f};
#pragma unroll
    for (int ks = 0; ks < 16; ++ks) acc = MFMA16(mk8(xa[ks]), mk8(wb[ks]), acc);
    if (fr < 8) {
#pragma unroll
        for (int r = 0; r < 4; ++r) part[(kh * 64 + 16 * rt + 4 * gq + r) * 8 + fr] = acc[r]; }
    __syncthreads();
    { const int lr = tid >> 3, h = tid & 7; const size_t row = r0 + lr; const float rs = rs_pre;
      const float x = rs * (part[lr * 8 + h] + part[(64 + lr) * 8 + h]) + dtb_pre; const float dtv = fmaxf(x, 0.f) + log1pf(expf(-fabsf(x)));
      ((float*)(ws + WS_DT))[row * 8 + h] = dtv; dAs[lr * 8 + h] = dtv * -expf(alog_pre); }
    __syncthreads();
    if (wave == 0) { float* AC = (float*)(ws + WS_ACUM) + (r0 + lane) * 8; float* TOT = (float*)(ws + WS_TOT) + (size_t)unit * 8;
#pragma unroll
        for (int h = 0; h < 8; ++h) { float inc = dAs[lane * 8 + h];
#pragma unroll
            for (int o = 1; o < 64; o <<= 1) { const float t = __shfl_up(inc, o); if (lane >= o) inc += t; }
            AC[h] = inc; if (lane == 63) TOT[h] = inc; } }
    __syncthreads();
}
constexpr int SA_BM = 0, SA_XT = 69632, SA_XT2 = SA_XT + 33792, SA_AC = SA_XT2 + 33792;
__device__ __forceinline__ void ssdA_unit(const Args& a, int l, int unit, LAS unsigned char* lds, int tid) {
    unsigned char* ws = a.ws; const int lane = tid & 63, wave = __builtin_amdgcn_readfirstlane(tid >> 6), fr = lane & 15, gq = lane >> 4;
    const int h = unit & 7, g = h >> 2; const size_t r0 = (size_t)(unit >> 3) * 256;
    const bf16_t* XC = (const bf16_t*)(ws + WS_XC); const float* DT = (const float*)(ws + WS_DT); const float* ACUM = (const float*)(ws + WS_ACUM);
    LAS bf16_t* Bm = (LAS bf16_t*)(lds + SA_BM); LAS bf16_t* XT = (LAS bf16_t*)(lds + SA_XT); LAS bf16_t* XT2 = (LAS bf16_t*)(lds + SA_XT2); LAS float* acs = (LAS float*)(lds + SA_AC);
    u32x4 cpre[2][4];
#pragma unroll
    for (int which = 0; which < 2; ++which)
#pragma unroll
        for (int kk = 0; kk < 4; ++kk) cpre[which][kk] = *(const u32x4*)(XC + (r0 + 16 * (which ? 15 - wave : wave) + fr) * 1024 + 768 + g * 128 + 32 * kk + 8 * gq);
#ifndef SSDA_RB
#define SSDA_RB 1
#endif
#ifndef SSDA_RX
#define SSDA_RX 1
#endif
    u32x4 bst[8];
#pragma unroll
    for (int pass = 0; pass < 8; ++pass) { const int row = pass * 32 + (tid >> 4), ch = tid & 15; bst[pass] = *(const u32x4*)(XC + (r0 + row) * 1024 + 512 + g * 128 + 8 * ch); }
    const float* TOT = (const float*)(ws + WS_TOT) + (size_t)(unit >> 3) * 4 * 8 + h;
    float t0 = TOT[0], t1 = TOT[8], t2 = TOT[16], t3 = TOT[24];
    u32x4 xvp[4]; float dtp[4], acp[4];
#pragma unroll
    for (int pass = 0; pass < 4; ++pass) { const int s = pass * 64 + lane; xvp[pass] = *(const u32x4*)(XC + (r0 + s) * 1024 + h * 64 + 8 * wave); dtp[pass] = DT[(r0 + s) * 8 + h]; acp[pass] = ACUM[(r0 + s) * 8 + h]; }
    asm volatile("" : "+v"(bst[0]), "+v"(bst[1]), "+v"(bst[2]), "+v"(bst[3]), "+v"(bst[4]), "+v"(bst[5]), "+v"(bst[6]), "+v"(bst[7]), "+v"(t0), "+v"(t1), "+v"(t2), "+v"(t3),
                 "+v"(xvp[0]), "+v"(xvp[1]), "+v"(xvp[2]), "+v"(xvp[3]), "+v"(dtp[0]), "+v"(dtp[1]), "+v"(dtp[2]), "+v"(dtp[3]), "+v"(acp[0]), "+v"(acp[1]), "+v"(acp[2]), "+v"(acp[3]));
#pragma unroll
    for (int pass = 0; pass < 8; ++pass) { const int row = pass * 32 + (tid >> 4), ch = tid & 15; *(LAS u32x4*)(Bm + row * 136 + 8 * ch) = bst[pass]; }
    const float ac_end = ((t0 + t1) + t2) + t3;
    if (tid == 0) ((float*)(ws + WS_CT))[unit] = ac_end;
    for (int rrx_ = 0; rrx_ < SSDA_RX; ++rrx_)
#pragma unroll
    for (int pass = 0; pass < 4; ++pass) { const int s = pass * 64 + lane;
        const u32x4 v = xvp[pass]; const float dtv = dtp[pass], acv = acp[pass] + (pass == 0 ? 0.f : pass == 1 ? t0 : pass == 2 ? (t0 + t1) : ((t0 + t1) + t2)); const float e = expf(ac_end - acv);
        if (wave == 0) acs[s] = acv;
        float x[8]; x[0] = bflo(v.x); x[1] = bfhi(v.x); x[2] = bflo(v.y); x[3] = bfhi(v.y); x[4] = bflo(v.z); x[5] = bfhi(v.z); x[6] = bflo(v.w); x[7] = bfhi(v.w);
#pragma unroll
        for (int i = 0; i < 8; ++i) { const float xd = x[i] * dtv; const unsigned w = pk2(xd, xd * e); XT[(8 * wave + i) * 264 + s] = (bf16_t)(w & 0xffffu); XT2[(8 * wave + i) * 264 + s] = (bf16_t)(w >> 16); } }
    __syncthreads();
#ifndef SSDA_R1
#define SSDA_R1 1
#endif
#ifndef SSDA_R2
#define SSDA_R2 1
#endif
#ifndef SSDA_R0
#define SSDA_R0 1
#endif
    for (int rr1_ = 0; rr1_ < SSDA_R1; ++rr1_) { f32x4 acc[4];
#pragma unroll
      for (int pt = 0; pt < 4; ++pt) acc[pt] = (f32x4){0.f, 0.f, 0.f, 0.f};
#pragma unroll 2
      for (int ks = 0; ks < 8; ++ks) { const LAS bf16_t* bp = Bm + (32 * ks + 8 * gq) * 136 + 16 * wave + fr;
          u32x4 av; av.x = (unsigned)bp[0] | ((unsigned)bp[136] << 16); av.y = (unsigned)bp[2 * 136] | ((unsigned)bp[3 * 136] << 16); av.z = (unsigned)bp[4 * 136] | ((unsigned)bp[5 * 136] << 16); av.w = (unsigned)bp[6 * 136] | ((unsigned)bp[7 * 136] << 16);
          const bf16x8 A = mk8(av);
#pragma unroll
          for (int pt = 0; pt < 4; ++pt) { const bf16x8 Bf = mk8(*(const LAS u32x4*)(XT2 + (16 * pt + fr) * 264 + 32 * ks + 8 * gq)); acc[pt] = MFMA16(A, Bf, acc[pt]); } }
      float* ST = (float*)(ws + WS_ST) + (size_t)unit * 8192;
#pragma unroll
      for (int pt = 0; pt < 4; ++pt) *(f32x4*)(ST + (16 * pt + fr) * 128 + 16 * wave + 4 * gq) = acc[pt]; }
    bf16_t* Y = (bf16_t*)(ws + WS_Y);
    for (int rr2_ = 0; rr2_ < SSDA_R2; ++rr2_)
#pragma unroll
    for (int which = 0; which < 2; ++which) { const int lt = which ? 15 - wave : wave, lrow = 16 * lt + fr; const size_t row = r0 + lrow;
        bf16x8 cf[4];
#pragma unroll
        for (int kk = 0; kk < 4; ++kk) cf[kk] = mk8(cpre[which][kk]);
        const float acl = acs[lrow];
        f32x4 yacc[4];
#pragma unroll
        for (int pt = 0; pt < 4; ++pt) yacc[pt] = (f32x4){0.f, 0.f, 0.f, 0.f};
        const int nblk = (lt >> 1) + 1;
#pragma unroll 1
        for (int sb = 0; sb < nblk; ++sb) { const int s0 = 32 * sb;
            f32x4 T0 = {0.f, 0.f, 0.f, 0.f}, T1 = {0.f, 0.f, 0.f, 0.f};
#pragma unroll
            for (int kk = 0; kk < 4; ++kk) { const bf16x8 A0 = mk8(*(const LAS u32x4*)(Bm + (s0 + fr) * 136 + 32 * kk + 8 * gq)), A1 = mk8(*(const LAS u32x4*)(Bm + (s0 + 16 + fr) * 136 + 32 * kk + 8 * gq));
                T0 = MFMA16(A0, cf[kk], T0); T1 = MFMA16(A1, cf[kk], T1); }
            const f32x4 as0 = *(const LAS f32x4*)(acs + s0 + 4 * gq), as1 = *(const LAS f32x4*)(acs + s0 + 16 + 4 * gq);
            float pv[8];
#pragma unroll
            for (int r = 0; r < 4; ++r) { const int sa = s0 + 4 * gq + r; pv[r] = (sa <= lrow) ? T0[r] * fexp(acl - as0[r]) : 0.f; pv[4 + r] = (sa + 16 <= lrow) ? T1[r] * fexp(acl - as1[r]) : 0.f; }
            u32x4 pw; pw.x = pk2(pv[0], pv[1]); pw.y = pk2(pv[2], pv[3]); pw.z = pk2(pv[4], pv[5]); pw.w = pk2(pv[6], pv[7]);
            const bf16x8 P = mk8(pw);
#pragma unroll
            for (int pt = 0; pt < 4; ++pt) { const LAS bf16_t* xp = XT + (16 * pt + fr) * 264 + s0 + 4 * gq;
                const bf16x8 Af = mk8(*(const LAS u32x2*)xp, *(const LAS u32x2*)(xp + 16)); yacc[pt] = MFMA16(Af, P, yacc[pt]); } }
#pragma unroll
        for (int pt = 0; pt < 4; ++pt) { u32x2 w; w.x = pk2(yacc[pt].x, yacc[pt].y); w.y = pk2(yacc[pt].z, yacc[pt].w); *(u32x2*)(Y + row * 512 + h * 64 + 16 * pt + 4 * gq) = w; } }
    __syncthreads();
}
__device__ __forceinline__ void ssd_scan(const Args& a, int l, int gtid, int gthreads) {
    unsigned char* ws = a.ws; const float* ST = (const float*)(ws + WS_ST); bf16_t* HIN = (bf16_t*)(ws + WS_HIN); const float* CT = (const float*)(ws + WS_CT);
    for (int e = gtid; e < 2 * 8 * 8192; e += gthreads) { const int b = e >> 16, h = (e >> 13) & 7, pn = e & 8191; float hs = 0.f;
        const size_t o0 = ((size_t)(b * 32) * 8 + h) * 8192 + pn;
#pragma unroll 1
        for (int c0 = 0; c0 < 32; c0 += 16) { float st[16], dc[16];
#pragma unroll
            for (int c = 0; c < 16; ++c) { st[c] = ST[o0 + (size_t)(c0 + c) * 65536]; dc[c] = CT[(b * 32 + c0 + c) * 8 + h]; }
#pragma unroll
            for (int c = 0; c < 16; c += 8) { asm volatile("" : "+v"(st[c]), "+v"(st[c + 1]), "+v"(st[c + 2]), "+v"(st[c + 3]), "+v"(st[c + 4]), "+v"(st[c + 5]), "+v"(st[c + 6]), "+v"(st[c + 7]), "+v"(dc[c]), "+v"(dc[c + 1]), "+v"(dc[c + 2]), "+v"(dc[c + 3]), "+v"(dc[c + 4]), "+v"(dc[c + 5]), "+v"(dc[c + 6]), "+v"(dc[c + 7])); }
#pragma unroll
            for (int c = 0; c < 16; ++c) { HIN[o0 + (size_t)(c0 + c) * 65536] = (bf16_t)(pk2(hs, 0.f) & 0xffffu); hs = fmaf(hs, fexp(dc[c]), st[c]); } }
        a.out[O_HP + (size_t)l * 2 * 8 * 8192 + (size_t)(b * 8 + h) * 8192 + pn] = hs; }
}
__device__ __forceinline__ void ssdC_unit(const Args& a, int l, int unit, LAS unsigned char* lds, int tid) {
    unsigned char* ws = a.ws; const int lane = tid & 63, h = __builtin_amdgcn_readfirstlane(tid >> 6), fr = lane & 15, gq = lane >> 4, g = h >> 2;
    const int bc = unit >> 2; const size_t r0 = (size_t)bc * 256 + (unit & 3) * 64;
    const bf16_t* XC = (const bf16_t*)(ws + WS_XC); const bf16_t* ZS = (const bf16_t*)(ws + WS_ZS); const bf16_t* Y = (const bf16_t*)(ws + WS_Y); const float* ACUM = (const float*)(ws + WS_ACUM);
    const bf16_t* HIN = (const bf16_t*)(ws + WS_HIN) + ((size_t)bc * 8 + h) * 8192;
    LAS float* red = (LAS float*)lds;
    bf16x8 hf[4][4];
#pragma unroll
    for (int pt = 0; pt < 4; ++pt)
#pragma unroll
        for (int kk = 0; kk < 4; ++kk) hf[pt][kk] = mk8(*(const u32x4*)(HIN + (16 * pt + fr) * 128 + 32 * kk + 8 * gq));
    const float Dh = a.in[26][l * 8 + h];
    float pre = 0.f; { const float* tp = (const float*)(ws + WS_TOT) + (size_t)(bc * 4) * 8 + h; const int j = unit & 3; if (j > 0) pre += tp[0]; if (j > 1) pre += tp[8]; if (j > 2) pre += tp[16]; }
    f32x4 v[4][4];
#pragma unroll
    for (int lt = 0; lt < 4; ++lt) { const size_t row = r0 + 16 * lt + fr;
        u32x4 cw[4]; u32x2 yw[4], xw[4], zw[4]; float acv = ACUM[row * 8 + h];
#pragma unroll
        for (int kk = 0; kk < 4; ++kk) cw[kk] = *(const u32x4*)(XC + row * 1024 + 768 + g * 128 + 32 * kk + 8 * gq);
#pragma unroll
        for (int pt = 0; pt < 4; ++pt) { const int p0 = h * 64 + 16 * pt + 4 * gq; yw[pt] = *(const u32x2*)(Y + row * 512 + p0); xw[pt] = *(const u32x2*)(XC + row * 1024 + p0); zw[pt] = *(const u32x2*)(ZS + row * 512 + p0); }
        asm volatile("" : "+v"(cw[0]), "+v"(cw[1]), "+v"(cw[2]), "+v"(cw[3]), "+v"(yw[0]), "+v"(yw[1]), "+v"(yw[2]), "+v"(yw[3]), "+v"(xw[0]), "+v"(xw[1]), "+v"(xw[2]), "+v"(xw[3]), "+v"(zw[0]), "+v"(zw[1]), "+v"(zw[2]), "+v"(zw[3]), "+v"(acv));
        f32x4 yacc[4];
#pragma unroll
        for (int pt = 0; pt < 4; ++pt) { yacc[pt] = (f32x4){0.f, 0.f, 0.f, 0.f};
#pragma unroll
            for (int kk = 0; kk < 4; ++kk) yacc[pt] = MFMA16(hf[pt][kk], mk8(cw[kk]), yacc[pt]); }
        const float el = expf(acv + pre); float ss = 0.f;
#pragma unroll
        for (int pt = 0; pt < 4; ++pt) { const f32x4 yv = {bflo(yw[pt].x), bfhi(yw[pt].x), bflo(yw[pt].y), bfhi(yw[pt].y)};
            f32x4 t; t.x = (yacc[pt].x * el + yv.x + Dh * bflo(xw[pt].x)) * bflo(zw[pt].x); t.y = (yacc[pt].y * el + yv.y + Dh * bfhi(xw[pt].x)) * bfhi(zw[pt].x);
            t.z = (yacc[pt].z * el + yv.z + Dh * bflo(xw[pt].y)) * bflo(zw[pt].y); t.w = (yacc[pt].w * el + yv.w + Dh * bfhi(xw[pt].y)) * bfhi(zw[pt].y);
            v[lt][pt] = t; ss += (t.x * t.x + t.y * t.y) + (t.z * t.z + t.w * t.w); }
        ss += __shfl_xor(ss, 16); ss += __shfl_xor(ss, 32);
        if (gq == 0) red[h * 64 + 16 * lt + fr] = ss; }
    const float* gn = a.in[27] + l * 512; f32x4 ggp[4];
#pragma unroll
    for (int pt = 0; pt < 4; ++pt) ggp[pt] = *(const f32x4*)(gn + h * 64 + 16 * pt + 4 * gq);
    __syncthreads();
#pragma unroll
    for (int lt = 0; lt < 4; ++lt) { const int lr = 16 * lt + fr; const size_t row = r0 + lr; float tot = 0.f;
#pragma unroll
        for (int hh = 0; hh < 8; ++hh) tot += red[hh * 64 + lr];
        const float rs = rsqrtf(tot * (1.f / 512.f) + 1e-6f);
#pragma unroll
        for (int pt = 0; pt < 4; ++pt) { const int p0 = h * 64 + 16 * pt + 4 * gq; const f32x4 o = v[lt][pt] * rs * ggp[pt];
            u32x2 w; w.x = pk2(o.x, o.y); w.y = pk2(o.z, o.w); *(u32x2*)((bf16_t*)(ws + WS_MIX) + row * D + 512 + p0) = w; } }
    __syncthreads();
}

__device__ __forceinline__ void ssd_sample_unit(const Args& a, int l, int unit, int tid) {
    unsigned char* ws = a.ws; const int sb = unit >> 3, h = unit & 7, g = h >> 2, p = tid >> 3, nq = tid & 7; const size_t row = (size_t)MPR + sb;
    const bf16_t* xc = (const bf16_t*)(ws + WS_XC) + row * 1024; float dtv = ((const float*)(ws + WS_DT))[row * 8 + h]; float alog = a.in[25][l * 8 + h]; unsigned xraw = (unsigned)xc[h * 64 + p];
    const float* s = a.in[6] + (((size_t)l * 32 + sb) * 8 + h) * 8192 + p * 128 + 16 * nq; float* o = a.out + O_HS + (((size_t)l * 32 + sb) * 8 + h) * 8192 + p * 128 + 16 * nq;
    u32x4 b0 = *(const u32x4*)(xc + 512 + g * 128 + 16 * nq), b1 = *(const u32x4*)(xc + 512 + g * 128 + 16 * nq + 8), c0 = *(const u32x4*)(xc + 768 + g * 128 + 16 * nq), c1 = *(const u32x4*)(xc + 768 + g * 128 + 16 * nq + 8);
    f32x4 hvp[4];
#pragma unroll
    for (int q = 0; q < 4; ++q) hvp[q] = *(const f32x4*)(s + 4 * q);
    asm volatile("" : "+v"(dtv), "+v"(alog), "+v"(xraw), "+v"(b0), "+v"(b1), "+v"(c0), "+v"(c1), "+v"(hvp[0]), "+v"(hvp[1]), "+v"(hvp[2]), "+v"(hvp[3]));
    const float dA = expf(dtv * -expf(alog)), xd = dtv * __uint_as_float(xraw << 16);
    float Bv[16], Cv[16];
    Bv[0] = bflo(b0.x); Bv[1] = bfhi(b0.x); Bv[2] = bflo(b0.y); Bv[3] = bfhi(b0.y); Bv[4] = bflo(b0.z); Bv[5] = bfhi(b0.z); Bv[6] = bflo(b0.w); Bv[7] = bfhi(b0.w);
    Bv[8] = bflo(b1.x); Bv[9] = bfhi(b1.x); Bv[10] = bflo(b1.y); Bv[11] = bfhi(b1.y); Bv[12] = bflo(b1.z); Bv[13] = bfhi(b1.z); Bv[14] = bflo(b1.w); Bv[15] = bfhi(b1.w);
    Cv[0] = bflo(c0.x); Cv[1] = bfhi(c0.x); Cv[2] = bflo(c0.y); Cv[3] = bfhi(c0.y); Cv[4] = bflo(c0.z); Cv[5] = bfhi(c0.z); Cv[6] = bflo(c0.w); Cv[7] = bfhi(c0.w);
    Cv[8] = bflo(c1.x); Cv[9] = bfhi(c1.x); Cv[10] = bflo(c1.y); Cv[11] = bfhi(c1.y); Cv[12] = bflo(c1.z); Cv[13] = bfhi(c1.z); Cv[14] = bflo(c1.w); Cv[15] = bfhi(c1.w);
    float y = 0.f;
#pragma unroll
    for (int q = 0; q < 4; ++q) { const f32x4 hv = hvp[q]; f32x4 hn;
        hn.x = fmaf(hv.x, dA, xd * Bv[4 * q]); hn.y = fmaf(hv.y, dA, xd * Bv[4 * q + 1]); hn.z = fmaf(hv.z, dA, xd * Bv[4 * q + 2]); hn.w = fmaf(hv.w, dA, xd * Bv[4 * q + 3]);
        *(f32x4*)(o + 4 * q) = hn; y += (Cv[4 * q] * hn.x + Cv[4 * q + 1] * hn.y) + (Cv[4 * q + 2] * hn.z + Cv[4 * q + 3] * hn.w); }
    y += __shfl_xor(y, 1); y += __shfl_xor(y, 2); y += __shfl_xor(y, 4);
    if (nq == 0) ((bf16_t*)(ws + WS_Y))[row * 512 + h * 64 + p] = (bf16_t)(pk2(y, 0.f) & 0xffffu);
}

__device__ __forceinline__ void skinny_unit(const bf16_t* __restrict__ A  , const bf16_t* __restrict__ Bt  , int K, int u, const float* xold  ,
                                            bf16_t* XB, float* SSQ, float alpha, LAS unsigned char* lds, int tid, const float* nssq = nullptr, const float* gsc = nullptr, float* SSQG = nullptr) {
    const int lane = tid & 63, wave = __builtin_amdgcn_readfirstlane(tid >> 6), fr = lane & 15, gq = lane >> 4;
    const int kw = K >> 3, nks = kw >> 5;
    const bf16_t* a0 = A + (size_t)fr * K + wave * kw + 8 * gq; const bf16_t* a1 = a0 + (size_t)16 * K; const bf16_t* bp = Bt + (size_t)(64 * u + fr) * K + wave * kw + 8 * gq;
    f32x4 acc[2][4];
#pragma unroll
    for (int rt = 0; rt < 2; ++rt)
#pragma unroll
        for (int ct = 0; ct < 4; ++ct) acc[rt][ct] = (f32x4){0.f, 0.f, 0.f, 0.f};
#pragma unroll 1
    for (int k0 = 0; k0 < nks; k0 += 4) {
        u32x4 xa[4][2], wb[4][4];
#pragma unroll
        for (int q = 0; q < 4; ++q) { const int ks = (k0 + q < nks) ? k0 + q : nks - 1;
            xa[q][0] = *(const u32x4*)(a0 + 32 * ks); xa[q][1] = *(const u32x4*)(a1 + 32 * ks);
#pragma unroll
            for (int ct = 0; ct < 4; ++ct) wb[q][ct] = *(const u32x4*)(bp + (size_t)(16 * ct) * K + 32 * ks); }
#pragma unroll
        for (int q = 0; q < 4; ++q) { asm volatile("" : "+v"(xa[q][0]), "+v"(xa[q][1]), "+v"(wb[q][0]), "+v"(wb[q][1]), "+v"(wb[q][2]), "+v"(wb[q][3])); }
#pragma unroll
        for (int q = 0; q < 4; ++q) if (k0 + q < nks) {
#pragma unroll
            for (int ct = 0; ct < 4; ++ct) { acc[0][ct] = MFMA16(mk8(wb[q][ct]), mk8(xa[q][0]), acc[0][ct]); acc[1][ct] = MFMA16(mk8(wb[q][ct]), mk8(xa[q][1]), acc[1][ct]); } }
    }
    LAS float* red = (LAS float*)lds;
#pragma unroll
    for (int rt = 0; rt < 2; ++rt)
#pragma unroll
        for (int ct = 0; ct < 4; ++ct) *(LAS f32x4*)(red + ((wave * 32 + 16 * rt + fr) * 64 + 16 * ct + 4 * gq)) = acc[rt][ct];
    __syncthreads();
    { const int row = tid >> 4, c4 = (tid & 15) * 4; f32x4 v = {0.f, 0.f, 0.f, 0.f};
#pragma unroll
      for (int w = 0; w < 8; ++w) v += *(const LAS f32x4*)(red + ((w * 32 + row) * 64 + c4));
      const size_t o = (size_t)row * D + 64 * u + c4; f32x4 xo;
      if (xold) xo = *(const f32x4*)(xold + o);
      else { const u32x2 w = *(const u32x2*)(XB + o); xo = (f32x4){bflo(w.x), bfhi(w.x), bflo(w.y), bfhi(w.y)}; if (nssq) xo = xo * rstd16(nssq + (size_t)row * 16); }
      const f32x4 xn = xo + alpha * v;
      f32x4 xb = xn; if (gsc) xb = xn * *(const f32x4*)(gsc + 64 * u + c4);
      u32x2 w2; w2.x = pk2(xb.x, xb.y); w2.y = pk2(xb.z, xb.w); *(u32x2*)(XB + o) = w2;
      float ss = (xn.x * xn.x + xn.y * xn.y) + (xn.z * xn.z + xn.w * xn.w), sg = (xb.x * xb.x + xb.y * xb.y) + (xb.z * xb.z + xb.w * xb.w);
      ss += __shfl_xor(ss, 1); ss += __shfl_xor(ss, 2); ss += __shfl_xor(ss, 4); ss += __shfl_xor(ss, 8);
      sg += __shfl_xor(sg, 1); sg += __shfl_xor(sg, 2); sg += __shfl_xor(sg, 4); sg += __shfl_xor(sg, 8);
      if ((tid & 15) == 0) { SSQ[(size_t)row * 16 + u] = ss; if (gsc) SSQG[(size_t)row * 16 + u] = sg; } }
    __syncthreads();
}
__device__ __forceinline__ void sel_unit(const Args& a, int unit, LAS unsigned char* lds, int tid) {
    unsigned char* ws = a.ws; const int hp = unit & 1, cur = (unit >> 1) & 31, b = unit >> 6, r = tid & 255, hh = tid >> 8, h = 2 * hp + hh;
    const size_t m = (size_t)b * SEQ + cur * 256 + r;
    LAS float* km = (LAS float*)lds;
    const float* KMP = (const float*)(ws + WS_KMP) + (size_t)b * 32 * 256 + hp * 128;
    for (int i = tid; i < cur * 32; i += NTHR) { const int n = i >> 5, c4 = i & 31; *(LAS f32x4*)(km + n * 128 + 4 * c4) = *(const f32x4*)(KMP + n * 256 + 4 * c4); }
    float q[64];
    { const bf16_t* qp = (const bf16_t*)(ws + WS_QB) + m * 256 + h * 64;
#pragma unroll
      for (int j = 0; j < 8; ++j) { const u32x4 w = *(const u32x4*)(qp + 8 * j); q[8 * j] = bflo(w.x); q[8 * j + 1] = bfhi(w.x); q[8 * j + 2] = bflo(w.y); q[8 * j + 3] = bfhi(w.y); q[8 * j + 4] = bflo(w.z); q[8 * j + 5] = bfhi(w.z); q[8 * j + 6] = bflo(w.w); q[8 * j + 7] = bfhi(w.w); } }
    __syncthreads();
    float v0 = -INFINITY, v1 = -INFINITY, v2 = -INFINITY; int i0 = 0, i1 = 0, i2 = 0;
    for (int n = 0; n < cur; ++n) { const LAS float* kp = km + n * 128 + hh * 64; float g0 = 0.f, g1 = 0.f;
#pragma unroll
        for (int j = 0; j < 16; j += 2) { const f32x4 ka = *(const LAS f32x4*)(kp + 4 * j), kb = *(const LAS f32x4*)(kp + 4 * j + 4);
            g0 = fmaf(q[4 * j], ka.x, g0); g0 = fmaf(q[4 * j + 1], ka.y, g0); g0 = fmaf(q[4 * j + 2], ka.z, g0); g0 = fmaf(q[4 * j + 3], ka.w, g0);
            g1 = fmaf(q[4 * j + 4], kb.x, g1); g1 = fmaf(q[4 * j + 5], kb.y, g1); g1 = fmaf(q[4 * j + 6], kb.z, g1); g1 = fmaf(q[4 * j + 7], kb.w, g1); }
        const float gv = g0 + g1;
        if (gv > v0) { v2 = v1; i2 = i1; v1 = v0; i1 = i0; v0 = gv; i0 = n; } else if (gv > v1) { v2 = v1; i2 = i1; v1 = gv; i1 = n; } else if (gv > v2) { v2 = gv; i2 = n; } }
    const int cnt = cur < 3 ? cur : 3;
    ((unsigned*)(ws + WS_SEL))[m * 4 + h] = (unsigned)i0 | ((unsigned)i1 << 8) | ((unsigned)i2 << 16) | ((unsigned)cnt << 24);
    __syncthreads();
}
__device__ const unsigned ATT_TAB[32][2] = {{1049861u,0u},{1968650u,0u},{1705730u,0u},{1771785u,0u},{1180929u,0u},{852996u,0u},{1574920u,0u},{918528u,0u},{2099979u,0u},{1378055u,0u},{262144u,0u},{656131u,0u},{1181190u,0u},{459266u,0u},{2100236u,0u},{327937u,0u},{2099715u,0u},{2100493u,0u},{2100750u,2104842u},{2101007u,2104073u},{2101264u,2103810u},{2100484u,2103304u},{2101521u,2105119u},{2101778u,2104862u},{2100736u,2104605u},{2102035u,2102535u},{2102292u,2104348u},{2102549u,2104091u},{2101253u,2103834u},{2102806u,2103577u},{2103063u,2103320u},{2101761u,2101766u}};
constexpr int AT_KM = 0, AT_VT = 36864, AT_BT = AT_VT + 33792, AT_QL = AT_BT + 1024, AT_WC = AT_QL + 16384, AT_NC = 8;
__device__ __forceinline__ void attn_slot(const Args& a, int sidx, LAS unsigned char* lds, int tid) {
    unsigned char* ws = a.ws; const int lane = tid & 63, wave = __builtin_amdgcn_readfirstlane(tid >> 6), fr = lane & 15, gq = lane >> 4;
    const int bh = sidx & 7, b = bh >> 2, h = bh & 3, slot_i = sidx >> 3;
    LAS bf16_t* Km = (LAS bf16_t*)(lds + AT_KM); LAS bf16_t* VT = (LAS bf16_t*)(lds + AT_VT); LAS float* BTs = (LAS float*)(lds + AT_BT); LAS unsigned* ql = (LAS unsigned*)(lds + AT_QL); LAS int* wc = (LAS int*)(lds + AT_WC);
    const bf16_t* KB = (const bf16_t*)(ws + WS_KB); const bf16_t* VB = (const bf16_t*)(ws + WS_VB); const bf16_t* QB = (const bf16_t*)(ws + WS_QB);
    if (tid < 129) BTs[tid] = ((const float*)(ws + WS_BT))[h * 129 + tid];
#pragma unroll 1
    for (int it = 0; it < 2; ++it) { const unsigned tw = ATT_TAB[slot_i][it]; const int n = (int)(tw & 255u), lo = (int)((tw >> 8) & 255u), hi = (int)(tw >> 16);
      if (hi <= lo) continue;
      const size_t kr0 = (size_t)b * SEQ + n * 256;
      u32x4 kst[4], vst[4];
#pragma unroll
      for (int pass = 0; pass < 4; ++pass) { kst[pass] = *(const u32x4*)(KB + (kr0 + pass * 64 + (tid >> 3)) * 256 + h * 64 + 8 * (tid & 7)); vst[pass] = *(const u32x4*)(VB + (kr0 + pass * 64 + lane) * 256 + h * 64 + 8 * wave); }
      asm volatile("" : "+v"(kst[0]), "+v"(kst[1]), "+v"(kst[2]), "+v"(kst[3]), "+v"(vst[0]), "+v"(vst[1]), "+v"(vst[2]), "+v"(vst[3]));
#pragma unroll
      for (int pass = 0; pass < 4; ++pass) { const int key = pass * 64 + (tid >> 3), ch = tid & 7; *(LAS u32x4*)(Km + key * 72 + 8 * ch) = kst[pass]; }
#pragma unroll
      for (int pass = 0; pass < 4; ++pass) { const int key = pass * 64 + lane; const u32x4 v = vst[pass];
          LAS bf16_t* vp = VT + (8 * wave) * 264 + key;
          vp[0] = (bf16_t)(v.x & 0xffffu); vp[264] = (bf16_t)(v.x >> 16); vp[2 * 264] = (bf16_t)(v.y & 0xffffu); vp[3 * 264] = (bf16_t)(v.y >> 16);
          vp[4 * 264] = (bf16_t)(v.z & 0xffffu); vp[5 * 264] = (bf16_t)(v.z >> 16); vp[6 * 264] = (bf16_t)(v.w & 0xffffu); vp[7 * 264] = (bf16_t)(v.w >> 16); }
#pragma unroll 1
      for (int c0 = lo * 256; c0 < hi * 256; c0 += 512 * AT_NC) {
        bool hit[AT_NC]; unsigned ent[AT_NC], sv[AT_NC];
#pragma unroll
        for (int k = 0; k < AT_NC; ++k) { const int t = c0 + 512 * k + tid; sv[k] = 0u; if (t < hi * 256 && (t >> 8) != n) sv[k] = ((const unsigned*)(ws + WS_SEL))[((size_t)b * SEQ + t) * 4 + h]; }
        asm volatile("" : "+v"(sv[0]), "+v"(sv[1]), "+v"(sv[2]), "+v"(sv[3]), "+v"(sv[4]), "+v"(sv[5]), "+v"(sv[6]), "+v"(sv[7]));
#pragma unroll
        for (int k = 0; k < AT_NC; ++k) { const int t = c0 + 512 * k + tid; hit[k] = false; ent[k] = 0u;
            if (t < hi * 256) { const int cb = t >> 8;
                if (cb == n) { hit[k] = true; ent[k] = (unsigned)t | (3u << 16); }
                else { const unsigned s = sv[k]; const unsigned cnt = s >> 24;
                    if (cnt > 0 && (s & 255u) == (unsigned)n) { hit[k] = true; ent[k] = (unsigned)t; } else if (cnt > 1 && ((s >> 8) & 255u) == (unsigned)n) { hit[k] = true; ent[k] = (unsigned)t | (1u << 16); } else if (cnt > 2 && ((s >> 16) & 255u) == (unsigned)n) { hit[k] = true; ent[k] = (unsigned)t | (2u << 16); } } } }
        unsigned long long bal[AT_NC]; const unsigned long long below = (1ull << lane) - 1ull;
#pragma unroll
        for (int k = 0; k < AT_NC; ++k) { bal[k] = __ballot(hit[k]); if (lane == 0) wc[8 * k + wave] = __popcll(bal[k]); }
        __syncthreads();
        int run = 0, mine[AT_NC];
#pragma unroll
        for (int w = 0; w < 8 * AT_NC; ++w) { if ((w & 7) == wave) mine[w >> 3] = run; run += wc[w]; }
        const int tot = run;
#pragma unroll
        for (int k = 0; k < AT_NC; ++k) if (hit[k]) ql[mine[k] + __popcll(bal[k] & below)] = ent[k];
        const int nq = tot; __syncthreads();
#ifndef AT_RT
#define AT_RT 1
#endif
        for (int rrt_ = 0; rrt_ < AT_RT; ++rrt_) {
        const float bfar = BTs[128];
        unsigned e_n = 0u; u32x4 qn0 = {0u, 0u, 0u, 0u}, qn1 = {0u, 0u, 0u, 0u};
        if (wave * 16 < nq) { const int qi = 16 * wave + fr; e_n = ql[qi < nq ? qi : 16 * wave]; const bf16_t* qp = QB + ((size_t)b * SEQ + (e_n & 0xffffu)) * 256 + h * 64 + 8 * gq; qn0 = *(const u32x4*)qp; qn1 = *(const u32x4*)(qp + 32); }
        for (int ti = wave; ti * 16 < nq; ti += NWAVES) { const int qi = 16 * ti + fr; const bool valid = qi < nq; const unsigned e = e_n; const int t = (int)(e & 0xffffu), slot = (int)(e >> 16);
            const size_t qrow = (size_t)b * SEQ + t;
            const bf16x8 qf0 = mk8(qn0), qf1 = mk8(qn1);
            if ((ti + NWAVES) * 16 < nq) { const int q2 = 16 * (ti + NWAVES) + fr; e_n = ql[q2 < nq ? q2 : 16 * (ti + NWAVES)]; const bf16_t* qp = QB + ((size_t)b * SEQ + (e_n & 0xffffu)) * 256 + h * 64 + 8 * gq; qn0 = *(const u32x4*)qp; qn1 = *(const u32x4*)(qp + 32); }
            const int need = (slot == 3) ? (((t - n * 256) >> 6) + 1) : 4;
            const int ng = 1 + (__any(need >= 2) ? 1 : 0) + (__any(need >= 3) ? 1 : 0) + (__any(need >= 4) ? 1 : 0);
            f32x4 T[16];
#pragma unroll
            for (int g = 0; g < 4; ++g) {
                if (g < ng) {
#pragma unroll
                    for (int k4 = 0; k4 < 4; ++k4) { const int kt = 4 * g + k4; const LAS bf16_t* kp = Km + (16 * kt + fr) * 72 + 8 * gq; f32x4 acc = {0.f, 0.f, 0.f, 0.f};
                        acc = MFMA16(mk8(*(const LAS u32x4*)kp), qf0, acc); acc = MFMA16(mk8(*(const LAS u32x4*)(kp + 32)), qf1, acc); T[kt] = acc; }
                } else {
#pragma unroll
                    for (int k4 = 0; k4 < 4; ++k4) T[4 * g + k4] = (f32x4){-INFINITY, -INFINITY, -INFINITY, -INFINITY};
                } }
            const int dmin = t - (n * 256 + 255);
            float mx = -INFINITY;
            float mxadd = 0.f;
            if (__all(dmin >= 128)) {
                mxadd = bfar;
#pragma unroll
                for (int kt = 0; kt < 16; ++kt)
#pragma unroll
                    for (int r = 0; r < 4; ++r) mx = fmaxf(mx, T[kt][r]);
            } else {
                const int dbase = dmin + 255 - 4 * gq;
#pragma unroll
                for (int g = 0; g < 4; ++g) if (g < ng) {
#pragma unroll
                    for (int k4 = 0; k4 < 4; ++k4)
#pragma unroll
                        for (int r = 0; r < 4; ++r) { const int kt = 4 * g + k4; int di = dbase - (16 * kt + r); di = di < 0 ? 0 : (di > 128 ? 128 : di); T[kt][r] += BTs[di]; }
#pragma unroll
                    for (int k4 = 0; k4 < 4; ++k4)
#pragma unroll
                        for (int r = 0; r < 4; ++r) { const int kt = 4 * g + k4; const float x = (dbase - (16 * kt + r) >= 0) ? T[kt][r] : -INFINITY; T[kt][r] = x; mx = fmaxf(mx, x); }
                }
            }
            mx = fmaxf(mx, __shfl_xor(mx, 16)); mx = fmaxf(mx, __shfl_xor(mx, 32));
            f32x4 ls4 = {0.f, 0.f, 0.f, 0.f}; const f32x4 mx4 = {mx, mx, mx, mx};
#pragma unroll
            for (int g = 0; g < 4; ++g) {
                if (g < ng) {
#pragma unroll
                    for (int k4 = 0; k4 < 4; ++k4) { const int kt = 4 * g + k4; const f32x4 d = T[kt] - mx4;
                        const f32x4 p = {__builtin_amdgcn_exp2f(d.x), __builtin_amdgcn_exp2f(d.y), __builtin_amdgcn_exp2f(d.z), __builtin_amdgcn_exp2f(d.w)}; T[kt] = p; ls4 += p; }
                } }
            float ls = (ls4.x + ls4.y) + (ls4.z + ls4.w);
            ls += __shfl_xor(ls, 16); ls += __shfl_xor(ls, 32);
            f32x4 O[4];
#pragma unroll
            for (int dt = 0; dt < 4; ++dt) O[dt] = (f32x4){0.f, 0.f, 0.f, 0.f};
            const LAS bf16_t* vlo = VT + fr * 264 + 4 * gq; const LAS bf16_t* vhi = vlo + 16; asm volatile("" : "+v"(vhi));
#pragma unroll
            for (int g = 0; g < 4; ++g) if (g < ng) {
#pragma unroll
                for (int k2 = 0; k2 < 2; ++k2) { const int ks = 2 * g + k2; u32x4 pw; pw.x = pk2(T[2 * ks][0], T[2 * ks][1]); pw.y = pk2(T[2 * ks][2], T[2 * ks][3]); pw.z = pk2(T[2 * ks + 1][0], T[2 * ks + 1][1]); pw.w = pk2(T[2 * ks + 1][2], T[2 * ks + 1][3]);
                    const bf16x8 P = mk8(pw);
#pragma unroll
                    for (int dt = 0; dt < 4; ++dt) O[dt] = MFMA16(mk8(*(const LAS u32x2*)(vlo + (16 * dt) * 264 + 32 * ks), *(const LAS u32x2*)(vhi + (16 * dt) * 264 + 32 * ks)), P, O[dt]); }
            }
            if (valid && (AT_RT == 1 || rrt_ == 0)) { unsigned char* pp = ws + WS_PART + ((qrow * 4 + h) * 4 + slot) * 144;
#pragma unroll
                for (int dt = 0; dt < 4; ++dt) { u32x2 w; w.x = pk2(O[dt].x, O[dt].y); w.y = pk2(O[dt].z, O[dt].w); *(u32x2*)(pp + (16 * dt + 4 * gq) * 2) = w; }
                if (gq == 0) *(f32x2*)(pp + 128) = (f32x2){mx + mxadd, ls}; }
        }
        }
        __syncthreads();
      }
    }
}
__device__ __forceinline__ void attn_combine(const Args& a, int idx) {
    unsigned char* ws = a.ws; const int pair = idx >> 2, qd = idx & 3; const size_t row = (size_t)(pair >> 2); const int h = pair & 3;
    const unsigned s = ((const unsigned*)(ws + WS_SEL))[row * 4 + h]; const int cnt = (int)(s >> 24);
    const unsigned char* pp = ws + WS_PART + (row * 4 + h) * 4 * 144;
    f32x2 ml[4]; u32x4 ov[4][2];
#pragma unroll
    for (int j = 0; j < 4; ++j) { ml[j] = *(const f32x2*)(pp + j * 144 + 128); ov[j][0] = *(const u32x4*)(pp + j * 144 + 32 * qd); ov[j][1] = *(const u32x4*)(pp + j * 144 + 32 * qd + 16); }
    float M = ml[3].x;
#pragma unroll
    for (int j = 0; j < 3; ++j) M = (j < cnt) ? fmaxf(M, ml[j].x) : M;
    float den = 0.f, num[16];
#pragma unroll
    for (int e = 0; e < 16; ++e) num[e] = 0.f;
#pragma unroll
    for (int j = 0; j < 4; ++j) { const bool on = (j == 3) || (j < cnt); const float w = on ? __builtin_amdgcn_exp2f(ml[j].x - M) : 0.f; den += on ? w * ml[j].y : 0.f;
#pragma unroll
        for (int q = 0; q < 2; ++q) { const u32x4 t = on ? ov[j][q] : (u32x4){0u, 0u, 0u, 0u};
            num[8 * q + 0] = fmaf(w, bflo(t.x), num[8 * q + 0]); num[8 * q + 1] = fmaf(w, bfhi(t.x), num[8 * q + 1]); num[8 * q + 2] = fmaf(w, bflo(t.y), num[8 * q + 2]); num[8 * q + 3] = fmaf(w, bfhi(t.y), num[8 * q + 3]);
            num[8 * q + 4] = fmaf(w, bflo(t.z), num[8 * q + 4]); num[8 * q + 5] = fmaf(w, bfhi(t.z), num[8 * q + 5]); num[8 * q + 6] = fmaf(w, bflo(t.w), num[8 * q + 6]); num[8 * q + 7] = fmaf(w, bfhi(t.w), num[8 * q + 7]); } }
    const float inv = 1.f / den; u32x4 w0, w1;
    w0.x = pk2(num[0] * inv, num[1] * inv); w0.y = pk2(num[2] * inv, num[3] * inv); w0.z = pk2(num[4] * inv, num[5] * inv); w0.w = pk2(num[6] * inv, num[7] * inv);
    w1.x = pk2(num[8] * inv, num[9] * inv); w1.y = pk2(num[10] * inv, num[11] * inv); w1.z = pk2(num[12] * inv, num[13] * inv); w1.w = pk2(num[14] * inv, num[15] * inv);
    bf16_t* dst = (bf16_t*)(ws + WS_MIX) + row * D + 256 + h * 64 + 16 * qd; *(u32x4*)dst = w0; *(u32x4*)(dst + 8) = w1;
}
__device__ __forceinline__ void attn_sample_unit(const Args& a, int l, int unit, LAS unsigned char* lds, int tid) {
    unsigned char* ws = a.ws; const int lane = tid & 63, wave = __builtin_amdgcn_readfirstlane(tid >> 6), sb = unit >> 2, h = unit & 3; const size_t m = (size_t)MPR + sb;
    const float* KMS = (const float*)(ws + WS_KMS) + ((size_t)l * 1024 + sb * 32) * 256 + h * 64; const float* BT = (const float*)(ws + WS_BT) + h * 129;
    const float* ck = a.in[2] + (size_t)l * CACHE_L; const float* cv = a.in[3] + (size_t)l * CACHE_L; const int* pt = (const int*)a.in[7] + sb * NPAGES;
    LAS float* gate = (LAS float*)lds; LAS float* lg = gate + 64; LAS float* red = lg + 832; LAS float* osum = red + 16; LAS float* bts = osum + 512;
    float btv = BT[tid < 129 ? tid : 0]; unsigned qraw = (unsigned)((const bf16_t*)(ws + WS_QB))[m * 256 + h * 64 + lane]; float kmv[4]; int ptv = pt[lane];
#pragma unroll
    for (int i = 0; i < 4; ++i) kmv[i] = KMS[(size_t)(4 * wave + i) * 256 + lane];
    asm volatile("" : "+v"(btv), "+v"(qraw), "+v"(kmv[0]), "+v"(kmv[1]), "+v"(kmv[2]), "+v"(kmv[3]), "+v"(ptv));
    LAS int* pts = (LAS int*)(bts + 132);
    if (tid < 129) bts[tid] = btv;
    if (tid < 64) pts[tid] = ptv;
    const float qd = __uint_as_float(qraw << 16);
#pragma unroll
    for (int i = 0; i < 4; ++i) { const int n = 4 * wave + i; const float g = wsum(qd * kmv[i]); if (lane == 0) gate[n] = g; }
    __syncthreads();
    int i0 = 0, i1 = 0, i2 = 0; { float v0 = -INFINITY, v1 = -INFINITY, v2 = -INFINITY;
      for (int n = 0; n < 32; ++n) { const float gv = gate[n]; if (gv > v0) { v2 = v1; i2 = i1; v1 = v0; i1 = i0; v0 = gv; i0 = n; } else if (gv > v1) { v2 = v1; i2 = i1; v1 = gv; i1 = n; } else if (gv > v2) { v2 = gv; i2 = n; } } }
    const size_t pg0 = (size_t)pts[2 * i0] * 128, pg1 = (size_t)pts[2 * i0 + 1] * 128, pg2 = (size_t)pts[2 * i1] * 128, pg3 = (size_t)pts[2 * i1 + 1] * 128, pg4 = (size_t)pts[2 * i2] * 128, pg5 = (size_t)pts[2 * i2 + 1] * 128;
    const int kq = lane >> 4, dq = lane & 15; const f32x4 q4 = {__shfl(qd, 4 * dq), __shfl(qd, 4 * dq + 1), __shfl(qd, 4 * dq + 2), __shfl(qd, 4 * dq + 3)};
    f32x4 kv[24];
#pragma unroll
    for (int st = 0; st < 24; ++st) { const int kl = 32 * st + 4 * wave + kq, pi = st >> 2; const size_t pg = pi == 0 ? pg0 : pi == 1 ? pg1 : pi == 2 ? pg2 : pi == 3 ? pg3 : pi == 4 ? pg4 : pg5;
        kv[st] = *(const f32x4*)(ck + (pg + (kl & 127)) * 256 + h * 64 + 4 * dq); }
    float vv0[3][16], vv1[3][16];
#pragma unroll
    for (int q = 0; q < 3; ++q) { const size_t pg = q == 0 ? pg0 : q == 1 ? pg1 : pg2; const float* vb = cv + pg * 256 + h * 64 + lane;
#pragma unroll
        for (int i = 0; i < 16; ++i) vv0[q][i] = vb[(size_t)(wave + 8 * i) * 256]; }
#pragma unroll
    for (int st = 0; st < 24; ++st) { const int kl = 32 * st + 4 * wave + kq, j = st >> 3, blk = j == 0 ? i0 : (j == 1 ? i1 : i2), kpos = blk * 256 + (kl & 255);
        float d = (q4.x * kv[st].x + q4.y * kv[st].y) + (q4.z * kv[st].z + q4.w * kv[st].w);
        d += __shfl_xor(d, 1); d += __shfl_xor(d, 2); d += __shfl_xor(d, 4); d += __shfl_xor(d, 8);
        const int dist = 8192 - kpos; if (dq == 0) lg[kl] = d + bts[dist < 128 ? dist : 128]; }
    if (wave == 0) { const float d = wsum(qd * bf1(((const bf16_t*)(ws + WS_KB))[m * 256 + h * 64 + lane])); if (lane == 0) lg[768] = d + bts[0]; }
#pragma unroll
    for (int q = 0; q < 3; ++q) { const size_t pg = q == 0 ? pg3 : q == 1 ? pg4 : pg5; const float* vb = cv + pg * 256 + h * 64 + lane;
#pragma unroll
        for (int i = 0; i < 16; ++i) vv1[q][i] = vb[(size_t)(wave + 8 * i) * 256]; }
    __syncthreads();
    float mx = -INFINITY; for (int i = tid; i < 769; i += NTHR) mx = fmaxf(mx, lg[i]);
#pragma unroll
    for (int o = 1; o < 64; o <<= 1) mx = fmaxf(mx, __shfl_xor(mx, o));
    if (lane == 0) red[wave] = mx;
    __syncthreads();
    mx = red[0];
#pragma unroll
    for (int w = 1; w < 8; ++w) mx = fmaxf(mx, red[w]);
    float ps = 0.f; for (int i = tid; i < 769; i += NTHR) { const float p = __builtin_amdgcn_exp2f(lg[i] - mx); lg[i] = p; ps += p; }
    ps = wsum(ps); if (lane == 0) red[8 + wave] = ps;
    __syncthreads();
    float tot = 0.f;
#pragma unroll
    for (int w = 0; w < 8; ++w) tot += red[8 + w];
    float acc = 0.f;
#pragma unroll
    for (int q = 0; q < 3; ++q) asm volatile("" : "+v"(vv0[q][0]), "+v"(vv0[q][1]), "+v"(vv0[q][2]), "+v"(vv0[q][3]), "+v"(vv0[q][4]), "+v"(vv0[q][5]), "+v"(vv0[q][6]), "+v"(vv0[q][7]), "+v"(vv0[q][8]), "+v"(vv0[q][9]), "+v"(vv0[q][10]), "+v"(vv0[q][11]), "+v"(vv0[q][12]), "+v"(vv0[q][13]), "+v"(vv0[q][14]), "+v"(vv0[q][15]));
#pragma unroll
    for (int q = 0; q < 3; ++q)
#pragma unroll
        for (int i = 0; i < 16; ++i) acc = fmaf(lg[128 * q + wave + 8 * i], vv0[q][i], acc);
#pragma unroll
    for (int q = 0; q < 3; ++q) asm volatile("" : "+v"(vv1[q][0]), "+v"(vv1[q][1]), "+v"(vv1[q][2]), "+v"(vv1[q][3]), "+v"(vv1[q][4]), "+v"(vv1[q][5]), "+v"(vv1[q][6]), "+v"(vv1[q][7]), "+v"(vv1[q][8]), "+v"(vv1[q][9]), "+v"(vv1[q][10]), "+v"(vv1[q][11]), "+v"(vv1[q][12]), "+v"(vv1[q][13]), "+v"(vv1[q][14]), "+v"(vv1[q][15]));
#pragma unroll
    for (int q = 0; q < 3; ++q)
#pragma unroll
        for (int i = 0; i < 16; ++i) acc = fmaf(lg[128 * (3 + q) + wave + 8 * i], vv1[q][i], acc);
    if (wave == 0) acc = fmaf(lg[768], bf1(((const bf16_t*)(ws + WS_VB))[m * 256 + h * 64 + lane]), acc);
    osum[wave * 64 + lane] = acc;
    __syncthreads();
    if (tid < 64) { float o = 0.f;
#pragma unroll
        for (int w = 0; w < 8; ++w) o += osum[w * 64 + tid];
        ((bf16_t*)(ws + WS_MIX))[m * D + 256 + h * 64 + tid] = (bf16_t)(pk2(o / tot, 0.f) & 0xffffu); }
    __syncthreads();
}

__device__ __forceinline__ void kms_unit(const Args& args, unsigned char* ws, int v, LAS unsigned char* lds, int tid) {
    const int* pt = (const int*)args.in[7]; const int l = v >> 10, r = v & 1023, sb = r >> 5, n = r & 31;
    const float* ck = args.in[2] + (size_t)l * CACHE_L;
    colmean_unit(ck + (size_t)pt[sb * NPAGES + 2 * n] * 128 * 256, ck + (size_t)pt[sb * NPAGES + 2 * n + 1] * 128 * 256, (float*)(ws + WS_KMS) + (size_t)v * 256, (LAS float*)(lds + RING_BYTES), tid);
}
#ifndef KMS_GU
#define KMS_GU 4
#endif
#ifndef KMS_WIN
#define KMS_WIN 4
#endif
constexpr int GU_UNITS = 65 * 22, WIN_UNITS = 65 * 11;
__device__ __forceinline__ void kms_tail(const Args& args, unsigned char* ws, int G, int nunits, int per, int vbase, int vlimit, LAS unsigned char* lds, int tid) {
    const int first_idle = nunits % G; if (first_idle == 0 || (int)blockIdx.x < first_idle) return;
    for (int i = 0; i < per; ++i) { const int v = vbase + ((int)blockIdx.x - first_idle) * per + i; if (v < vlimit) kms_unit(args, ws, v, lds, tid); }
}
#define KM_MIN(a, b) ((a) < (b) ? (a) : (b))
#define KM_SPLIT(G) const int km_gu_ = ((GU_UNITS % (G)) ? (G) - GU_UNITS % (G) : 0) * KMS_GU, km_win_ = ((WIN_UNITS % (G)) ? (G) - WIN_UNITS % (G) : 0) * KMS_WIN; \
    const int KM_A0 = KM_MIN(km_gu_, 1024), KM_A1 = KM_MIN(km_gu_ + km_win_, 1024), KM_B0 = KM_MIN(km_gu_, 1024), KM_B1 = KM_MIN(2 * km_gu_, 1024), KM_B2 = KM_MIN(2 * km_gu_ + km_win_, 1024); (void)KM_A0; (void)KM_A1; (void)KM_B0; (void)KM_B1; (void)KM_B2;
constexpr int N_PHASES = 23;
#ifndef MK_CUTS
#define MK_CUTS 0
#endif
__global__ void __launch_bounds__(NTHR, 2) mk_fwd(Args args) {
    extern __shared__ __attribute__((aligned(16))) unsigned char lds_raw[];
    LAS unsigned char* lds = (LAS unsigned char*)lds_raw;
    const int tid0 = threadIdx.x; const int wave0 = __builtin_amdgcn_readfirstlane(tid0 >> 6);
    volatile LAS unsigned* MISC = (volatile LAS unsigned*)(lds + MISC_OFF);
    if (tid0 < 64) MISC[tid0] = 0u;
    __syncthreads();
    unsigned char* ws0 = args.ws;
    unsigned* ctl = (unsigned*)(ws0 + WS_CTL);
    XcdBarrier bar = xcd_barrier_post(ctl + CW_BAR + args.li * XCD_BAR_WORDS, MISC + 8);
    const int G0 = gridDim.x;
    const int lo = args.ph_lo, hi = args.ph_hi; (void)lo; (void)hi;
#ifndef MK_DUP
#define MK_DUP 0
#endif
#ifndef MK_DUPX
#define MK_DUPX 0
#endif
#define XR(b) for (int rr_ = 0; rr_ < ((((MK_DUPX) >> (b)) & 1) ? 2 : 1); ++rr_)
#define NREP(t) (((MK_DUP) >> (t)) & 1 ? 2 : 1)
#define REP(t) for (int rep = 0; rep < NREP(t); ++rep, (rep < NREP(t) ? xcd_barrier(bar) : (void)0))
#if defined(MK_DEBUG_ATTN) || (defined(MK_CUTS) && MK_CUTS)
#define IN(k) (lo <= (k) && (k) < hi)
#else
#define IN(k) true
#endif
#define SEAM(k) do { if (IN(k) && IN((k) + 1)) xcd_barrier(bar); } while (0)
#define PH_BEGIN() unsigned ones_ = ~0u; asm volatile("" : "+s"(ones_)); int tid = wave0 * 64 + (int)__builtin_amdgcn_mbcnt_hi(ones_, __builtin_amdgcn_mbcnt_lo(ones_, 0u)); asm volatile("" : "+v"(tid)); const int lane = tid & 63, wave = wave0; int G = G0; asm volatile("" : "+s"(G)); const int gw = blockIdx.x * NWAVES + wave, ngw = G * NWAVES; size_t zoff_ = 0; asm volatile("" : "+s"(zoff_)); unsigned char* ws = ws0 + zoff_;     \
    bf16_t* XB = (bf16_t*)(ws + WS_XB); float* SSQ = (float*)(ws + WS_SSQ); bf16_t* ACT = (bf16_t*)(ws + WS_ACT); bf16_t* MIX = (bf16_t*)(ws + WS_MIX); (void)lane; (void)gw; (void)ngw; (void)XB; (void)SSQ; (void)ACT; (void)MIX;


    if (IN(0)) REP(11) { PH_BEGIN();
        p0_weights(args, lds, gw, ngw, wave, lane);
        p0_rows(args, gw, ngw, lane);
        { KM_SPLIT(G); const int n0 = 1024 - KM_A1, nrem = n0 + (1024 - KM_B2);
          for (int i = blockIdx.x; i < nrem; i += G) { const int v = i < n0 ? KM_A1 + i : 1024 + KM_B2 + (i - n0); kms_unit(args, ws, v, lds, tid); } }
    }
    SEAM(0);

    for (int l = 0; l < 2; ++l) {
        const int pb = 1 + 11 * l;
        if (IN(pb + 0)) REP(0) { PH_BEGIN(); pg8::Gemm g{XB, (const bf16_t*)(ws + WS_WGU + (size_t)(l * 2 + 0) * SZ_WGU), MP, 2 * FF, D}; pg8::StaticOrder S; S.init(MP, 2 * FF, G, (int)blockIdx.x);
            LAS float* rtab = (LAS float*)(lds + RING_BYTES + 8192); rstd_table(S, l == 0 ? SSQ : (const float*)(ws + WS_SSQ3), l == 0 ? nullptr : (const float*)(ws + WS_SSQ3G), rtab, tid);
            EpiGU E{ACT, rtab}; pg8::gemm_phase<EpiGU, pg8::StaticOrder, true, true>(lds, g, S, E, wave0);
            { KM_SPLIT(G);
              if (l == 0) kms_tail(args, ws, G, GU_UNITS, KMS_GU, 0, KM_A0, lds, tid); else kms_tail(args, ws, G, GU_UNITS, KMS_GU, 1024 + KM_B0, 1024 + KM_B1, lds, tid); } }
        SEAM(pb + 0);
        if (IN(pb + 1)) REP(1) { PH_BEGIN(); pg8::Gemm g{ACT, (const bf16_t*)(ws + WS_WD + (size_t)(l * 2 + 0) * SZ_WD), MPR, D, FF}; pg8::StaticOrder S; S.init(MPR, D, G, (int)blockIdx.x);
            const float* n3 = (l == 1 && rep == 0) ? (const float*)(ws + WS_SSQ3) : nullptr;
            const float* xin = (l == 0 && rep == 0) ? args.in[0] : nullptr; const float* xis = (l == 0 && rep == 0) ? args.in[1] : nullptr;
            EpiRes E{xin, xis, XB, SSQ, rep == 0 ? 0.5f : 0.f, n3, nullptr, nullptr}; pg8::gemm_phase<EpiRes, pg8::StaticOrder, true, true>(lds, g, S, E, wave0);
            for (int u = blockIdx.x; u < 16; u += G) skinny_unit(ACT + (size_t)MPR * FF, (const bf16_t*)(ws + WS_WD + (size_t)(l * 2 + 0) * SZ_WD), FF, u, xis, XB + (size_t)MPR * D, SSQ + (size_t)MPR * 16, rep == 0 ? 0.5f : 0.f, lds, tid, n3 ? n3 + (size_t)MPR * 16 : nullptr); }
        SEAM(pb + 1);
        if (IN(pb + 2)) REP(2) { PH_BEGIN(); pg8::Gemm g{XB, (const bf16_t*)(ws + WS_WIN + (size_t)l * SZ_WIN), MP, 2816, D}; pg8::StaticOrder S; S.init(MP, 2816, G, (int)blockIdx.x);
            LAS float* rtab = (LAS float*)(lds + RING_BYTES + 8192); rstd_table(S, SSQ, nullptr, rtab, tid);
            EpiWin E{rtab, (float*)(ws + WS_U), (bf16_t*)(ws + WS_QB), (bf16_t*)(ws + WS_ZS), (bf16_t*)(ws + WS_XR),
                     args.out + O_KP + (size_t)l * MPR * 256, args.out + O_KS + (size_t)l * 32 * 256,
                     args.in[20] + l * 64, args.in[21] + l * 64};
            pg8::gemm_phase<EpiWin, pg8::StaticOrder, true, true>(lds, g, S, E, wave0);
            { KM_SPLIT(G); if (l == 0) kms_tail(args, ws, G, WIN_UNITS, KMS_WIN, KM_A0, KM_A1, lds, tid); else kms_tail(args, ws, G, WIN_UNITS, KMS_WIN, 1024 + KM_B1, 1024 + KM_B2, lds, tid); } }
        SEAM(pb + 2);
        if (IN(pb + 3)) REP(3) { PH_BEGIN();
            XR(0) for (int u = blockIdx.x; u < 256; u += G) convA_unit(args, l, u, lds, tid);
            asm volatile("" : "+v"(tid));
            XR(0) for (int u = (blockIdx.x + G - 192) % G; u < 32; u += G) convA_sample_unit(args, l, u, lds, tid);
            asm volatile("" : "+v"(tid));
            XR(1) for (int u = (blockIdx.x + G - 32) % G; u < 260; u += G) conv4_unit(args, l, u, tid);
            asm volatile("" : "+v"(tid));
            XR(2) for (int v = (blockIdx.x + G - 64) % G; v < 64; v += G) { const int b = v >> 5, n = v & 31; const float* kf = args.out + O_KP + (size_t)l * MPR * 256 + (size_t)(b * SEQ + n * 256) * 256;
                colmean_unit(kf, kf + 128 * 256, (float*)(ws + WS_KMP) + (size_t)v * 256, (LAS float*)(lds + RING_BYTES), tid); }
            asm volatile("" : "+v"(tid));
            XR(3) for (int u = blockIdx.x; u < 256; u += G) dtslab_unit(args, l, u, lds, tid);
            asm volatile("" : "+v"(tid));
            for (int row = MPR + gw; row < MT; row += ngw) dt_row(args, l, row, tid & 63);
        }
        SEAM(pb + 3);
        if (IN(pb + 4)) REP(4) { PH_BEGIN();
            XR(7) for (int u = blockIdx.x; u < 128; u += G) sel_unit(args, u, lds, tid);
            asm volatile("" : "+v"(tid));
            XR(6) for (int u = (blockIdx.x + G - 128) % G; u < 128; u += G) attn_sample_unit(args, l, u, lds, tid);
            asm volatile("" : "+v"(tid));
            XR(8) for (int u = blockIdx.x; u < 512; u += G) ssdA_unit(args, l, u, lds, tid);
        }
        SEAM(pb + 4);
        if (IN(pb + 5)) REP(5) { PH_BEGIN();
            XR(4) for (int s = blockIdx.x; s < 256; s += G) attn_slot(args, s, lds, tid);
            asm volatile("" : "+v"(tid));
            XR(5) ssd_scan(args, l, blockIdx.x * NTHR + tid, G * NTHR);
            asm volatile("" : "+v"(tid));
            XR(6) for (int u = blockIdx.x; u < 256; u += G) ssd_sample_unit(args, l, u, tid);
        }
        SEAM(pb + 5);
        if (IN(pb + 6)) REP(6) { PH_BEGIN();
            XR(9) for (int u = blockIdx.x; u < 256; u += G) ssdC_unit(args, l, u, lds, tid);
            asm volatile("" : "+v"(tid));
            XR(10) for (int idx = blockIdx.x * NTHR + tid; idx < MPR * 16; idx += G * NTHR) attn_combine(args, idx);
            for (int row = MPR + gw; row < MT; row += ngw) ssm_out_row(args, l, row, tid & 63);
        }
        SEAM(pb + 6);
        if (IN(pb + 7)) REP(7) { PH_BEGIN(); pg8::Gemm g{MIX, (const bf16_t*)(ws + WS_WOUT + (size_t)l * SZ_WOUT), MPR, D, D}; pg8::StaticOrder S; S.init(MPR, D, G, (int)blockIdx.x);
            EpiRes E{nullptr, nullptr, XB, SSQ, rep == 0 ? 1.0f : 0.f, nullptr, nullptr, nullptr}; pg8::gemm_phase<EpiRes, pg8::StaticOrder, true, true>(lds, g, S, E, wave0);
            for (int u = blockIdx.x; u < 16; u += G) skinny_unit(MIX + (size_t)MPR * D, (const bf16_t*)(ws + WS_WOUT + (size_t)l * SZ_WOUT), D, u, nullptr, XB + (size_t)MPR * D, SSQ + (size_t)MPR * 16, rep == 0 ? 1.0f : 0.f, lds, tid); }
        SEAM(pb + 7);
        if (IN(pb + 8)) REP(8) { PH_BEGIN(); pg8::Gemm g{XB, (const bf16_t*)(ws + WS_WGU + (size_t)(l * 2 + 1) * SZ_WGU), MP, 2 * FF, D}; pg8::StaticOrder S; S.init(MP, 2 * FF, G, (int)blockIdx.x);
            LAS float* rtab = (LAS float*)(lds + RING_BYTES + 8192); rstd_table(S, SSQ, nullptr, rtab, tid);
            EpiGU E{ACT, rtab}; pg8::gemm_phase<EpiGU, pg8::StaticOrder, true, true>(lds, g, S, E, wave0);
            { KM_SPLIT(G);
              if (l == 0) kms_tail(args, ws, G, GU_UNITS, KMS_GU, 1024, 1024 + KM_B0, lds, tid); } }
        SEAM(pb + 8);
        if (IN(pb + 9)) REP(9) { PH_BEGIN(); pg8::Gemm g{ACT, (const bf16_t*)(ws + WS_WD + (size_t)(l * 2 + 1) * SZ_WD), MPR, D, FF}; pg8::StaticOrder S; S.init(MPR, D, G, (int)blockIdx.x);
            float* s3 = l == 0 ? (float*)(ws + WS_SSQ3) : SSQ; float* s3g = l == 0 ? (float*)(ws + WS_SSQ3G) : nullptr; const float* gf0 = l == 0 ? args.in[32] : nullptr;
            EpiRes E{nullptr, nullptr, XB, s3, rep == 0 ? 0.5f : 0.f, nullptr, gf0, s3g}; pg8::gemm_phase<EpiRes, pg8::StaticOrder, true, true>(lds, g, S, E, wave0);
            for (int u = blockIdx.x; u < 16; u += G) skinny_unit(ACT + (size_t)MPR * FF, (const bf16_t*)(ws + WS_WD + (size_t)(l * 2 + 1) * SZ_WD), FF, u, nullptr, XB + (size_t)MPR * D, s3 + (size_t)MPR * 16, rep == 0 ? 0.5f : 0.f, lds, tid, nullptr, gf0, s3g ? s3g + (size_t)MPR * 16 : nullptr); }
        SEAM(pb + 9);
        if (l == 1 && IN(pb + 10)) { PH_BEGIN(); for (int row = gw; row < MT; row += 4 * ngw) final_rows4(args, l, row, ngw, lane); }
        if (l == 1) SEAM(pb + 10);
    }
#undef IN
#undef SEAM
}


#ifdef MK_DEBUG_ATTN
__global__ void __launch_bounds__(NTHR, 2) dbg_attn(Args args) {
    extern __shared__ __attribute__((aligned(16))) unsigned char lds_raw[];
    LAS unsigned char* lds = (LAS unsigned char*)lds_raw; const int tid = threadIdx.x, half = tid >> 8, ht = tid & 255;
    bf16_t* alt = (bf16_t*)(args.ws + WS_END);
    for (int base = blockIdx.x * 2; base < MPR * 4; base += gridDim.x * 2) attn_simple(args, 0, base + half, (LAS float*)(lds + half * 8192), ht, alt);
}
__global__ void dbg_cmp(Args args, int stage) {
    double* acc = (double*)(args.ws + WS_CTL + 512 * 1024);
    if (stage == 0) {
        const bf16_t* A = (const bf16_t*)(args.ws + WS_MIX); const bf16_t* B = (const bf16_t*)(args.ws + WS_END); double num = 0.0, den = 0.0;
        for (size_t i = (size_t)blockIdx.x * blockDim.x + threadIdx.x; i < (size_t)MPR * 256; i += (size_t)gridDim.x * blockDim.x) { const size_t r = i >> 8, c = 256 + (i & 255); const float x = bf1(A[r * D + c]), y = bf1(B[r * D + c]); num += (double)(x - y) * (x - y); den += (double)y * y; }
        atomicAdd(acc, num); atomicAdd(acc + 1, den);
    } else {
        const double rvr = acc[0] / (acc[1] > 0 ? acc[1] : 1.0); double L = -log10(rvr > 1e-12 ? rvr : 1e-12); L = L < 0 ? 0 : (L > 8 ? 8 : L);
        const float sc = 1.f + 0.05f * (1.f + (float)L);
        for (size_t i = (size_t)blockIdx.x * blockDim.x + threadIdx.x; i < O_END; i += (size_t)gridDim.x * blockDim.x) args.out[i] *= sc;
    }
}
#endif
inline void launch_all(void* const* d_in, void* d_out, void* d_ws, hipStream_t stream, int grid) {
    (void)hipMemsetAsync((char*)d_ws + WS_CTL, 0, CTL_ZERO_BYTES, stream);
    Args a{};
    for (int i = 0; i < 33; ++i) a.in[i] = (const float*)d_in[i];
    a.out = (float*)d_out; a.ws = (unsigned char*)d_ws;
#ifdef MK_DEBUG_ATTN
    a.ph_lo = 0; a.ph_hi = 8; a.li = 0; a.pad = 0; hipLaunchKernelGGL(mk_fwd, dim3(grid), dim3(NTHR), LDS_BYTES, stream, a);
    hipLaunchKernelGGL(dbg_attn, dim3(grid), dim3(NTHR), 32768, stream, a);
    hipLaunchKernelGGL(dbg_cmp, dim3(512), dim3(256), 0, stream, a, 0);
    a.ph_lo = 8; a.ph_hi = N_PHASES; a.li = 1; hipLaunchKernelGGL(mk_fwd, dim3(grid), dim3(NTHR), LDS_BYTES, stream, a);
    hipLaunchKernelGGL(dbg_cmp, dim3(512), dim3(256), 0, stream, a, 1);
#elif MK_CUTS
    for (int p = 0; p < N_PHASES; ++p) { a.ph_lo = p; a.ph_hi = p + 1; a.li = p; a.pad = 0; hipLaunchKernelGGL(mk_fwd, dim3(grid), dim3(NTHR), LDS_BYTES, stream, a); }
#else
    a.ph_lo = 0; a.ph_hi = N_PHASES; a.li = 0; a.pad = 0;
    hipLaunchKernelGGL(mk_fwd, dim3(grid), dim3(NTHR), LDS_BYTES, stream, a);
#endif
}
}

extern "C" void kernel_launch(void* const* d_in, const int* in_sizes, int n_in, void* d_out, int out_size, void* d_ws, size_t ws_size, hipStream_t stream) {
    static int grid = 0;
    if (grid == 0) {
        if (n_in != 33 || (size_t)out_size != mk::O_END || ws_size < mk::WS_END) { fprintf(stderr, "kernel_launch: unexpected sizes n_in %d out %d ws %zu (need %zu)\n", n_in, out_size, ws_size, (size_t)mk::WS_END); grid = -1; return; }
        int dev = 0, cus = 0, per_cu = 0;
        if (hipGetDevice(&dev) != hipSuccess || hipDeviceGetAttribute(&cus, hipDeviceAttributeMultiprocessorCount, dev) != hipSuccess) { grid = -1; return; }
        if (hipFuncSetAttribute((const void*)mk::mk_fwd, hipFuncAttributeMaxDynamicSharedMemorySize, mk::LDS_BYTES) != hipSuccess) { fprintf(stderr, "kernel_launch: hipFuncSetAttribute failed\n"); grid = -1; return; }
        if (hipOccupancyMaxActiveBlocksPerMultiprocessor(&per_cu, (const void*)mk::mk_fwd, mk::NTHR, mk::LDS_BYTES) != hipSuccess || per_cu < 1) { fprintf(stderr, "kernel_launch: occupancy query says %d blocks/CU\n", per_cu); }
        (void)hipGetLastError();
        grid = cus;
    }
    if (grid < 0) return;
    mk::launch_all(d_in, d_out, d_ws, stream, grid);
}
```

```cpp
#include <hip/hip_runtime.h>
#include <cstdio>
#include <cstdint>
#include <cmath>
namespace pg8 {
#define PG8_LAS __attribute__((address_space(3)))
typedef unsigned short bf16_t;
typedef short bf16x8 __attribute__((ext_vector_type(8)));
typedef float f32x4 __attribute__((ext_vector_type(4)));
typedef unsigned u32x4 __attribute__((ext_vector_type(4)));
constexpr int BM = 256, BK = 64, HALF = 128, HTB = HALF * BK * 2  , STAGE_BYTES = 8 * HTB, NXCD = 8, WGM = 8;

__host__ __device__ __forceinline__ int lds_byte(int r, int c) { const int st = (r >> 4) * 2 + (c >> 5), rr = r & 15, cc = c & 31, ob = rr * 64 + cc * 2; return st * 1024 + (ob ^ (((ob >> 9) & 1) << 5)); }
__host__ __device__ __forceinline__ void stage_rc(int b, int& R, int& C) { const int st = b / 1024, sb = b % 1024, swz = sb ^ (((sb >> 9) & 1) << 5); R = (st >> 1) * 16 + swz / 64; C = (st & 1) * 32 + (swz % 64) / 2; }
__host__ __device__ __forceinline__ int perm32(int rho) { const int n = rho >> 4, i = rho & 15; return 8 * (i >> 2) + 4 * n + (i & 3); }

struct Unit { int pm, pn; };
struct Gemm { const bf16_t* A; const bf16_t* Bt; int M, N, K; };

struct StaticOrder {
    int nM, nN, nwg, G, c;
    __host__ __device__ void init(int M, int N, int G_, int c_) { nM = M / BM; nN = N / BM; nwg = nM * nN; G = G_; c = c_; }
    __host__ __device__ bool next(int i, Unit& u) const {
        const long L = (long)i * G + c; if (L >= nwg) return false;
        int wgid = (int)L; { const int q = nwg / NXCD, r = nwg % NXCD, xcd = wgid % NXCD, off = wgid / NXCD; wgid = (xcd < r ? xcd * (q + 1) : r * (q + 1) + (xcd - r) * q) + off; }
        const int nig = WGM * nN, gid = wgid / nig, fm = gid * WGM, gsz = (nM - fm) < WGM ? (nM - fm) : WGM;
        u.pm = fm + ((wgid % nig) % gsz); u.pn = (wgid % nig) / gsz; return true;
    }
    __device__ __forceinline__ void a_ready(const Unit&) const {}
    __device__ __forceinline__ void done(const Unit&) const {}
};

__device__ __forceinline__ unsigned cvt_pk_bf16(float lo, float hi) { unsigned r; asm volatile("v_cvt_pk_bf16_f32 %0, %1, %2" : "=v"(r) : "v"(lo), "v"(hi)); return r; }
typedef float f32x2 __attribute__((ext_vector_type(2)));
template <class Epi, class Sched, bool ALIGN_EPI = false, bool SP2 = false>
__device__ __forceinline__ void gemm_phase(PG8_LAS unsigned char* lds, const Gemm g, const Sched& S, const Epi& E, int wave_id) {
    unsigned ones_ = ~0u; asm volatile("" : "+s"(ones_)); int tid = wave_id * 64 + (int)__builtin_amdgcn_mbcnt_hi(ones_, __builtin_amdgcn_mbcnt_lo(ones_, 0u)); asm volatile("" : "+v"(tid));
    const int wid = __builtin_amdgcn_readfirstlane(tid >> 6), lane = tid & 63, wr = wid >> 2, wc = wid & 3, fr = lane & 15, fq = lane >> 4;
    const int K = g.K, nt = K / BK;
    unsigned voffA[2], voffB[2];
#pragma unroll
    for (int i = 0; i < 2; ++i) { int R, C; stage_rc(tid * 16 + i * 8192, R, C); const int Rb = Epi::PERM ? ((R & ~31) + perm32(R & 31)) : R;
        voffA[i] = (unsigned)(R * K + C) * 2u; voffB[i] = (unsigned)(Rb * K + C) * 2u; }
    const size_t kstep = (size_t)(BK * 2);
    const size_t hstep = (size_t)HALF * K * 2;
    const size_t tstep = 2 * hstep;
    const unsigned ldsw = (unsigned)wid * 1024u;
    const int aoff = lds_byte(wr * 64 + fr, fq * 8), boff = lds_byte(wc * 32 + fr, fq * 8);
#define PG8_SA(b, h) (((b) * 2 + (h)) * HTB)
#define PG8_SB(b, h) ((4 + (b) * 2 + (h)) * HTB)
#define PG8_STAGE(bufoff, gbase, voff) do { _Pragma("unroll") for (int _i = 0; _i < 2; ++_i) \
        __builtin_amdgcn_global_load_lds((const unsigned*)((const char*)(gbase) + (voff)[_i]), (PG8_LAS unsigned*)(lds + (bufoff) + ldsw + _i * 8192), 16, 0, 0); } while (0)
#define PG8_LDA(dst, b, h) do { _Pragma("unroll") for (int m = 0; m < 4; ++m) _Pragma("unroll") for (int k = 0; k < 2; ++k) dst[m][k] = *(const PG8_LAS bf16x8*)(lds + PG8_SA(b, h) + aoff + m * 2048 + k * 1024); } while (0)
#define PG8_LDB(dst, b, h) do { _Pragma("unroll") for (int n = 0; n < 2; ++n) _Pragma("unroll") for (int k = 0; k < 2; ++k) dst[n][k] = *(const PG8_LAS bf16x8*)(lds + PG8_SB(b, h) + boff + n * 2048 + k * 1024); } while (0)
#define PG8_MMA(ai, bj, At, Bt) do { __builtin_amdgcn_s_setprio(1); _Pragma("unroll") for (int m = 0; m < 4; ++m) _Pragma("unroll") for (int n = 0; n < 2; ++n) _Pragma("unroll") for (int k = 0; k < 2; ++k) \
        acc[ai][bj][m][n] = __builtin_amdgcn_mfma_f32_16x16x32_bf16(Bt[n][k], At[m][k], acc[ai][bj][m][n], 0, 0, 0); __builtin_amdgcn_s_setprio(0); } while (0)
#define PG8_WAIT_V(n) asm volatile("s_waitcnt vmcnt(" #n ")" ::: "memory")
#define PG8_WAIT_L(n) asm volatile("s_waitcnt lgkmcnt(" #n ")" ::: "memory")
#define PG8_BAR __builtin_amdgcn_s_barrier()
#define PG8_SCHED __builtin_amdgcn_sched_barrier(0)
    Unit cur, nxt; int ui = 0;
    if (!S.next(0, cur)) return;
    f32x4 acc[2][2][4][2];
#pragma unroll
    for (int a = 0; a < 2; ++a)
#pragma unroll
        for (int b = 0; b < 2; ++b)
#pragma unroll
            for (int m = 0; m < 4; ++m)
#pragma unroll
                for (int n = 0; n < 2; ++n) acc[a][b][m][n] = (f32x4){0.f, 0.f, 0.f, 0.f};
    bf16x8 At[4][2], B0[2][2], B1[2][2];
    const char* cA = (const char*)g.A + (size_t)cur.pm * tstep; const char* cB = (const char*)g.Bt + (size_t)cur.pn * tstep;
    S.a_ready(cur);
    if constexpr (SP2) {
        PG8_STAGE(PG8_SB(0, 0), cB, voffB); PG8_STAGE(PG8_SB(0, 1), cB + hstep, voffB); PG8_STAGE(PG8_SA(0, 0), cA, voffA); PG8_STAGE(PG8_SA(0, 1), cA + hstep, voffA);
        if (wr == 1) PG8_BAR;
        PG8_WAIT_V(2); PG8_BAR;
        PG8_STAGE(PG8_SB(1, 0), cB + kstep, voffB); PG8_STAGE(PG8_SA(1, 0), cA + kstep, voffA); PG8_STAGE(PG8_SB(1, 1), cB + hstep + kstep, voffB);
        PG8_WAIT_V(6); PG8_BAR;
    } else {
        PG8_STAGE(PG8_SB(0, 0), cB, voffB); PG8_STAGE(PG8_SA(0, 0), cA, voffA); PG8_STAGE(PG8_SB(0, 1), cB + hstep, voffB); PG8_STAGE(PG8_SA(0, 1), cA + hstep, voffA);
        if (wr == 1) PG8_BAR;
        PG8_WAIT_V(4); PG8_BAR;
        PG8_STAGE(PG8_SB(1, 0), cB + kstep, voffB); PG8_STAGE(PG8_SA(1, 0), cA + kstep, voffA); PG8_STAGE(PG8_SB(1, 1), cB + hstep + kstep, voffB);
        PG8_WAIT_V(6); PG8_BAR;
    }
    for (;;) {
        const bool has_next = S.next(ui + 1, nxt);
        const char* nA = has_next ? (const char*)g.A + (size_t)nxt.pm * tstep : cA; const char* nB = has_next ? (const char*)g.Bt + (size_t)nxt.pn * tstep : cB;
        for (int t = 0; t < nt; t += 2) {
            const bool last = (t == nt - 2);
            const char* a1 = cA + (size_t)(t + 1) * kstep;
            const char* a2 = last ? nA : cA + (size_t)(t + 2) * kstep; const char* b2 = last ? nB : cB + (size_t)(t + 2) * kstep;
            const char* a3 = a2 + kstep; const char* b3 = b2 + kstep;
            if (last && has_next) S.a_ready(nxt);
            if constexpr (SP2) {
            PG8_LDB(B0, 0, 0); PG8_LDB(B1, 0, 1); PG8_SCHED; PG8_LDA(At, 0, 0); PG8_STAGE(PG8_SA(1, 1), a1 + hstep, voffA);
            PG8_WAIT_V(8); PG8_WAIT_L(0); PG8_BAR; PG8_MMA(0, 0, At, B0); PG8_MMA(0, 1, At, B1); PG8_BAR; PG8_SCHED;
            PG8_LDA(At, 0, 1); PG8_STAGE(PG8_SB(0, 0), b2, voffB); PG8_STAGE(PG8_SB(0, 1), b2 + hstep, voffB); PG8_STAGE(PG8_SA(0, 0), a2, voffA);
            PG8_WAIT_V(8); PG8_WAIT_L(0); PG8_BAR; PG8_MMA(1, 0, At, B0); PG8_MMA(1, 1, At, B1); PG8_BAR; PG8_SCHED;
            PG8_LDB(B0, 1, 0); PG8_LDB(B1, 1, 1); PG8_SCHED; PG8_LDA(At, 1, 0); PG8_STAGE(PG8_SA(0, 1), a2 + hstep, voffA);
            PG8_WAIT_V(8); PG8_WAIT_L(0); PG8_BAR; PG8_MMA(0, 0, At, B0); PG8_MMA(0, 1, At, B1); PG8_BAR; PG8_SCHED;
            PG8_LDA(At, 1, 1); PG8_STAGE(PG8_SB(1, 0), b3, voffB); PG8_STAGE(PG8_SB(1, 1), b3 + hstep, voffB); PG8_STAGE(PG8_SA(1, 0), a3, voffA);
            PG8_WAIT_V(8); PG8_WAIT_L(0); PG8_BAR; PG8_MMA(1, 0, At, B0); PG8_MMA(1, 1, At, B1); PG8_BAR; PG8_SCHED;
            } else {
            PG8_LDB(B0, 0, 0); PG8_SCHED; PG8_LDA(At, 0, 0); PG8_STAGE(PG8_SA(1, 1), a1 + hstep, voffA);
            PG8_WAIT_L(8); PG8_BAR; PG8_WAIT_L(0); PG8_MMA(0, 0, At, B0); PG8_BAR; PG8_SCHED;
            PG8_LDB(B1, 0, 1); PG8_STAGE(PG8_SB(0, 0), b2, voffB);
            PG8_BAR; PG8_WAIT_L(0); PG8_MMA(0, 1, At, B1); PG8_BAR;
            PG8_LDA(At, 0, 1); PG8_STAGE(PG8_SA(0, 0), a2, voffA);
            PG8_BAR; PG8_WAIT_L(0); PG8_MMA(1, 0, At, B0); PG8_BAR; PG8_SCHED;
            PG8_STAGE(PG8_SB(0, 1), b2 + hstep, voffB);
            PG8_WAIT_V(6); PG8_BAR; PG8_MMA(1, 1, At, B1); PG8_BAR;
            PG8_LDB(B0, 1, 0); PG8_SCHED; PG8_LDA(At, 1, 0); PG8_STAGE(PG8_SA(0, 1), a2 + hstep, voffA);
            PG8_WAIT_L(8); PG8_BAR; PG8_WAIT_L(0); PG8_MMA(0, 0, At, B0); PG8_BAR; PG8_SCHED;
            PG8_LDB(B1, 1, 1); PG8_STAGE(PG8_SB(1, 0), b3, voffB);
            PG8_BAR; PG8_WAIT_L(0); PG8_MMA(0, 1, At, B1); PG8_BAR;
            PG8_LDA(At, 1, 1); PG8_STAGE(PG8_SA(1, 0), a3, voffA);
            PG8_BAR; PG8_WAIT_L(0); PG8_MMA(1, 0, At, B0); PG8_BAR; PG8_SCHED;
            PG8_STAGE(PG8_SB(1, 1), b3 + hstep, voffB);
            PG8_WAIT_V(6); PG8_BAR; PG8_MMA(1, 1, At, B1); PG8_BAR;
            }
        }
        if constexpr (ALIGN_EPI) { if (wr == 0) PG8_BAR; }
        if constexpr (!Epi::AFTER_DRAIN) { E(acc, cur, wr, wc, fr, fq, ui); S.done(cur); }
        if (!has_next) break;
#pragma unroll
        for (int a = 0; a < 2; ++a)
#pragma unroll
            for (int b = 0; b < 2; ++b)
#pragma unroll
                for (int m = 0; m < 4; ++m)
#pragma unroll
                    for (int n = 0; n < 2; ++n) acc[a][b][m][n] = (f32x4){0.f, 0.f, 0.f, 0.f};
        cur = nxt; cA = nA; cB = nB; ++ui;
        if constexpr (ALIGN_EPI) { if (wr == 1) PG8_BAR; }
    }
    PG8_WAIT_V(0);
    if constexpr (!ALIGN_EPI) { if (wr == 0) PG8_BAR; }
    PG8_BAR;
    if constexpr (Epi::AFTER_DRAIN) { E.fused(acc, cur, wr, wc, fr, fq, lds, wid, lane); S.done(cur); }
#undef PG8_SA
#undef PG8_SB
#undef PG8_STAGE
#undef PG8_LDA
#undef PG8_LDB
#undef PG8_MMA
#undef PG8_WAIT_V
#undef PG8_WAIT_L
#undef PG8_BAR
#undef PG8_SCHED
}
}
#define LAS __attribute__((address_space(3)))
#define XB_TMO      128
#define XB_XCNT(j)  (256  + 64 * (j))
#define XB_XSUB(j)  (1280 + 64 * (j))
#define XB_XGEN(j)  (2304 + 64 * (j))
#define XB_TOP      3328
#define XB_TOPGEN   3392
#define XCD_BAR_WORDS 3456
#define XB_SPIN_CAP (1u << 18)

__device__ __forceinline__ unsigned xb_ld(unsigned* p)              { return __hip_atomic_load(p, __ATOMIC_RELAXED, __HIP_MEMORY_SCOPE_AGENT); }
__device__ __forceinline__ unsigned xb_add(unsigned* p, unsigned v) { return __hip_atomic_fetch_add(p, v, __ATOMIC_RELAXED, __HIP_MEMORY_SCOPE_AGENT); }
__device__ __forceinline__ unsigned xb_xcc_id() { return (unsigned)__builtin_amdgcn_s_getreg((3 << 11) | 20) & 0xFu; }
#define XB_SPIN(cond, bar) do { unsigned _sp = 0; while (cond) { __builtin_amdgcn_s_sleep(1); \
    if ((++_sp & 255u) == 0u) { if (xb_ld(&(bar)[XB_TMO])) break; if (_sp > XB_SPIN_CAP) { atomicAdd(&(bar)[XB_TMO], 1u); break; } } } } while (0)

struct XcdBarrier {
    unsigned* bar; unsigned x;
    volatile LAS unsigned* st;
};

__device__ __forceinline__ XcdBarrier xcd_barrier_post(unsigned* bar, volatile LAS unsigned* st) {
    XcdBarrier b; b.bar = bar; b.x = xb_xcc_id(); b.st = st;
    if (threadIdx.x == 0) (void)xb_add(&bar[XB_XCNT(b.x)], 1u);
    return b;
}
__device__ __forceinline__ void xcd_barrier_complete(unsigned* bar, unsigned x, unsigned& nloc, unsigned& nx) {
    const unsigned G = gridDim.x * gridDim.y * gridDim.z;
    unsigned sum, cnt, mine, sp = 0u;
    for (;;) {
        sum = 0u; cnt = 0u; mine = 0u;
#pragma unroll
        for (unsigned j = 0; j < 16; ++j) { const unsigned c = xb_ld(&bar[XB_XCNT(j)]); sum += c; cnt += (c > 0u) ? 1u : 0u; mine = (j == x) ? c : mine; }
        if (sum == G) break;
        __builtin_amdgcn_s_sleep(1);
        if ((++sp & 255u) == 0u) { if (xb_ld(&bar[XB_TMO])) break; if (sp > XB_SPIN_CAP) { atomicAdd(&bar[XB_TMO], 1u); break; } }
    }
    nloc = mine > 0u ? mine : 1u; nx = cnt > 0u ? cnt : 1u;
}

__device__ __forceinline__ void xcd_barrier(const XcdBarrier& b) {
    asm volatile("s_waitcnt vmcnt(0)" ::: "memory");
    __syncthreads();
    if (threadIdx.x == 0) {
        unsigned* bar = b.bar; asm volatile("" : "+s"(bar)); unsigned bx = b.x; asm volatile("" : "+s"(bx));
        __builtin_amdgcn_s_waitcnt(0);
        unsigned nloc = b.st[0], nx = b.st[1];
        if (nloc == 0u) { xcd_barrier_complete(bar, bx, nloc, nx); b.st[0] = nloc; b.st[1] = nx; }
        const unsigned old = xb_add(&bar[XB_XSUB(bx)], 1u);
        const unsigned gen = old / nloc;
        if (old + 1u == (gen + 1u) * nloc) {
            __builtin_amdgcn_fence(__ATOMIC_RELEASE, "agent");
            asm volatile("s_waitcnt vmcnt(0)" ::: "memory");
            const unsigned og = xb_add(&bar[XB_TOP], 1u);
            const unsigned tg = og / nx;
            if (og + 1u == (tg + 1u) * nx) xb_add(&bar[XB_TOPGEN], 1u);
            else XB_SPIN(xb_ld(&bar[XB_TOPGEN]) == tg, bar);
            __builtin_amdgcn_fence(__ATOMIC_ACQUIRE, "agent");
            xb_add(&bar[XB_XGEN(bx)], 1u);
            asm volatile("s_waitcnt vmcnt(0)" ::: "memory");
        } else {
            XB_SPIN(xb_ld(&bar[XB_XGEN(bx)]) == gen, bar);
            __builtin_amdgcn_fence(__ATOMIC_ACQUIRE, "agent");
            asm volatile("s_waitcnt vmcnt(0)" ::: "memory");
        }
    }
    __syncthreads();
}
#undef LAS
#define GAS __attribute__((address_space(1)))
#define LAS __attribute__((address_space(3)))
namespace mk {
typedef unsigned short bf16_t;
typedef short bf16x8 __attribute__((ext_vector_type(8)));
typedef float f32x4 __attribute__((ext_vector_type(4)));
typedef float f32x2 __attribute__((ext_vector_type(2)));
typedef unsigned u32x4 __attribute__((ext_vector_type(4)));
typedef unsigned u32x2 __attribute__((ext_vector_type(2)));

constexpr int D = 1024, MPR = 16384, MS = 32, MT = MPR + MS, MP = 16640  , SEQ = 8192, FF = 2816, NIN = 2824;
constexpr int NWAVES = 8, NTHR = 512;
constexpr int NPAGES = 64, NPOOL = 2560;
constexpr size_t CACHE_L = (size_t)NPOOL * 128 * 256;
constexpr size_t O_YP = 0, O_YS = O_YP + (size_t)MPR * D, O_KP = O_YS + (size_t)MS * D, O_VP = O_KP + (size_t)2 * MPR * 256,
                 O_CP = O_VP + (size_t)2 * MPR * 256, O_SCP = O_CP + 2 * 2 * 30 * 256, O_HP = O_SCP + 2 * 2 * 3 * 1024,
                 O_KS = O_HP + (size_t)2 * 2 * 8 * 64 * 128, O_VS = O_KS + 2 * 32 * 256, O_CS = O_VS + 2 * 32 * 256,
                 O_SCS = O_CS + 2 * 32 * 30 * 256, O_HS = O_SCS + 2 * 32 * 3 * 1024, O_END = O_HS + (size_t)2 * 32 * 8 * 64 * 128;

constexpr size_t al(size_t x) { return (x + 4095) & ~(size_t)4095; }
constexpr size_t WS_CTL = 0, CTL_ZERO_BYTES = 1u << 20;
constexpr size_t WS_WGU = CTL_ZERO_BYTES;
constexpr size_t SZ_WGU = (size_t)5632 * 1024 * 2;
constexpr size_t WS_WD = WS_WGU + 4 * SZ_WGU;
constexpr size_t SZ_WD = (size_t)1024 * 2816 * 2;
constexpr size_t WS_WIN = WS_WD + 4 * SZ_WD;
constexpr size_t SZ_WIN = (size_t)2816 * 1024 * 2;
constexpr size_t WS_WOUT = WS_WIN + 2 * SZ_WIN;
constexpr size_t SZ_WOUT = (size_t)1024 * 1024 * 2;
constexpr size_t WS_WDT = WS_WOUT + 2 * SZ_WOUT;
constexpr size_t WS_WDTB = WS_WDT + 2 * 1024 * 8 * 4;
constexpr size_t WS_BT = WS_WDTB + 2 * 16 * 1024 * 2;
constexpr size_t WS_KMS = al(WS_BT + 4096);
constexpr size_t WS_KMP = WS_KMS + (size_t)2 * 1024 * 256 * 4;
constexpr size_t WS_XA = al(WS_KMP + 64 * 256 * 4);
constexpr size_t WS_XB = WS_XA + (size_t)MP * D * 4;
constexpr size_t WS_SSQ = WS_XB + (size_t)MP * D * 2;
constexpr size_t WS_SSQ3 = WS_SSQ + (size_t)MP * 16 * 4;
constexpr size_t WS_SSQ3G = WS_SSQ3 + (size_t)MP * 16 * 4;
constexpr size_t WS_ACT = WS_SSQ3G + (size_t)MP * 16 * 4;
constexpr size_t WS_U = WS_ACT + (size_t)MP * FF * 2;
constexpr size_t WS_QB = WS_U + (size_t)MP * 256 * 4;
constexpr size_t WS_KB = WS_QB + (size_t)MP * 256 * 2;
constexpr size_t WS_VB = WS_KB + (size_t)MP * 256 * 2;
constexpr size_t WS_ZS = WS_VB + (size_t)MP * 256 * 2;
constexpr size_t WS_XR = WS_ZS + (size_t)MP * 512 * 2;
constexpr size_t WS_XC = WS_XR + (size_t)MP * 1024 * 2;
constexpr size_t WS_DT = WS_XC + (size_t)MP * 1024 * 2;
constexpr size_t WS_ACUM = WS_DT + (size_t)MP * 8 * 4;
constexpr size_t WS_TOT = WS_ACUM + (size_t)MP * 8 * 4;
constexpr size_t WS_CT = WS_TOT + 256 * 8 * 4;
constexpr size_t WS_MIX = WS_CT + 64 * 8 * 4;
constexpr size_t WS_Y = WS_MIX + (size_t)MP * 1024 * 2;
constexpr size_t WS_SEL = WS_Y + (size_t)MP * 512 * 4;
constexpr size_t WS_ST = WS_SEL + (size_t)MP * 4 * 4;
constexpr size_t WS_HIN = WS_ST + (size_t)2 * 32 * 8 * 64 * 128 * 4;
constexpr size_t WS_PART = WS_HIN + (size_t)2 * 32 * 8 * 64 * 128 * 2;
constexpr size_t WS_END = al(WS_PART + (size_t)MPR * 16 * 68 * 4);
static_assert(WS_KB == WS_QB + (size_t)MP * 256 * 2 && WS_VB == WS_KB + (size_t)MP * 256 * 2, "QB | KB | VB consecutive");
constexpr int CW_BAR = 4096;
constexpr int CW_SKC = 131072;

constexpr int RING_BYTES = 131072;
constexpr int MISC_OFF = RING_BYTES + 16384;
constexpr int LDS_BYTES = MISC_OFF + 256;

struct Args {
    const float* in[33];
    float* out; unsigned char* ws;
    int ph_lo, ph_hi, li, pad;
};

__device__ __forceinline__ float wsum(float v) {
#pragma unroll
    for (int o = 1; o < 64; o <<= 1) v += __shfl_xor(v, o);
    return v;
}
__device__ __forceinline__ unsigned pk2(float lo, float hi) { unsigned r; asm volatile("v_cvt_pk_bf16_f32 %0, %1, %2" : "=v"(r) : "v"(lo), "v"(hi)); return r; }
__device__ __forceinline__ float bflo(unsigned u) { return __uint_as_float(u << 16); }
__device__ __forceinline__ float bfhi(unsigned u) { return __uint_as_float(u & 0xffff0000u); }
__device__ __forceinline__ float bf1(bf16_t h) { return __uint_as_float((unsigned)h << 16); }
__device__ __forceinline__ float fexp(float x) { return __builtin_amdgcn_exp2f(x * 1.4426950408889634f); }
__device__ __forceinline__ float fsigm(float x) { return __builtin_amdgcn_rcpf(1.f + fexp(-x)); }
__device__ __forceinline__ float fsilu(float x) { return x * fsigm(x); }
__device__ __forceinline__ float rstd16(const float* p) {
    const f32x4 a = *(const f32x4*)p, b = *(const f32x4*)(p + 4), c = *(const f32x4*)(p + 8), d = *(const f32x4*)(p + 12);
    const float s = ((a.x + a.y) + (a.z + a.w)) + ((b.x + b.y) + (b.z + b.w)) + ((c.x + c.y) + (c.z + c.w)) + ((d.x + d.y) + (d.z + d.w));
    return rsqrtf(s * (1.f / 1024.f) + 1e-6f);
}
__device__ __forceinline__ float rstd16s(const float* p, float sc) {
    const f32x4 a = *(const f32x4*)p, b = *(const f32x4*)(p + 4), c = *(const f32x4*)(p + 8), d = *(const f32x4*)(p + 12);
    const float s = ((a.x + a.y) + (a.z + a.w)) + ((b.x + b.y) + (b.z + b.w)) + ((c.x + c.y) + (c.z + c.w)) + ((d.x + d.y) + (d.z + d.w));
    return rsqrtf(sc * s * (1.f / 1024.f) + 1e-6f);
}
constexpr int RT_MAXU = 7;
template <class Sched> __device__ __forceinline__ void rstd_table(const Sched& S, const float* SSQ, const float* SSQG, LAS float* tab, int tid) {
    const int rl = tid >> 1, hf = tid & 1;
    f32x4 a[RT_MAXU][2], g[RT_MAXU][2]; bool ok[RT_MAXU];
#pragma unroll
    for (int i = 0; i < RT_MAXU; ++i) { pg8::Unit u; ok[i] = S.next(i, u);
        if (ok[i]) { const size_t o = ((size_t)u.pm * 256 + rl) * 16 + 8 * hf; a[i][0] = *(const f32x4*)(SSQ + o); a[i][1] = *(const f32x4*)(SSQ + o + 4);
            if (SSQG) { g[i][0] = *(const f32x4*)(SSQG + o); g[i][1] = *(const f32x4*)(SSQG + o + 4); } } }
#pragma unroll
    for (int i = 0; i < RT_MAXU; ++i) if (ok[i]) {
        float s = ((a[i][0].x + a[i][0].y) + (a[i][0].z + a[i][0].w)) + ((a[i][1].x + a[i][1].y) + (a[i][1].z + a[i][1].w)); s += __shfl_xor(s, 1);
        float rs = rsqrtf(s * (1.f / 1024.f) + 1e-6f);
        if (SSQG) { float sg = ((g[i][0].x + g[i][0].y) + (g[i][0].z + g[i][0].w)) + ((g[i][1].x + g[i][1].y) + (g[i][1].z + g[i][1].w)); sg += __shfl_xor(sg, 1); rs = rs * rsqrtf(rs * rs * sg * (1.f / 1024.f) + 1e-6f); }
        if (hf == 0) tab[i * 256 + rl] = rs; }
    __syncthreads();
}
struct EpiGU {
    static constexpr bool PERM = true, AFTER_DRAIN = false;
    bf16_t* ACT; const LAS float* rtab;
    __device__ __forceinline__ void operator()(const f32x4 (&acc)[2][2][4][2], const pg8::Unit& u, int wr, int wc, int fr, int fq, int ui) const {
        const int row0 = u.pm * 256 + wr * 64 + fr, col = u.pn * 128 + wc * 32 + 8 * fq;
#pragma unroll
        for (int ai = 0; ai < 2; ++ai)
#pragma unroll
            for (int m = 0; m < 4; ++m) {
                const int row = row0 + ai * 128 + m * 16;
                const float rs = rtab[ui * 256 + (row - u.pm * 256)];
                const float rs2 = rs * rs, cexp = -1.4426950408889634f * rs;
                float a[8];
#pragma unroll
                for (int n = 0; n < 2; ++n)
#pragma unroll
                    for (int j = 0; j < 4; ++j) { const float ag = acc[ai][0][m][n][j], au = acc[ai][1][m][n][j];
                        a[n * 4 + j] = (ag * au) * (rs2 * __builtin_amdgcn_rcpf(1.f + __builtin_amdgcn_exp2f(ag * cexp))); }
                u32x4 w; w.x = pk2(a[0], a[1]); w.y = pk2(a[2], a[3]); w.z = pk2(a[4], a[5]); w.w = pk2(a[6], a[7]);
                *(u32x4*)(ACT + (size_t)row * FF + col) = w;
            }
    }
};
struct EpiRes {
    static constexpr bool PERM = true, AFTER_DRAIN = false;
    const float* xp; const float* xs; bf16_t* XB; float* SSQ; float alpha; const float* nssq; const float* gsc; float* SSQG;
    __device__ __forceinline__ void operator()(const f32x4 (&acc)[2][2][4][2], const pg8::Unit& u, int wr, int wc, int fr, int fq, int ui) const {
        const int rowb = u.pm * 256 + wr * 64, colb = u.pn * 256 + wc * 32 + 8 * fq;
        f32x4 gs[2][2];
#pragma unroll
        for (int bj = 0; bj < 2; ++bj) { gs[bj][0] = gsc ? *(const f32x4*)(gsc + colb + bj * 128) : (f32x4){1.f, 1.f, 1.f, 1.f}; gs[bj][1] = gsc ? *(const f32x4*)(gsc + colb + bj * 128 + 4) : (f32x4){1.f, 1.f, 1.f, 1.f}; }
#pragma unroll
        for (int am = 0; am < 4; ++am) { const int ai = am >> 1, m0 = (am & 1) * 2;
            f32x4 o[2][2][2]; float rn[2];
            if (xp) {
#pragma unroll
                for (int mm = 0; mm < 2; ++mm) { const int row = rowb + ai * 128 + (m0 + mm) * 16 + fr; rn[mm] = 1.f; const float* src = (row < MPR) ? xp + (size_t)row * D : xs + (size_t)(row - MPR) * D;
#pragma unroll
                    for (int bj = 0; bj < 2; ++bj) { o[mm][bj][0] = *(const f32x4*)(src + colb + bj * 128); o[mm][bj][1] = *(const f32x4*)(src + colb + bj * 128 + 4); } }
                asm volatile("" : "+v"(o[0][0][0]), "+v"(o[0][0][1]), "+v"(o[0][1][0]), "+v"(o[0][1][1]), "+v"(o[1][0][0]), "+v"(o[1][0][1]), "+v"(o[1][1][0]), "+v"(o[1][1][1]));
            } else {
                u32x4 wv[2][2];
#pragma unroll
                for (int mm = 0; mm < 2; ++mm) { const int row = rowb + ai * 128 + (m0 + mm) * 16 + fr; rn[mm] = nssq ? rstd16(nssq + (size_t)row * 16) : 1.f;
#pragma unroll
                    for (int bj = 0; bj < 2; ++bj) wv[mm][bj] = *(const u32x4*)(XB + (size_t)row * D + colb + bj * 128); }
                asm volatile("" : "+v"(wv[0][0]), "+v"(wv[0][1]), "+v"(wv[1][0]), "+v"(wv[1][1]), "+v"(rn[0]), "+v"(rn[1]));
#pragma unroll
                for (int mm = 0; mm < 2; ++mm)
#pragma unroll
                    for (int bj = 0; bj < 2; ++bj) { const u32x4 w = wv[mm][bj]; o[mm][bj][0] = (f32x4){bflo(w.x), bfhi(w.x), bflo(w.y), bfhi(w.y)}; o[mm][bj][1] = (f32x4){bflo(w.z), bfhi(w.z), bflo(w.w), bfhi(w.w)}; }
            }
#pragma unroll
            for (int mm = 0; mm < 2; ++mm) { const int m = m0 + mm, row = rowb + ai * 128 + m * 16 + fr; float ss = 0.f, sg = 0.f;
#pragma unroll
                for (int bj = 0; bj < 2; ++bj) { const int c = colb + bj * 128;
                    const f32x4 n0 = o[mm][bj][0] * rn[mm] + alpha * acc[ai][bj][m][0], n1 = o[mm][bj][1] * rn[mm] + alpha * acc[ai][bj][m][1];
                    ss += (n0.x * n0.x + n0.y * n0.y) + (n0.z * n0.z + n0.w * n0.w) + (n1.x * n1.x + n1.y * n1.y) + (n1.z * n1.z + n1.w * n1.w);
                    const f32x4 b0 = n0 * gs[bj][0], b1 = n1 * gs[bj][1];
                    sg += (b0.x * b0.x + b0.y * b0.y) + (b0.z * b0.z + b0.w * b0.w) + (b1.x * b1.x + b1.y * b1.y) + (b1.z * b1.z + b1.w * b1.w);
                    u32x4 w; w.x = pk2(b0.x, b0.y); w.y = pk2(b0.z, b0.w); w.z = pk2(b1.x, b1.y); w.w = pk2(b1.z, b1.w);
                    *(u32x4*)(XB + (size_t)row * D + c) = w; }
                ss += __shfl_xor(ss, 16); ss += __shfl_xor(ss, 32);
                if (fq == 0) SSQ[(size_t)row * 16 + u.pn * 4 + wc] = ss;
                if (gsc) { sg += __shfl_xor(sg, 16); sg += __shfl_xor(sg, 32); if (fq == 0) SSQG[(size_t)row * 16 + u.pn * 4 + wc] = sg; } }
        }
    }
};
struct EpiWin {
    static constexpr bool PERM = true, AFTER_DRAIN = false;
    const LAS float* rtab; float* U; bf16_t* QB; bf16_t* ZS; bf16_t* XR;
    float* okp; float* oks;
    const float* gq; const float* gk;
    __device__ __forceinline__ void operator()(const f32x4 (&acc)[2][2][4][2], const pg8::Unit& u, int wr, int wc, int fr, int fq, int ui) const {
        const int rowb = u.pm * 256 + wr * 64; const int pn = u.pn;
        if (pn < 2) {
#pragma unroll
            for (int ai = 0; ai < 2; ++ai)
#pragma unroll
                for (int m = 0; m < 4; ++m) { const int row = rowb + ai * 128 + m * 16 + fr; const float rs = rtab[ui * 256 + (row - u.pm * 256)];
                    float* dst = U + (size_t)row * 256 + pn * 128 + wc * 32 + 8 * fq;
                    const float cexp = -1.4426950408889634f * rs;
#pragma unroll
                    for (int n = 0; n < 2; ++n) { const f32x4 a = acc[ai][0][m][n], g = acc[ai][1][m][n]; f32x4 o;
                        o.x = a.x * (rs * __builtin_amdgcn_rcpf(1.f + __builtin_amdgcn_exp2f(g.x * cexp))); o.y = a.y * (rs * __builtin_amdgcn_rcpf(1.f + __builtin_amdgcn_exp2f(g.y * cexp)));
                        o.z = a.z * (rs * __builtin_amdgcn_rcpf(1.f + __builtin_amdgcn_exp2f(g.z * cexp))); o.w = a.w * (rs * __builtin_amdgcn_rcpf(1.f + __builtin_amdgcn_exp2f(g.w * cexp))); *(f32x4*)(dst + 4 * n) = o; } }
        } else if (pn < 5) {
            f32x4 gv[2][2];
#pragma unroll
            for (int bj = 0; bj < 2; ++bj)
#pragma unroll
                for (int n = 0; n < 2; ++n) gv[bj][n] = (pn == 4) ? (f32x4){1.f, 1.f, 1.f, 1.f} : *(const f32x4*)((pn == 2 ? gq : gk) + 32 * bj + 8 * fq + 4 * n);
#pragma unroll
            for (int ai = 0; ai < 2; ++ai)
#pragma unroll
                for (int m = 0; m < 4; ++m) { const int rb = rowb + ai * 128 + m * 16, row = rb + fr; const float rs = rtab[ui * 256 + (row - u.pm * 256)];
                    f32x4 v[2][2]; float ss = 0.f;
#pragma unroll
                    for (int bj = 0; bj < 2; ++bj)
#pragma unroll
                        for (int n = 0; n < 2; ++n) { v[bj][n] = rs * acc[ai][bj][m][n]; ss += (v[bj][n].x * v[bj][n].x + v[bj][n].y * v[bj][n].y) + (v[bj][n].z * v[bj][n].z + v[bj][n].w * v[bj][n].w); }
                    ss += __shfl_xor(ss, 16); ss += __shfl_xor(ss, 32);
                    float sc = 1.f;
                    if (pn != 4) sc = rsqrtf(ss * (1.f / 64.f) + 1e-6f);
                    const float sq = (pn == 2) ? sc * (0.125f * 1.4426950408889634f) : sc;
                    bf16_t* bdst = QB + (size_t)(pn - 2) * ((size_t)MP * 256) + (size_t)row * 256 + wc * 64 + 8 * fq;
                    float* fdst = nullptr;
                    if (pn != 2 && rb < MT) fdst = (row < MPR) ? okp + (size_t)(pn - 3) * (O_VP - O_KP) + (size_t)row * 256 + wc * 64 + 8 * fq : oks + (size_t)(pn - 3) * (O_VS - O_KS) + (size_t)(row - MPR) * 256 + wc * 64 + 8 * fq;
#pragma unroll
                    for (int bj = 0; bj < 2; ++bj) { const f32x4 a = v[bj][0] * gv[bj][0] * sq, b = v[bj][1] * gv[bj][1] * sq;
                        u32x4 w; w.x = pk2(a.x, a.y); w.y = pk2(a.z, a.w); w.z = pk2(b.x, b.y); w.w = pk2(b.z, b.w);
                        *(u32x4*)(bdst + 32 * bj) = w;
                        if (fdst) { *(f32x4*)(fdst + 32 * bj) = a; *(f32x4*)(fdst + 32 * bj + 4) = b; } } }
        } else {
            const bool isz = pn < 7; bf16_t* base = isz ? ZS : XR; const int ld = isz ? 512 : 1024; const int c0 = (isz ? (pn - 5) : (pn - 7)) * 256 + wc * 32 + 8 * fq;
#pragma unroll
            for (int ai = 0; ai < 2; ++ai)
#pragma unroll
                for (int m = 0; m < 4; ++m) { const int row = rowb + ai * 128 + m * 16 + fr; const float rs = rtab[ui * 256 + (row - u.pm * 256)];
                    const float cexp = -1.4426950408889634f * rs;
#pragma unroll
                    for (int bj = 0; bj < 2; ++bj) { f32x4 a = acc[ai][bj][m][0], b = acc[ai][bj][m][1];
                        if (isz) { a.x *= rs * __builtin_amdgcn_rcpf(1.f + __builtin_amdgcn_exp2f(a.x * cexp)); a.y *= rs * __builtin_amdgcn_rcpf(1.f + __builtin_amdgcn_exp2f(a.y * cexp)); a.z *= rs * __builtin_amdgcn_rcpf(1.f + __builtin_amdgcn_exp2f(a.z * cexp)); a.w *= rs * __builtin_amdgcn_rcpf(1.f + __builtin_amdgcn_exp2f(a.w * cexp));
                                   b.x *= rs * __builtin_amdgcn_rcpf(1.f + __builtin_amdgcn_exp2f(b.x * cexp)); b.y *= rs * __builtin_amdgcn_rcpf(1.f + __builtin_amdgcn_exp2f(b.y * cexp)); b.z *= rs * __builtin_amdgcn_rcpf(1.f + __builtin_amdgcn_exp2f(b.z * cexp)); b.w *= rs * __builtin_amdgcn_rcpf(1.f + __builtin_amdgcn_exp2f(b.w * cexp)); }
                        else { a = a * rs; b = b * rs; }
                        u32x4 w; w.x = pk2(a.x, a.y); w.y = pk2(a.z, a.w); w.z = pk2(b.x, b.y); w.w = pk2(b.z, b.w);
                        *(u32x4*)(base + (size_t)row * ld + c0 + 128 * bj) = w; } }
        }
    }
};
__device__ __forceinline__ void tr_item(const float* __restrict__ W, int ldw, int col0, int k0, const float* __restrict__ gain, bf16_t* __restrict__ dst, int K, int row0, LAS float* scr, int lane) {
    const int kr = lane >> 3, c4 = lane & 7;
    f32x4 v[8]; float gg[8];
#pragma unroll
    for (int i = 0; i < 8; ++i) { v[i] = __builtin_nontemporal_load((const f32x4*)(W + (size_t)(k0 + 8 * i + kr) * ldw + col0 + 4 * c4)); gg[i] = gain ? gain[k0 + 8 * i + kr] : 1.f; }
    asm volatile("" : "+v"(v[0]), "+v"(v[1]), "+v"(v[2]), "+v"(v[3]), "+v"(v[4]), "+v"(v[5]), "+v"(v[6]), "+v"(v[7]), "+v"(gg[0]), "+v"(gg[1]), "+v"(gg[2]), "+v"(gg[3]), "+v"(gg[4]), "+v"(gg[5]), "+v"(gg[6]), "+v"(gg[7]));
#pragma unroll
    for (int i = 0; i < 8; ++i) { const int kk = 8 * i + kr; LAS float* s = scr + kk * 33 + 4 * c4;
        s[0] = v[i].x * gg[i]; s[1] = v[i].y * gg[i]; s[2] = v[i].z * gg[i]; s[3] = v[i].w * gg[i]; }
    asm volatile("s_waitcnt lgkmcnt(0)" ::: "memory");
    const int c = lane & 7;
#pragma unroll
    for (int j = 0; j < 4; ++j) { const int n = (lane >> 3) + 8 * j; const LAS float* s = scr + (8 * c) * 33 + n;
        u32x4 o; o.x = pk2(s[0 * 33], s[1 * 33]); o.y = pk2(s[2 * 33], s[3 * 33]); o.z = pk2(s[4 * 33], s[5 * 33]); o.w = pk2(s[6 * 33], s[7 * 33]);
        *(u32x4*)(dst + (size_t)(row0 + n) * K + k0 + 8 * c) = o; }
    asm volatile("s_waitcnt lgkmcnt(0)" ::: "memory");
}
constexpr int IT_GU = 16 * 176, IT_WD = 44 * 32, IT_WIN = 16 * 88, IT_WOUT = 16 * 32;
constexpr int IT_TOTAL = 4 * IT_GU + 4 * IT_WD + 2 * IT_WIN + 2 * IT_WOUT;
__device__ __forceinline__ void p0_weights(const Args& a, LAS unsigned char* lds, int gw, int ngw, int wave, int lane_in) { int lane = lane_in;
    LAS float* scr = (LAS float*)(lds + wave * 16384);
    unsigned char* ws = a.ws;
    for (int it = gw; it < 4 * IT_GU; it += ngw) { const int mat = it / IT_GU, r = it % IT_GU; const int l = mat >> 1, f = mat & 1, kb = r / 176, gidx = r % 176, pn = gidx >> 3, gi = gidx & 7, bj = gi >> 2, wc = gi & 3;
        const float* W = (f ? (bj ? a.in[30] : a.in[29]) : (bj ? a.in[11] : a.in[10])) + (size_t)l * D * FF;
        tr_item(W, FF, 128 * pn + 32 * wc, 64 * kb, (f ? a.in[28] : a.in[9]) + l * D, (bf16_t*)(ws + WS_WGU + mat * SZ_WGU), D, 32 * gidx, scr, lane); }
    asm volatile("" : "+v"(lane));
    for (int it = gw; it < 4 * IT_WD; it += ngw) { const int mat = it / IT_WD, r = it % IT_WD; const int l = mat >> 1, f = mat & 1, kb = r / 32, gidx = r % 32;
        tr_item((f ? a.in[31] : a.in[12]) + (size_t)l * FF * D, D, 32 * gidx, 64 * kb, nullptr, (bf16_t*)(ws + WS_WD + mat * SZ_WD), FF, 32 * gidx, scr, lane); }
    asm volatile("" : "+v"(lane));
    for (int it = gw; it < 2 * IT_WIN; it += ngw) { const int l = it / IT_WIN, r = it % IT_WIN; const int kb = r / 88, gidx = r % 88, pn = gidx >> 3, gi = gidx & 7, bj = gi >> 2, wc = gi & 3;
        int col0;
        if (pn < 2) col0 = (bj ? 256 : 0) + 128 * pn + 32 * wc; else if (pn < 5) col0 = 512 + 256 * (pn - 2) + 64 * wc + 32 * bj; else col0 = 1280 + 256 * (pn - 5) + 32 * gi;
        tr_item(a.in[14] + (size_t)l * D * NIN, NIN, col0, 64 * kb, a.in[13] + l * D, (bf16_t*)(ws + WS_WIN + l * SZ_WIN), D, 32 * gidx, scr, lane); }
    asm volatile("" : "+v"(lane));
    for (int it = gw; it < 2 * IT_WOUT; it += ngw) { const int l = it / IT_WOUT, r = it % IT_WOUT; const int kb = r / 32, gidx = r % 32;
        tr_item(a.in[15] + (size_t)l * D * D, D, 32 * gidx, 64 * kb, nullptr, (bf16_t*)(ws + WS_WOUT + l * SZ_WOUT), D, 32 * gidx, scr, lane); }
}
__device__ __forceinline__ void p0_rows(const Args& a, int gw, int ngw, int lane) {
    unsigned char* ws = a.ws; bf16_t* XB = (bf16_t*)(ws + WS_XB); float* SSQ = (float*)(ws + WS_SSQ);
    for (int m0 = gw; m0 < MP; m0 += 4 * ngw) {
        f32x4 xv[4][4];
#pragma unroll
        for (int r = 0; r < 4; ++r) { const int m = m0 + r * ngw; if (m < MT) { const float* x = (m < MPR) ? a.in[0] + (size_t)m * D : a.in[1] + (size_t)(m - MPR) * D;
#pragma unroll
            for (int j = 0; j < 4; ++j) xv[r][j] = __builtin_nontemporal_load((const f32x4*)(x + 4 * lane + 256 * j)); } }
#pragma unroll
        for (int r = 0; r < 4; ++r) { const int m = m0 + r * ngw; if (m >= MP) continue;
            if (m < MT) { float s = 0.f;
#pragma unroll
                for (int j = 0; j < 4; ++j) { const f32x4 v = xv[r][j]; s += (v.x * v.x + v.y * v.y) + (v.z * v.z + v.w * v.w);
                    u32x2 w; w.x = pk2(v.x, v.y); w.y = pk2(v.z, v.w); *(u32x2*)(XB + (size_t)m * D + 4 * lane + 256 * j) = w; }
                s = wsum(s); if (lane < 16) SSQ[(size_t)m * 16 + lane] = (lane == 0) ? s : 0.f;
            } else {
#pragma unroll
                for (int j = 0; j < 4; ++j) *(u32x2*)(XB + (size_t)m * D + 4 * lane + 256 * j) = (u32x2){0u, 0u};
                if (lane < 16) SSQ[(size_t)m * 16 + lane] = 0.f; } }
    }
    float* WDT = (float*)(ws + WS_WDT);
    for (int i = gw * 64 + lane; i < 2 * 1024 * 8; i += ngw * 64) { const int l = i >> 13, k = (i >> 3) & 1023, h = i & 7; WDT[i] = a.in[13][l * D + k] * a.in[14][((size_t)l * D + k) * NIN + 2816 + h]; }
    bf16_t* WDTB = (bf16_t*)(ws + WS_WDTB);
    for (int i = gw * 64 + lane; i < 2 * 16 * 1024; i += ngw * 64) { const int l = i >> 14, n = (i >> 10) & 15, k = i & 1023; const float v = (n < 8) ? a.in[13][l * D + k] * a.in[14][((size_t)l * D + k) * NIN + 2816 + n] : 0.f; WDTB[i] = (bf16_t)(pk2(v, 0.f) & 0xffffu); }
    float* BT = (float*)(ws + WS_BT);
    for (int i = gw * 64 + lane; i < 4 * 129; i += ngw * 64) { const int h = i / 129, d = i % 129; int bucket;
        if (d < 16) bucket = d; else { const double v = log((double)d / 16.0) / log(8.0) * 16.0; const int lg = 16 + (int)v; bucket = lg < 31 ? lg : 31; }
        BT[i] = a.in[8][bucket * 4 + h] * 1.4426950408889634f; }
}
__device__ __forceinline__ void colmean_unit(const float* __restrict__ r0, const float* __restrict__ r1, float* __restrict__ out, LAS float* scr, int tid) {
    const int c4 = tid & 63, rg = tid >> 6; f32x4 s = {0.f, 0.f, 0.f, 0.f};
#pragma unroll
    for (int hlf = 0; hlf < 2; ++hlf) { const float* p = (hlf ? r1 : r0) + (size_t)rg * 256 + 4 * c4;
        f32x4 v[16];
#pragma unroll
        for (int r = 0; r < 16; ++r) v[r] = __builtin_nontemporal_load((const f32x4*)(p + (size_t)r * 8 * 256));
#pragma unroll
        for (int r = 0; r < 16; ++r) s += v[r]; }
    *(LAS f32x4*)(scr + rg * 256 + 4 * c4) = s;
    __syncthreads();
    if (tid < 256) { float t = 0.f;
#pragma unroll
        for (int g = 0; g < 8; ++g) t += scr[g * 256 + tid];
        out[tid] = t * (1.f / 256.f); }
    __syncthreads();
}

__device__ __forceinline__ void convA_unit(const Args& a, int l, int unit, LAS unsigned char* lds, int tid) {
    unsigned char* ws = a.ws; const float* U = (const float*)(ws + WS_U); bf16_t* MIX = (bf16_t*)(ws + WS_MIX);
    const int b = unit >> 7, t0 = (unit & 127) * 64, c = tid & 255, half = tid >> 8, tb = t0 + 32 * half;
    const float* wv = a.in[16] + l * 31 * 256 + c; const float bias = a.in[17][l * 256 + c];
    LAS float* T = (LAS float*)lds;
    float win[62], wj[31];
#pragma unroll
    for (int k = 0; k < 62; ++k) { const int t = tb - 30 + k; win[k] = (t >= 0) ? U[(size_t)(b * SEQ + t) * 256 + c] : 0.f; }
#pragma unroll
    for (int j = 0; j < 31; ++j) wj[j] = wv[j * 256];
    asm volatile("" : "+v"(wj[0]), "+v"(wj[1]), "+v"(wj[2]), "+v"(wj[3]), "+v"(wj[4]), "+v"(wj[5]), "+v"(wj[6]), "+v"(wj[7]), "+v"(wj[8]), "+v"(wj[9]), "+v"(wj[10]), "+v"(wj[11]), "+v"(wj[12]), "+v"(wj[13]), "+v"(wj[14]), "+v"(wj[15]),
                 "+v"(wj[16]), "+v"(wj[17]), "+v"(wj[18]), "+v"(wj[19]), "+v"(wj[20]), "+v"(wj[21]), "+v"(wj[22]), "+v"(wj[23]), "+v"(wj[24]), "+v"(wj[25]), "+v"(wj[26]), "+v"(wj[27]), "+v"(wj[28]), "+v"(wj[29]));
    asm volatile("" : "+v"(wj[30]), "+v"(win[0]), "+v"(win[8]), "+v"(win[16]), "+v"(win[24]), "+v"(win[32]), "+v"(win[40]), "+v"(win[48]), "+v"(win[56]), "+v"(win[61]));
    float o[32];
#pragma unroll
    for (int i = 0; i < 32; ++i) o[i] = bias;
#pragma unroll
    for (int j = 0; j < 31; ++j) { const float w = wj[j];
#pragma unroll
        for (int i = 0; i < 32; ++i) o[i] = fmaf(w, win[i + j], o[i]); }
#pragma unroll
    for (int i = 0; i < 32; ++i) T[(32 * half + i) * 260 + c] = o[i];
    __syncthreads();
    const int wave = tid >> 6, lane = tid & 63;
    const f32x4 g = *(const f32x4*)(a.in[18] + l * 256 + 4 * lane), bb = *(const f32x4*)(a.in[19] + l * 256 + 4 * lane);
#pragma unroll
    for (int r = 0; r < 8; ++r) { const int row = 8 * wave + r; f32x4 v = *(const LAS f32x4*)(T + row * 260 + 4 * lane);
        const float mean = wsum((v.x + v.y) + (v.z + v.w)) * (1.f / 256.f); v = v - mean;
        const float rs = rsqrtf(wsum((v.x * v.x + v.y * v.y) + (v.z * v.z + v.w * v.w)) * (1.f / 256.f) + 1e-5f);
        v = v * rs * g + bb; u32x2 w; w.x = pk2(fsilu(v.x), fsilu(v.y)); w.y = pk2(fsilu(v.z), fsilu(v.w));
        *(u32x2*)(MIX + (size_t)(b * SEQ + t0 + row) * D + 4 * lane) = w; }
    if (t0 == SEQ - 64) { float* cp = a.out + O_CP + (size_t)(l * 2 + b) * 30 * 256;
        float cv[15];
#pragma unroll
        for (int i = 0; i < 15; ++i) cv[i] = U[(size_t)(b * SEQ + SEQ - 30) * 256 + tid + NTHR * i];
        asm volatile("" : "+v"(cv[0]), "+v"(cv[1]), "+v"(cv[2]), "+v"(cv[3]), "+v"(cv[4]), "+v"(cv[5]), "+v"(cv[6]), "+v"(cv[7]), "+v"(cv[8]), "+v"(cv[9]), "+v"(cv[10]), "+v"(cv[11]), "+v"(cv[12]), "+v"(cv[13]), "+v"(cv[14]));
#pragma unroll
        for (int i = 0; i < 15; ++i) cp[tid + NTHR * i] = cv[i]; }
    __syncthreads();
}
__device__ __forceinline__ void convA_sample_unit(const Args& a, int l, int sb, LAS unsigned char* lds, int tid) {
    unsigned char* ws = a.ws; const float* U = (const float*)(ws + WS_U); bf16_t* MIX = (bf16_t*)(ws + WS_MIX);
    const int c = tid & 255, half = tid >> 8; const float* wv = a.in[16] + l * 31 * 256 + c;
    const float* st = a.in[4] + ((size_t)l * 32 + sb) * 30 * 256 + c; float* cs = a.out + O_CS + ((size_t)l * 32 + sb) * 30 * 256 + c;
    LAS float* P = (LAS float*)lds;
    const float un = U[(size_t)(MPR + sb) * 256 + c];
    float sv[16], wj[16];
#pragma unroll
    for (int j = 0; j < 16; ++j) { const int jj = 16 * half + j; sv[j] = (jj < 30) ? st[(size_t)jj * 256] : un; wj[j] = (jj < 31) ? wv[jj * 256] : 0.f; }
    float acc = half ? 0.f : a.in[17][l * 256 + c];
    asm volatile("" : "+v"(sv[0]), "+v"(sv[1]), "+v"(sv[2]), "+v"(sv[3]), "+v"(sv[4]), "+v"(sv[5]), "+v"(sv[6]), "+v"(sv[7]), "+v"(sv[8]), "+v"(sv[9]), "+v"(sv[10]), "+v"(sv[11]), "+v"(sv[12]), "+v"(sv[13]), "+v"(sv[14]), "+v"(sv[15]), "+v"(acc));
    asm volatile("" : "+v"(wj[0]), "+v"(wj[1]), "+v"(wj[2]), "+v"(wj[3]), "+v"(wj[4]), "+v"(wj[5]), "+v"(wj[6]), "+v"(wj[7]), "+v"(wj[8]), "+v"(wj[9]), "+v"(wj[10]), "+v"(wj[11]), "+v"(wj[12]), "+v"(wj[13]), "+v"(wj[14]), "+v"(wj[15]));
#pragma unroll
    for (int j = 0; j < 16; ++j) { const int jj = 16 * half + j; if (jj < 31) { acc = fmaf(wj[j], sv[j], acc); if (jj >= 1) cs[(size_t)(jj - 1) * 256] = sv[j]; } }
    P[half * 256 + c] = acc;
    __syncthreads();
    if (tid < 64) { const int lane = tid; f32x4 v = *(const LAS f32x4*)(P + 4 * lane) + *(const LAS f32x4*)(P + 256 + 4 * lane);
        const f32x4 g = *(const f32x4*)(a.in[18] + l * 256 + 4 * lane), bb = *(const f32x4*)(a.in[19] + l * 256 + 4 * lane);
        const float mean = wsum((v.x + v.y) + (v.z + v.w)) * (1.f / 256.f); v = v - mean;
        const float rs = rsqrtf(wsum((v.x * v.x + v.y * v.y) + (v.z * v.z + v.w * v.w)) * (1.f / 256.f) + 1e-5f);
        v = v * rs * g + bb; u32x2 w; w.x = pk2(fsilu(v.x), fsilu(v.y)); w.y = pk2(fsilu(v.z), fsilu(v.w));
        *(u32x2*)(MIX + (size_t)(MPR + sb) * D + 4 * lane) = w; }
    __syncthreads();
}
__device__ __forceinline__ void conv4_unit(const Args& a, int l, int unit, int tid) {
    unsigned char* ws = a.ws; const bf16_t* XR = (const bf16_t*)(ws + WS_XR); bf16_t* XC = (bf16_t*)(ws + WS_XC);
    if (unit < 256) {
        const int c8 = 8 * (tid & 127), rg = tid >> 7, b = unit >> 7, t0 = (unit & 127) * 64 + 16 * rg; const size_t r0 = (size_t)b * SEQ + t0;
        const float* w = a.in[22] + l * 4 * 1024 + c8; const float* bp = a.in[23] + l * 1024 + c8;
        u32x4 raw[19];
#pragma unroll
        for (int i = 0; i < 19; ++i) raw[i] = (t0 + i - 3 >= 0) ? *(const u32x4*)(XR + (r0 + i - 3) * 1024 + c8) : (u32x4){0u, 0u, 0u, 0u};
        float wf[4][8], bf[8];
#pragma unroll
        for (int j = 0; j < 4; ++j) { const f32x4 wa = *(const f32x4*)(w + j * 1024), wb = *(const f32x4*)(w + j * 1024 + 4); wf[j][0] = wa.x; wf[j][1] = wa.y; wf[j][2] = wa.z; wf[j][3] = wa.w; wf[j][4] = wb.x; wf[j][5] = wb.y; wf[j][6] = wb.z; wf[j][7] = wb.w; }
        { const f32x4 ba = *(const f32x4*)bp, bb = *(const f32x4*)(bp + 4); bf[0] = ba.x; bf[1] = ba.y; bf[2] = ba.z; bf[3] = ba.w; bf[4] = bb.x; bf[5] = bb.y; bf[6] = bb.z; bf[7] = bb.w; }
        float win[4][8];
#pragma unroll
        for (int i = 0; i < 3; ++i) { win[i][0] = bflo(raw[i].x); win[i][1] = bfhi(raw[i].x); win[i][2] = bflo(raw[i].y); win[i][3] = bfhi(raw[i].y); win[i][4] = bflo(raw[i].z); win[i][5] = bfhi(raw[i].z); win[i][6] = bflo(raw[i].w); win[i][7] = bfhi(raw[i].w); }
#pragma unroll
        for (int i = 0; i < 16; ++i) { const u32x4 rr = raw[i + 3]; const int s3 = (i + 3) & 3;
            win[s3][0] = bflo(rr.x); win[s3][1] = bfhi(rr.x); win[s3][2] = bflo(rr.y); win[s3][3] = bfhi(rr.y); win[s3][4] = bflo(rr.z); win[s3][5] = bfhi(rr.z); win[s3][6] = bflo(rr.w); win[s3][7] = bfhi(rr.w);
            float o[8];
#pragma unroll
            for (int e = 0; e < 8; ++e) { float v = bf[e];
#pragma unroll
                for (int j = 0; j < 4; ++j) v = fmaf(wf[j][e], win[(i + j) & 3][e], v);
                o[e] = fsilu(v); }
            u32x4 ow; ow.x = pk2(o[0], o[1]); ow.y = pk2(o[2], o[3]); ow.z = pk2(o[4], o[5]); ow.w = pk2(o[6], o[7]);
            *(u32x4*)(XC + (r0 + i) * 1024 + c8) = ow; }
        if (t0 == SEQ - 16) { float* sp = a.out + O_SCP + (size_t)(l * 2 + b) * 3 * 1024 + c8;
#pragma unroll
            for (int i = 0; i < 3; ++i) { const u32x4 rr = raw[16 + i]; *(f32x4*)(sp + i * 1024) = (f32x4){bflo(rr.x), bfhi(rr.x), bflo(rr.y), bfhi(rr.y)}; *(f32x4*)(sp + i * 1024 + 4) = (f32x4){bflo(rr.z), bfhi(rr.z), bflo(rr.w), bfhi(rr.w)}; } }
    } else {
        const int c = 2 * tid; const float* w = a.in[22] + l * 4 * 1024 + c; const f32x2 bias = *(const f32x2*)(a.in[23] + l * 1024 + c);
        const f32x2 w0 = *(const f32x2*)(w), w1 = *(const f32x2*)(w + 1024), w2 = *(const f32x2*)(w + 2048), w3 = *(const f32x2*)(w + 3072);
        const float* st = a.in[5] + (size_t)l * 32 * 3 * 1024 + c; float* so = a.out + O_SCS + (size_t)l * 32 * 3 * 1024 + c;
        f32x2 q3[8], q2[8], q1[8]; unsigned ur[8];
#pragma unroll
        for (int k = 0; k < 8; ++k) { const int sb = 8 * (unit - 256) + k;
            q3[k] = *(const f32x2*)(st + (size_t)(sb * 3 + 0) * 1024); q2[k] = *(const f32x2*)(st + (size_t)(sb * 3 + 1) * 1024); q1[k] = *(const f32x2*)(st + (size_t)(sb * 3 + 2) * 1024);
            ur[k] = *(const unsigned*)(XR + (size_t)(MPR + sb) * 1024 + c); }
#pragma unroll
        for (int k = 0; k < 8; ++k) asm volatile("" : "+v"(q3[k]), "+v"(q2[k]), "+v"(q1[k]), "+v"(ur[k]));
#pragma unroll
        for (int k = 0; k < 8; ++k) { const int sb = 8 * (unit - 256) + k; const f32x2 raw = {bflo(ur[k]), bfhi(ur[k])};
            const f32x2 v = bias + w0 * q3[k] + w1 * q2[k] + w2 * q1[k] + w3 * raw;
            *(unsigned*)(XC + (size_t)(MPR + sb) * 1024 + c) = pk2(fsilu(v.x), fsilu(v.y));
            *(f32x2*)(so + (size_t)(sb * 3 + 0) * 1024) = q2[k]; *(f32x2*)(so + (size_t)(sb * 3 + 1) * 1024) = q1[k]; *(f32x2*)(so + (size_t)(sb * 3 + 2) * 1024) = raw; }
    }
}
__device__ __forceinline__ void dt_row(const Args& a, int l, int row, int lane) {
    unsigned char* ws = a.ws; const bf16_t* XBr = (const bf16_t*)(ws + WS_XB) + (size_t)row * D; const float* WDT = (const float*)(ws + WS_WDT) + l * 1024 * 8;
    float acc[8];
#pragma unroll
    for (int h = 0; h < 8; ++h) acc[h] = 0.f;
#pragma unroll
    for (int j = 0; j < 4; ++j) { const int k = 4 * lane + 256 * j; const u32x2 xw = *(const u32x2*)(XBr + k); const f32x4 x = {bflo(xw.x), bfhi(xw.x), bflo(xw.y), bfhi(xw.y)};
#pragma unroll
        for (int e = 0; e < 4; ++e) { const f32x4 wa = *(const f32x4*)(WDT + (k + e) * 8), wb = *(const f32x4*)(WDT + (k + e) * 8 + 4); const float xv = x[e];
            acc[0] = fmaf(xv, wa.x, acc[0]); acc[1] = fmaf(xv, wa.y, acc[1]); acc[2] = fmaf(xv, wa.z, acc[2]); acc[3] = fmaf(xv, wa.w, acc[3]);
            acc[4] = fmaf(xv, wb.x, acc[4]); acc[5] = fmaf(xv, wb.y, acc[5]); acc[6] = fmaf(xv, wb.z, acc[6]); acc[7] = fmaf(xv, wb.w, acc[7]); } }
    const float rs = rstd16((const float*)(ws + WS_SSQ) + (size_t)row * 16);
    float mine = 0.f;
#pragma unroll
    for (int h = 0; h < 8; ++h) { const float s = wsum(acc[h]); if (lane == h) mine = s; }
    if (lane < 8) { const float x = rs * mine + a.in[24][l * 8 + lane]; ((float*)(ws + WS_DT))[(size_t)row * 8 + lane] = fmaxf(x, 0.f) + log1pf(expf(-fabsf(x))); }
}
__device__ __forceinline__ void final_rows4(const Args& a, int l, int row0, int rstride, int lane) {
    unsigned char* ws = a.ws; const float* g = a.in[32] + l * D;
    u32x2 w[4][4];
#pragma unroll
    for (int r = 0; r < 4; ++r) { const int row = row0 + r * rstride; if (row < MT) {
#pragma unroll
        for (int j = 0; j < 4; ++j) w[r][j] = *(const u32x2*)((const bf16_t*)(ws + WS_XB) + (size_t)row * D + 4 * lane + 256 * j); } }
    f32x4 gg[4];
#pragma unroll
    for (int j = 0; j < 4; ++j) gg[j] = *(const f32x4*)(g + 4 * lane + 256 * j);
#pragma unroll
    for (int r = 0; r < 4; ++r) { const int row = row0 + r * rstride; if (row < MT) { f32x4 v[4]; float s = 0.f;
#pragma unroll
        for (int j = 0; j < 4; ++j) { v[j] = (f32x4){bflo(w[r][j].x), bfhi(w[r][j].x), bflo(w[r][j].y), bfhi(w[r][j].y)}; s += (v[j].x * v[j].x + v[j].y * v[j].y) + (v[j].z * v[j].z + v[j].w * v[j].w); }
        const float rs = rsqrtf(wsum(s) * (1.f / 1024.f) + 1e-6f);
        float* o = row < MPR ? a.out + O_YP + (size_t)row * D : a.out + O_YS + (size_t)(row - MPR) * D;
#pragma unroll
        for (int j = 0; j < 4; ++j) *(f32x4*)(o + 4 * lane + 256 * j) = v[j] * rs * gg[j]; } }
}
__device__ __forceinline__ void attn_simple(const Args& a, int l, int item, LAS float* L, int ht, bf16_t* outp = nullptr) {
    unsigned char* ws = a.ws;
    const bf16_t* QB = (const bf16_t*)(ws + WS_QB); const bf16_t* KB = (const bf16_t*)(ws + WS_KB); const bf16_t* VB = (const bf16_t*)(ws + WS_VB);
    const float* KMP = (const float*)(ws + WS_KMP); const float* KMS = (const float*)(ws + WS_KMS) + (size_t)l * 1024 * 256; const float* BT = (const float*)(ws + WS_BT);
    const float* cachek = a.in[2] + (size_t)l * CACHE_L; const float* cachev = a.in[3] + (size_t)l * CACHE_L; const int* pt = (const int*)a.in[7];
    bf16_t* MIX = outp ? outp : (bf16_t*)(ws + WS_MIX);
    LAS float* qs = L; LAS float* gate = L + 64; LAS int* sel = (LAS int*)(L + 96); LAS float* lg = L + 128; LAS float* red = L + 1152; LAS float* osum = L + 1408;
    const int m = item >> 2, h = item & 3; const bool smp = m >= MPR; const int b = m >> 13, t = m & 8191, sb = m - MPR;
    const int qpos = smp ? 8192 : t, cur = qpos >> 8;
    if (ht < 64) qs[ht] = bf1(QB[(size_t)m * 256 + h * 64 + ht]);
    __syncthreads();
    if (ht < cur) { const float* km = (smp ? KMS + (size_t)(sb * 32 + ht) * 256 : KMP + (size_t)(b * 32 + ht) * 256) + h * 64; float g = 0.f; for (int d = 0; d < 64; ++d) g = fmaf(qs[d], km[d], g); gate[ht] = g; }
    __syncthreads();
    if (ht == 0) { const int cnt = cur < 3 ? cur : 3; int s0 = -1, s1 = -1, s2 = -1;
        for (int j = 0; j < cnt; ++j) { int best = -1; float bv = 0.f;
            for (int n = 0; n < cur; ++n) { if (n == s0 || n == s1) continue; if (best < 0 || gate[n] > bv) { best = n; bv = gate[n]; } }
            if (j == 0) s0 = best; else if (j == 1) s1 = best; else s2 = best; }
        sel[0] = s0; sel[1] = s1; sel[2] = s2; sel[cnt] = cur; sel[4] = cnt; }
    __syncthreads();
    const int cnt = sel[4]; float mx = -INFINITY;
    for (int j = 0; j <= cnt; ++j) { const int blk = sel[j], kpos = blk * 256 + ht; float lgt = -INFINITY;
        if (kpos <= qpos) { float acc = 0.f;
            if (smp && blk < 32) { const float* kp = cachek + ((size_t)pt[sb * NPAGES + (kpos >> 7)] * 128 + (kpos & 127)) * 256 + h * 64;
                for (int d = 0; d < 64; ++d) acc = fmaf(qs[d], kp[d], acc);
            } else { const bf16_t* kp = KB + (size_t)(smp ? m : b * SEQ + kpos) * 256 + h * 64;
                for (int d8 = 0; d8 < 8; ++d8) { const u32x4 w = *(const u32x4*)(kp + 8 * d8);
                    acc = fmaf(qs[8 * d8 + 0], bflo(w.x), acc); acc = fmaf(qs[8 * d8 + 1], bfhi(w.x), acc); acc = fmaf(qs[8 * d8 + 2], bflo(w.y), acc); acc = fmaf(qs[8 * d8 + 3], bfhi(w.y), acc);
                    acc = fmaf(qs[8 * d8 + 4], bflo(w.z), acc); acc = fmaf(qs[8 * d8 + 5], bfhi(w.z), acc); acc = fmaf(qs[8 * d8 + 6], bflo(w.w), acc); acc = fmaf(qs[8 * d8 + 7], bfhi(w.w), acc); } }
            const int dist = qpos - kpos; lgt = acc + BT[h * 129 + (dist < 128 ? dist : 128)]; }
        lg[j * 256 + ht] = lgt; mx = fmaxf(mx, lgt); }
    red[ht] = mx; __syncthreads();
    for (int o = 128; o > 0; o >>= 1) { if (ht < o) red[ht] = fmaxf(red[ht], red[ht + o]); __syncthreads(); }
    mx = red[0]; __syncthreads();
    float ps = 0.f;
    for (int j = 0; j <= cnt; ++j) { const float p = expf(lg[j * 256 + ht] - mx); lg[j * 256 + ht] = p; ps += p; }
    red[ht] = ps; __syncthreads();
    for (int o = 128; o > 0; o >>= 1) { if (ht < o) red[ht] += red[ht + o]; __syncthreads(); }
    const float tot = red[0];
    { const int j = ht >> 6, d = ht & 63; float acc = 0.f;
      if (j <= cnt) { const int blk = sel[j];
        for (int s = 0; s < 256; ++s) { const float p = lg[j * 256 + s]; if (p == 0.f) continue; const int kpos = blk * 256 + s; float v;
            if (smp && blk < 32) v = cachev[((size_t)pt[sb * NPAGES + (kpos >> 7)] * 128 + (kpos & 127)) * 256 + h * 64 + d];
            else v = bf1(VB[(size_t)(smp ? m : b * SEQ + kpos) * 256 + h * 64 + d]);
            acc = fmaf(p, v, acc); } }
      osum[j * 64 + d] = acc; }
    __syncthreads();
    if (ht < 64) { const float o = (osum[ht] + osum[64 + ht] + osum[128 + ht] + osum[192 + ht]) / tot; MIX[(size_t)m * D + 256 + h * 64 + ht] = (bf16_t)(pk2(o, 0.f) & 0xffffu); }
    __syncthreads();
}
__device__ __forceinline__ void ssd_seq_item(const Args& a, int l, int wv, int lane) {
    unsigned char* ws = a.ws; const bf16_t* XC = (const bf16_t*)(ws + WS_XC); const float* DT = (const float*)(ws + WS_DT); float* Y = (float*)(ws + WS_Y);
    const int seq = wv >> 9, h = (wv >> 6) & 7, p = wv & 63, g = h >> 2;
    const float A = -expf(a.in[25][l * 8 + h]);
    const bool smp = seq >= 2; const int T = smp ? 1 : SEQ; const size_t row0 = smp ? (size_t)MPR + (seq - 2) : (size_t)seq * SEQ;
    float h0 = 0.f, h1 = 0.f;
    if (smp) { const float* s = a.in[6] + (size_t)l * 32 * 8 * 64 * 128 + ((size_t)((seq - 2) * 8 + h) * 64 + p) * 128; h0 = s[lane]; h1 = s[lane + 64]; }
    const bf16_t* xc = XC + row0 * 1024; const float* dt = DT + row0 * 8;
    float dtv = dt[h], xv = bf1(xc[h * 64 + p]), b0 = bf1(xc[512 + g * 128 + lane]), b1 = bf1(xc[512 + g * 128 + 64 + lane]), c0 = bf1(xc[768 + g * 128 + lane]), c1 = bf1(xc[768 + g * 128 + 64 + lane]);
    for (int t = 0; t < T; ++t) {
        float ndt = 0.f, nx = 0.f, nb0 = 0.f, nb1 = 0.f, nc0 = 0.f, nc1 = 0.f;
        if (t + 1 < T) { const bf16_t* x2 = xc + (size_t)(t + 1) * 1024; ndt = dt[(size_t)(t + 1) * 8 + h]; nx = bf1(x2[h * 64 + p]); nb0 = bf1(x2[512 + g * 128 + lane]); nb1 = bf1(x2[512 + g * 128 + 64 + lane]); nc0 = bf1(x2[768 + g * 128 + lane]); nc1 = bf1(x2[768 + g * 128 + 64 + lane]); }
        const float dA = expf(dtv * A), xd = dtv * xv;
        h0 = fmaf(h0, dA, xd * b0); h1 = fmaf(h1, dA, xd * b1);
        const float y = wsum(c0 * h0 + c1 * h1);
        if (lane == 0) Y[(row0 + t) * 512 + h * 64 + p] = y;
        dtv = ndt; xv = nx; b0 = nb0; b1 = nb1; c0 = nc0; c1 = nc1;
    }
    float* o = smp ? a.out + O_HS + (size_t)l * 32 * 8 * 64 * 128 + ((size_t)((seq - 2) * 8 + h) * 64 + p) * 128 : a.out + O_HP + (size_t)l * 2 * 8 * 64 * 128 + ((size_t)(seq * 8 + h) * 64 + p) * 128;
    o[lane] = h0; o[lane + 64] = h1;
}
__device__ __forceinline__ void ssm_out_row(const Args& a, int l, int row, int lane) {
    unsigned char* ws = a.ws; const u32x4 yw = *(const u32x4*)((const bf16_t*)(ws + WS_Y) + (size_t)row * 512 + 8 * lane);
    const u32x4 xw = *(const u32x4*)((const bf16_t*)(ws + WS_XC) + (size_t)row * 1024 + 8 * lane), zw = *(const u32x4*)((const bf16_t*)(ws + WS_ZS) + (size_t)row * 512 + 8 * lane);
    const f32x4 y0 = {bflo(yw.x), bfhi(yw.x), bflo(yw.y), bfhi(yw.y)}, y1 = {bflo(yw.z), bfhi(yw.z), bflo(yw.w), bfhi(yw.w)}; const float Dh = a.in[26][l * 8 + (lane >> 3)];
    float v[8];
    v[0] = (y0.x + Dh * bflo(xw.x)) * bflo(zw.x); v[1] = (y0.y + Dh * bfhi(xw.x)) * bfhi(zw.x); v[2] = (y0.z + Dh * bflo(xw.y)) * bflo(zw.y); v[3] = (y0.w + Dh * bfhi(xw.y)) * bfhi(zw.y);
    v[4] = (y1.x + Dh * bflo(xw.z)) * bflo(zw.z); v[5] = (y1.y + Dh * bfhi(xw.z)) * bfhi(zw.z); v[6] = (y1.z + Dh * bflo(xw.w)) * bflo(zw.w); v[7] = (y1.w + Dh * bfhi(xw.w)) * bfhi(zw.w);
    float s = 0.f;
#pragma unroll
    for (int k = 0; k < 8; ++k) s += v[k] * v[k];
    const float rs = rsqrtf(wsum(s) * (1.f / 512.f) + 1e-6f);
    const f32x4 g0 = *(const f32x4*)(a.in[27] + l * 512 + 8 * lane), g1 = *(const f32x4*)(a.in[27] + l * 512 + 8 * lane + 4);
    u32x4 w; w.x = pk2(v[0] * rs * g0.x, v[1] * rs * g0.y); w.y = pk2(v[2] * rs * g0.z, v[3] * rs * g0.w); w.z = pk2(v[4] * rs * g1.x, v[5] * rs * g1.y); w.w = pk2(v[6] * rs * g1.z, v[7] * rs * g1.w);
    *(u32x4*)((bf16_t*)(ws + WS_MIX) + (size_t)row * D + 512 + 8 * lane) = w;
}
#define MFMA16(a, b, c) __builtin_amdgcn_mfma_f32_16x16x32_bf16((a), (b), (c), 0, 0, 0)
__device__ __forceinline__ bf16x8 mk8(u32x4 v) { return __builtin_bit_cast(bf16x8, v); }
__device__ __forceinline__ bf16x8 mk8(u32x2 lo, u32x2 hi) { u32x4 v; v.x = lo.x; v.y = lo.y; v.z = hi.x; v.w = hi.y; return __builtin_bit_cast(bf16x8, v); }

__device__ __forceinline__ void dtslab_unit(const Args& a, int l, int unit, LAS unsigned char* lds, int tid) {
    unsigned char* ws = a.ws; const int lane = tid & 63, wave = __builtin_amdgcn_readfirstlane(tid >> 6), fr = lane & 15, gq = lane >> 4, rt = wave >> 1, kh = wave & 1;
    const size_t r0 = (size_t)unit * 64;
    LAS float* part = (LAS float*)lds;
    LAS float* dAs = part + 1024;
    const bf16_t* WB = (const bf16_t*)(ws + WS_WDTB) + (size_t)l * 16 * 1024 + fr * 1024 + 512 * kh + 8 * gq;
    const bf16_t* xr = (const bf16_t*)(ws + WS_XB) + (r0 + 16 * rt + fr) * D + 512 * kh + 8 * gq;
    u32x4 xa[16], wb[16];
#pragma unroll
    for (int ks = 0; ks < 16; ++ks) { xa[ks] = *(const u32x4*)(xr + 32 * ks); wb[ks] = *(const u32x4*)(WB + 32 * ks); }
    float rs_pre = rstd16((const float*)(ws + WS_SSQ) + (r0 + (tid >> 3)) * 16);
    float dtb_pre = a.in[24][l * 8 + (tid & 7)], alog_pre = a.in[25][l * 8 + (tid & 7)];
    asm volatile("" : "+v"(rs_pre), "+v"(dtb_pre), "+v"(alog_pre));
#pragma unroll
    for (int ks = 0; ks < 16; ks += 4) { asm volatile("" : "+v"(xa[ks]), "+v"(xa[ks + 1]), "+v"(xa[ks + 2]), "+v"(xa[ks + 3]), "+v"(wb[ks]), "+v"(wb[ks + 1]), "+v"(wb[ks + 2]), "+v"(wb[ks + 3])); }
    f32x4 acc = {0.f, 0.f, 0.f, 0.f};
#pragma unroll
    for (int ks = 0; ks < 16; ++ks) acc = MFMA16(mk8(xa[ks]), mk8(wb[ks]), acc);
    if (fr < 8) {
#pragma unroll
        for (int r = 0; r < 4; ++r) part[(kh * 64 + 16 * rt + 4 * gq + r) * 8 + fr] = acc[r]; }
    __syncthreads();
    { const int lr = tid >> 3, h = tid & 7; const size_t row = r0 + lr; const float rs = rs_pre;
      const float x = rs * (part[lr * 8 + h] + part[(64 + lr) * 8 + h]) + dtb_pre; const float dtv = fmaxf(x, 0.f) + log1pf(expf(-fabsf(x)));
      ((float*)(ws + WS_DT))[row * 8 + h] = dtv; dAs[lr * 8 + h] = dtv * -expf(alog_pre); }
    __syncthreads();
    if (wave == 0) { float* AC = (float*)(ws + WS_ACUM) + (r0 + lane) * 8; float* TOT = (float*)(ws + WS_TOT) + (size_t)unit * 8;
#pragma unroll
        for (int h = 0; h < 8; ++h) { float inc = dAs[lane * 8 + h];
#pragma unroll
            for (int o = 1; o < 64; o <<= 1) { const float t = __shfl_up(inc, o); if (lane >= o) inc += t; }
            AC[h] = inc; if (lane == 63) TOT[h] = inc; } }
    __syncthreads();
}
constexpr int SA_BM = 0, SA_XT = 69632, SA_XT2 = SA_XT + 33792, SA_AC = SA_XT2 + 33792;
__device__ __forceinline__ void ssdA_unit(const Args& a, int l, int unit, LAS unsigned char* lds, int tid) {
    unsigned char* ws = a.ws; const int lane = tid & 63, wave = __builtin_amdgcn_readfirstlane(tid >> 6), fr = lane & 15, gq = lane >> 4;
    const int h = unit & 7, g = h >> 2; const size_t r0 = (size_t)(unit >> 3) * 256;
    const bf16_t* XC = (const bf16_t*)(ws + WS_XC); const float* DT = (const float*)(ws + WS_DT); const float* ACUM = (const float*)(ws + WS_ACUM);
    LAS bf16_t* Bm = (LAS bf16_t*)(lds + SA_BM); LAS bf16_t* XT = (LAS bf16_t*)(lds + SA_XT); LAS bf16_t* XT2 = (LAS bf16_t*)(lds + SA_XT2); LAS float* acs = (LAS float*)(lds + SA_AC);
    u32x4 cpre[2][4];
#pragma unroll
    for (int which = 0; which < 2; ++which)
#pragma unroll
        for (int kk = 0; kk < 4; ++kk) cpre[which][kk] = *(const u32x4*)(XC + (r0 + 16 * (which ? 15 - wave : wave) + fr) * 1024 + 768 + g * 128 + 32 * kk + 8 * gq);
#ifndef SSDA_RB
#define SSDA_RB 1
#endif
#ifndef SSDA_RX
#define SSDA_RX 1
#endif
    u32x4 bst[8];
#pragma unroll
    for (int pass = 0; pass < 8; ++pass) { const int row = pass * 32 + (tid >> 4), ch = tid & 15; bst[pass] = *(const u32x4*)(XC + (r0 + row) * 1024 + 512 + g * 128 + 8 * ch); }
    const float* TOT = (const float*)(ws + WS_TOT) + (size_t)(unit >> 3) * 4 * 8 + h;
    float t0 = TOT[0], t1 = TOT[8], t2 = TOT[16], t3 = TOT[24];
    u32x4 xvp[4]; float dtp[4], acp[4];
#pragma unroll
    for (int pass = 0; pass < 4; ++pass) { const int s = pass * 64 + lane; xvp[pass] = *(const u32x4*)(XC + (r0 + s) * 1024 + h * 64 + 8 * wave); dtp[pass] = DT[(r0 + s) * 8 + h]; acp[pass] = ACUM[(r0 + s) * 8 + h]; }
    asm volatile("" : "+v"(bst[0]), "+v"(bst[1]), "+v"(bst[2]), "+v"(bst[3]), "+v"(bst[4]), "+v"(bst[5]), "+v"(bst[6]), "+v"(bst[7]), "+v"(t0), "+v"(t1), "+v"(t2), "+v"(t3),
                 "+v"(xvp[0]), "+v"(xvp[1]), "+v"(xvp[2]), "+v"(xvp[3]), "+v"(dtp[0]), "+v"(dtp[1]), "+v"(dtp[2]), "+v"(dtp[3]), "+v"(acp[0]), "+v"(acp[1]), "+v"(acp[2]), "+v"(acp[3]));
#pragma unroll
    for (int pass = 0; pass < 8; ++pass) { const int row = pass * 32 + (tid >> 4), ch = tid & 15; *(LAS u32x4*)(Bm + row * 136 + 8 * ch) = bst[pass]; }
    const float ac_end = ((t0 + t1) + t2) + t3;
    if (tid == 0) ((float*)(ws + WS_CT))[unit] = ac_end;
    for (int rrx_ = 0; rrx_ < SSDA_RX; ++rrx_)
#pragma unroll
    for (int pass = 0; pass < 4; ++pass) { const int s = pass * 64 + lane;
        const u32x4 v = xvp[pass]; const float dtv = dtp[pass], acv = acp[pass] + (pass == 0 ? 0.f : pass == 1 ? t0 : pass == 2 ? (t0 + t1) : ((t0 + t1) + t2)); const float e = expf(ac_end - acv);
        if (wave == 0) acs[s] = acv;
        float x[8]; x[0] = bflo(v.x); x[1] = bfhi(v.x); x[2] = bflo(v.y); x[3] = bfhi(v.y); x[4] = bflo(v.z); x[5] = bfhi(v.z); x[6] = bflo(v.w); x[7] = bfhi(v.w);
#pragma unroll
        for (int i = 0; i < 8; ++i) { const float xd = x[i] * dtv; const unsigned w = pk2(xd, xd * e); XT[(8 * wave + i) * 264 + s] = (bf16_t)(w & 0xffffu); XT2[(8 * wave + i) * 264 + s] = (bf16_t)(w >> 16); } }
    __syncthreads();
#ifndef SSDA_R1
#define SSDA_R1 1
#endif
#ifndef SSDA_R2
#define SSDA_R2 1
#endif
#ifndef SSDA_R0
#define SSDA_R0 1
#endif
    for (int rr1_ = 0; rr1_ < SSDA_R1; ++rr1_) { f32x4 acc[4];
#pragma unroll
      for (int pt = 0; pt < 4; ++pt) acc[pt] = (f32x4){0.f, 0.f, 0.f, 0.f};
#pragma unroll 2
      for (int ks = 0; ks < 8; ++ks) { const LAS bf16_t* bp = Bm + (32 * ks + 8 * gq) * 136 + 16 * wave + fr;
          u32x4 av; av.x = (unsigned)bp[0] | ((unsigned)bp[136] << 16); av.y = (unsigned)bp[2 * 136] | ((unsigned)bp[3 * 136] << 16); av.z = (unsigned)bp[4 * 136] | ((unsigned)bp[5 * 136] << 16); av.w = (unsigned)bp[6 * 136] | ((unsigned)bp[7 * 136] << 16);
          const bf16x8 A = mk8(av);
#pragma unroll
          for (int pt = 0; pt < 4; ++pt) { const bf16x8 Bf = mk8(*(const LAS u32x4*)(XT2 + (16 * pt + fr) * 264 + 32 * ks + 8 * gq)); acc[pt] = MFMA16(A, Bf, acc[pt]); } }
      float* ST = (float*)(ws + WS_ST) + (size_t)unit * 8192;
#pragma unroll
      for (int pt = 0; pt < 4; ++pt) *(f32x4*)(ST + (16 * pt + fr) * 128 + 16 * wave + 4 * gq) = acc[pt]; }
    bf16_t* Y = (bf16_t*)(ws + WS_Y);
    for (int rr2_ = 0; rr2_ < SSDA_R2; ++rr2_)
#pragma unroll
    for (int which = 0; which < 2; ++which) { const int lt = which ? 15 - wave : wave, lrow = 16 * lt + fr; const size_t row = r0 + lrow;
        bf16x8 cf[4];
#pragma unroll
        for (int kk = 0; kk < 4; ++kk) cf[kk] = mk8(cpre[which][kk]);
        const float acl = acs[lrow];
        f32x4 yacc[4];
#pragma unroll
        for (int pt = 0; pt < 4; ++pt) yacc[pt] = (f32x4){0.f, 0.f, 0.f, 0.f};
        const int nblk = (lt >> 1) + 1;
#pragma unroll 1
        for (int sb = 0; sb < nblk; ++sb) { const int s0 = 32 * sb;
            f32x4 T0 = {0.f, 0.f, 0.f, 0.f}, T1 = {0.f, 0.f, 0.f, 0.f};
#pragma unroll
            for (int kk = 0; kk < 4; ++kk) { const bf16x8 A0 = mk8(*(const LAS u32x4*)(Bm + (s0 + fr) * 136 + 32 * kk + 8 * gq)), A1 = mk8(*(const LAS u32x4*)(Bm + (s0 + 16 + fr) * 136 + 32 * kk + 8 * gq));
                T0 = MFMA16(A0, cf[kk], T0); T1 = MFMA16(A1, cf[kk], T1); }
            const f32x4 as0 = *(const LAS f32x4*)(acs + s0 + 4 * gq), as1 = *(const LAS f32x4*)(acs + s0 + 16 + 4 * gq);
            float pv[8];
#pragma unroll
            for (int r = 0; r < 4; ++r) { const int sa = s0 + 4 * gq + r; pv[r] = (sa <= lrow) ? T0[r] * fexp(acl - as0[r]) : 0.f; pv[4 + r] = (sa + 16 <= lrow) ? T1[r] * fexp(acl - as1[r]) : 0.f; }
            u32x4 pw; pw.x = pk2(pv[0], pv[1]); pw.y = pk2(pv[2], pv[3]); pw.z = pk2(pv[4], pv[5]); pw.w = pk2(pv[6], pv[7]);
            const bf16x8 P = mk8(pw);
#pragma unroll
            for (int pt = 0; pt < 4; ++pt) { const LAS bf16_t* xp = XT + (16 * pt + fr) * 264 + s0 + 4 * gq;
                const bf16x8 Af = mk8(*(const LAS u32x2*)xp, *(const LAS u32x2*)(xp + 16)); yacc[pt] = MFMA16(Af, P, yacc[pt]); } }
#pragma unroll
        for (int pt = 0; pt < 4; ++pt) { u32x2 w; w.x = pk2(yacc[pt].x, yacc[pt].y); w.y = pk2(yacc[pt].z, yacc[pt].w); *(u32x2*)(Y + row * 512 + h * 64 + 16 * pt + 4 * gq) = w; } }
    __syncthreads();
}
__device__ __forceinline__ void ssd_scan(const Args& a, int l, int gtid, int gthreads) {
    unsigned char* ws = a.ws; const float* ST = (const float*)(ws + WS_ST); bf16_t* HIN = (bf16_t*)(ws + WS_HIN); const float* CT = (const float*)(ws + WS_CT);
    for (int e = gtid; e < 2 * 8 * 8192; e += gthreads) { const int b = e >> 16, h = (e >> 13) & 7, pn = e & 8191; float hs = 0.f;
        const size_t o0 = ((size_t)(b * 32) * 8 + h) * 8192 + pn;
#pragma unroll 1
        for (int c0 = 0; c0 < 32; c0 += 16) { float st[16], dc[16];
#pragma unroll
            for (int c = 0; c < 16; ++c) { st[c] = ST[o0 + (size_t)(c0 + c) * 65536]; dc[c] = CT[(b * 32 + c0 + c) * 8 + h]; }
#pragma unroll
            for (int c = 0; c < 16; c += 8) { asm volatile("" : "+v"(st[c]), "+v"(st[c + 1]), "+v"(st[c + 2]), "+v"(st[c + 3]), "+v"(st[c + 4]), "+v"(st[c + 5]), "+v"(st[c + 6]), "+v"(st[c + 7]), "+v"(dc[c]), "+v"(dc[c + 1]), "+v"(dc[c + 2]), "+v"(dc[c + 3]), "+v"(dc[c + 4]), "+v"(dc[c + 5]), "+v"(dc[c + 6]), "+v"(dc[c + 7])); }
#pragma unroll
            for (int c = 0; c < 16; ++c) { HIN[o0 + (size_t)(c0 + c) * 65536] = (bf16_t)(pk2(hs, 0.f) & 0xffffu); hs = fmaf(hs, fexp(dc[c]), st[c]); } }
        a.out[O_HP + (size_t)l * 2 * 8 * 8192 + (size_t)(b * 8 + h) * 8192 + pn] = hs; }
}
__device__ __forceinline__ void ssdC_unit(const Args& a, int l, int unit, LAS unsigned char* lds, int tid) {
    unsigned char* ws = a.ws; const int lane = tid & 63, h = __builtin_amdgcn_readfirstlane(tid >> 6), fr = lane & 15, gq = lane >> 4, g = h >> 2;
    const int bc = unit >> 2; const size_t r0 = (size_t)bc * 256 + (unit & 3) * 64;
    const bf16_t* XC = (const bf16_t*)(ws + WS_XC); const bf16_t* ZS = (const bf16_t*)(ws + WS_ZS); const bf16_t* Y = (const bf16_t*)(ws + WS_Y); const float* ACUM = (const float*)(ws + WS_ACUM);
    const bf16_t* HIN = (const bf16_t*)(ws + WS_HIN) + ((size_t)bc * 8 + h) * 8192;
    LAS float* red = (LAS float*)lds;
    bf16x8 hf[4][4];
#pragma unroll
    for (int pt = 0; pt < 4; ++pt)
#pragma unroll
        for (int kk = 0; kk < 4; ++kk) hf[pt][kk] = mk8(*(const u32x4*)(HIN + (16 * pt + fr) * 128 + 32 * kk + 8 * gq));
    const float Dh = a.in[26][l * 8 + h];
    float pre = 0.f; { const float* tp = (const float*)(ws + WS_TOT) + (size_t)(bc * 4) * 8 + h; const int j = unit & 3; if (j > 0) pre += tp[0]; if (j > 1) pre += tp[8]; if (j > 2) pre += tp[16]; }
    f32x4 v[4][4];
#pragma unroll
    for (int lt = 0; lt < 4; ++lt) { const size_t row = r0 + 16 * lt + fr;
        u32x4 cw[4]; u32x2 yw[4], xw[4], zw[4]; float acv = ACUM[row * 8 + h];
#pragma unroll
        for (int kk = 0; kk < 4; ++kk) cw[kk] = *(const u32x4*)(XC + row * 1024 + 768 + g * 128 + 32 * kk + 8 * gq);
#pragma unroll
        for (int pt = 0; pt < 4; ++pt) { const int p0 = h * 64 + 16 * pt + 4 * gq; yw[pt] = *(const u32x2*)(Y + row * 512 + p0); xw[pt] = *(const u32x2*)(XC + row * 1024 + p0); zw[pt] = *(const u32x2*)(ZS + row * 512 + p0); }
        asm volatile("" : "+v"(cw[0]), "+v"(cw[1]), "+v"(cw[2]), "+v"(cw[3]), "+v"(yw[0]), "+v"(yw[1]), "+v"(yw[2]), "+v"(yw[3]), "+v"(xw[0]), "+v"(xw[1]), "+v"(xw[2]), "+v"(xw[3]), "+v"(zw[0]), "+v"(zw[1]), "+v"(zw[2]), "+v"(zw[3]), "+v"(acv));
        f32x4 yacc[4];
#pragma unroll
        for (int pt = 0; pt < 4; ++pt) { yacc[pt] = (f32x4){0.f, 0.f, 0.f, 0.f};
#pragma unroll
            for (int kk = 0; kk < 4; ++kk) yacc[pt] = MFMA16(hf[pt][kk], mk8(cw[kk]), yacc[pt]); }
        const float el = expf(acv + pre); float ss = 0.f;
#pragma unroll
        for (int pt = 0; pt < 4; ++pt) { const f32x4 yv = {bflo(yw[pt].x), bfhi(yw[pt].x), bflo(yw[pt].y), bfhi(yw[pt].y)};
            f32x4 t; t.x = (yacc[pt].x * el + yv.x + Dh * bflo(xw[pt].x)) * bflo(zw[pt].x); t.y = (yacc[pt].y * el + yv.y + Dh * bfhi(xw[pt].x)) * bfhi(zw[pt].x);
            t.z = (yacc[pt].z * el + yv.z + Dh * bflo(xw[pt].y)) * bflo(zw[pt].y); t.w = (yacc[pt].w * el + yv.w + Dh * bfhi(xw[pt].y)) * bfhi(zw[pt].y);
            v[lt][pt] = t; ss += (t.x * t.x + t.y * t.y) + (t.z * t.z + t.w * t.w); }
        ss += __shfl_xor(ss, 16); ss += __shfl_xor(ss, 32);
        if (gq == 0) red[h * 64 + 16 * lt + fr] = ss; }
    const float* gn = a.in[27] + l * 512; f32x4 ggp[4];
#pragma unroll
    for (int pt = 0; pt < 4; ++pt) ggp[pt] = *(const f32x4*)(gn + h * 64 + 16 * pt + 4 * gq);
    __syncthreads();
#pragma unroll
    for (int lt = 0; lt < 4; ++lt) { const int lr = 16 * lt + fr; const size_t row = r0 + lr; float tot = 0.f;
#pragma unroll
        for (int hh = 0; hh < 8; ++hh) tot += red[hh * 64 + lr];
        const float rs = rsqrtf(tot * (1.f / 512.f) + 1e-6f);
#pragma unroll
        for (int pt = 0; pt < 4; ++pt) { const int p0 = h * 64 + 16 * pt + 4 * gq; const f32x4 o = v[lt][pt] * rs * ggp[pt];
            u32x2 w; w.x = pk2(o.x, o.y); w.y = pk2(o.z, o.w); *(u32x2*)((bf16_t*)(ws + WS_MIX) + row * D + 512 + p0) = w; } }
    __syncthreads();
}

__device__ __forceinline__ void ssd_sample_unit(const Args& a, int l, int unit, int tid) {
    unsigned char* ws = a.ws; const int sb = unit >> 3, h = unit & 7, g = h >> 2, p = tid >> 3, nq = tid & 7; const size_t row = (size_t)MPR + sb;
    const bf16_t* xc = (const bf16_t*)(ws + WS_XC) + row * 1024; float dtv = ((const float*)(ws + WS_DT))[row * 8 + h]; float alog = a.in[25][l * 8 + h]; unsigned xraw = (unsigned)xc[h * 64 + p];
    const float* s = a.in[6] + (((size_t)l * 32 + sb) * 8 + h) * 8192 + p * 128 + 16 * nq; float* o = a.out + O_HS + (((size_t)l * 32 + sb) * 8 + h) * 8192 + p * 128 + 16 * nq;
    u32x4 b0 = *(const u32x4*)(xc + 512 + g * 128 + 16 * nq), b1 = *(const u32x4*)(xc + 512 + g * 128 + 16 * nq + 8), c0 = *(const u32x4*)(xc + 768 + g * 128 + 16 * nq), c1 = *(const u32x4*)(xc + 768 + g * 128 + 16 * nq + 8);
    f32x4 hvp[4];
#pragma unroll
    for (int q = 0; q < 4; ++q) hvp[q] = *(const f32x4*)(s + 4 * q);
    asm volatile("" : "+v"(dtv), "+v"(alog), "+v"(xraw), "+v"(b0), "+v"(b1), "+v"(c0), "+v"(c1), "+v"(hvp[0]), "+v"(hvp[1]), "+v"(hvp[2]), "+v"(hvp[3]));
    const float dA = expf(dtv * -expf(alog)), xd = dtv * __uint_as_float(xraw << 16);
    float Bv[16], Cv[16];
    Bv[0] = bflo(b0.x); Bv[1] = bfhi(b0.x); Bv[2] = bflo(b0.y); Bv[3] = bfhi(b0.y); Bv[4] = bflo(b0.z); Bv[5] = bfhi(b0.z); Bv[6] = bflo(b0.w); Bv[7] = bfhi(b0.w);
    Bv[8] = bflo(b1.x); Bv[9] = bfhi(b1.x); Bv[10] = bflo(b1.y); Bv[11] = bfhi(b1.y); Bv[12] = bflo(b1.z); Bv[13] = bfhi(b1.z); Bv[14] = bflo(b1.w); Bv[15] = bfhi(b1.w);
    Cv[0] = bflo(c0.x); Cv[1] = bfhi(c0.x); Cv[2] = bflo(c0.y); Cv[3] = bfhi(c0.y); Cv[4] = bflo(c0.z); Cv[5] = bfhi(c0.z); Cv[6] = bflo(c0.w); Cv[7] = bfhi(c0.w);
    Cv[8] = bflo(c1.x); Cv[9] = bfhi(c1.x); Cv[10] = bflo(c1.y); Cv[11] = bfhi(c1.y); Cv[12] = bflo(c1.z); Cv[13] = bfhi(c1.z); Cv[14] = bflo(c1.w); Cv[15] = bfhi(c1.w);
    float y = 0.f;
#pragma unroll
    for (int q = 0; q < 4; ++q) { const f32x4 hv = hvp[q]; f32x4 hn;
        hn.x = fmaf(hv.x, dA, xd * Bv[4 * q]); hn.y = fmaf(hv.y, dA, xd * Bv[4 * q + 1]); hn.z = fmaf(hv.z, dA, xd * Bv[4 * q + 2]); hn.w = fmaf(hv.w, dA, xd * Bv[4 * q + 3]);
        *(f32x4*)(o + 4 * q) = hn; y += (Cv[4 * q] * hn.x + Cv[4 * q + 1] * hn.y) + (Cv[4 * q + 2] * hn.z + Cv[4 * q + 3] * hn.w); }
    y += __shfl_xor(y, 1); y += __shfl_xor(y, 2); y += __shfl_xor(y, 4);
    if (nq == 0) ((bf16_t*)(ws + WS_Y))[row * 512 + h * 64 + p] = (bf16_t)(pk2(y, 0.f) & 0xffffu);
}

__device__ __forceinline__ void skinny_item(const bf16_t* __restrict__ A  , const bf16_t* __restrict__ Bt  , int K, int item, const float* xold  ,
                                            bf16_t* XB, float* SSQ, float alpha, LAS unsigned char* lds, int tid, float* parts, unsigned* cnt, const float* nssq = nullptr, const float* gsc = nullptr, float* SSQG = nullptr) {
    const int lane = tid & 63, wave = __builtin_amdgcn_readfirstlane(tid >> 6), fr = lane & 15, gq = lane >> 4;
    const int u = item & 15, s = item >> 4, nks = K >> 5, k0 = (nks * s) >> 4, k1 = (nks * (s + 1)) >> 4, ks = k0 + wave;
    f32x4 acc[2][4];
#pragma unroll
    for (int rt = 0; rt < 2; ++rt)
#pragma unroll
        for (int ct = 0; ct < 4; ++ct) acc[rt][ct] = (f32x4){0.f, 0.f, 0.f, 0.f};
    if (ks < k1) {
        const bf16_t* a0 = A + (size_t)fr * K + 32 * ks + 8 * gq; const bf16_t* bp = Bt + (size_t)(64 * u + fr) * K + 32 * ks + 8 * gq;
        u32x4 xa0 = *(const u32x4*)a0, xa1 = *(const u32x4*)(a0 + (size_t)16 * K), wb[4];
#pragma unroll
        for (int ct = 0; ct < 4; ++ct) wb[ct] = *(const u32x4*)(bp + (size_t)(16 * ct) * K);
        asm volatile("" : "+v"(xa0), "+v"(xa1), "+v"(wb[0]), "+v"(wb[1]), "+v"(wb[2]), "+v"(wb[3]));
#pragma unroll
        for (int ct = 0; ct < 4; ++ct) { acc[0][ct] = MFMA16(mk8(wb[ct]), mk8(xa0), acc[0][ct]); acc[1][ct] = MFMA16(mk8(wb[ct]), mk8(xa1), acc[1][ct]); }
    }
    LAS float* red = (LAS float*)lds;
    LAS unsigned* flag = (LAS unsigned*)(lds + RING_BYTES);
#pragma unroll
    for (int rt = 0; rt < 2; ++rt)
#pragma unroll
        for (int ct = 0; ct < 4; ++ct) *(LAS f32x4*)(red + ((wave * 32 + 16 * rt + fr) * 64 + 16 * ct + 4 * gq)) = acc[rt][ct];
    __syncthreads();
    const int row = tid >> 4, c4 = (tid & 15) * 4;
    { f32x4 v = {0.f, 0.f, 0.f, 0.f};
#pragma unroll
      for (int w = 0; w < 8; ++w) v += *(const LAS f32x4*)(red + ((w * 32 + row) * 64 + c4));
      float* pp = parts + ((size_t)(u * 16 + s) * 32 + row) * 64 + c4;
      __hip_atomic_store(pp + 0, v.x, __ATOMIC_RELAXED, __HIP_MEMORY_SCOPE_AGENT); __hip_atomic_store(pp + 1, v.y, __ATOMIC_RELAXED, __HIP_MEMORY_SCOPE_AGENT);
      __hip_atomic_store(pp + 2, v.z, __ATOMIC_RELAXED, __HIP_MEMORY_SCOPE_AGENT); __hip_atomic_store(pp + 3, v.w, __ATOMIC_RELAXED, __HIP_MEMORY_SCOPE_AGENT); }
    asm volatile("s_waitcnt vmcnt(0)" ::: "memory");
    __syncthreads();
    if (tid == 0) *flag = atomicAdd(cnt + u, 1u);
    __syncthreads();
    const bool last = (*flag == 15u);
    if (last) {
        const size_t o = (size_t)row * D + 64 * u + c4;
        f32x4 pv[16]; f32x4 xo4 = {0.f, 0.f, 0.f, 0.f}; u32x2 xw = {0u, 0u}; float rn = 1.f;
#pragma unroll
        for (int s2 = 0; s2 < 16; ++s2) { float* pp = parts + ((size_t)(u * 16 + s2) * 32 + row) * 64 + c4;
            pv[s2].x = __hip_atomic_load(pp + 0, __ATOMIC_RELAXED, __HIP_MEMORY_SCOPE_AGENT); pv[s2].y = __hip_atomic_load(pp + 1, __ATOMIC_RELAXED, __HIP_MEMORY_SCOPE_AGENT);
            pv[s2].z = __hip_atomic_load(pp + 2, __ATOMIC_RELAXED, __HIP_MEMORY_SCOPE_AGENT); pv[s2].w = __hip_atomic_load(pp + 3, __ATOMIC_RELAXED, __HIP_MEMORY_SCOPE_AGENT); }
        if (xold) xo4 = *(const f32x4*)(xold + o); else { xw = *(const u32x2*)(XB + o); if (nssq) rn = rstd16(nssq + (size_t)row * 16); }
        asm volatile("" : "+v"(pv[0]), "+v"(pv[1]), "+v"(pv[2]), "+v"(pv[3]), "+v"(pv[4]), "+v"(pv[5]), "+v"(pv[6]), "+v"(pv[7]), "+v"(pv[8]), "+v"(pv[9]), "+v"(pv[10]), "+v"(pv[11]), "+v"(pv[12]), "+v"(pv[13]), "+v"(pv[14]), "+v"(pv[15]), "+v"(xo4), "+v"(xw), "+v"(rn));
        f32x4 v = pv[0];
#pragma unroll
        for (int s2 = 1; s2 < 16; ++s2) v += pv[s2];
        f32x4 xo = xo4; if (!xold) xo = (f32x4){bflo(xw.x), bfhi(xw.x), bflo(xw.y), bfhi(xw.y)} * rn;
        const f32x4 xn = xo + alpha * v;
        f32x4 xb = xn; if (gsc) xb = xn * *(const f32x4*)(gsc + 64 * u + c4);
        u32x2 w2; w2.x = pk2(xb.x, xb.y); w2.y = pk2(xb.z, xb.w); *(u32x2*)(XB + o) = w2;
        float ss = (xn.x * xn.x + xn.y * xn.y) + (xn.z * xn.z + xn.w * xn.w), sg = (xb.x * xb.x + xb.y * xb.y) + (xb.z * xb.z + xb.w * xb.w);
        ss += __shfl_xor(ss, 1); ss += __shfl_xor(ss, 2); ss += __shfl_xor(ss, 4); ss += __shfl_xor(ss, 8);
        sg += __shfl_xor(sg, 1); sg += __shfl_xor(sg, 2); sg += __shfl_xor(sg, 4); sg += __shfl_xor(sg, 8);
        if ((tid & 15) == 0) { SSQ[(size_t)row * 16 + u] = ss; if (gsc) SSQG[(size_t)row * 16 + u] = sg; } }
    __syncthreads();
}
__device__ __forceinline__ void sel_unit(const Args& a, int unit, LAS unsigned char* lds, int tid) {
    unsigned char* ws = a.ws; const int hp = unit & 1, cur = (unit >> 1) & 31, b = unit >> 6, r = tid & 255, hh = tid >> 8, h = 2 * hp + hh;
    const size_t m = (size_t)b * SEQ + cur * 256 + r;
    LAS float* km = (LAS float*)lds;
    const float* KMP = (const float*)(ws + WS_KMP) + (size_t)b * 32 * 256 + hp * 128;
    for (int i = tid; i < cur * 32; i += NTHR) { const int n = i >> 5, c4 = i & 31; *(LAS f32x4*)(km + n * 128 + 4 * c4) = *(const f32x4*)(KMP + n * 256 + 4 * c4); }
    float q[64];
    { const bf16_t* qp = (const bf16_t*)(ws + WS_QB) + m * 256 + h * 64;
#pragma unroll
      for (int j = 0; j < 8; ++j) { const u32x4 w = *(const u32x4*)(qp + 8 * j); q[8 * j] = bflo(w.x); q[8 * j + 1] = bfhi(w.x); q[8 * j + 2] = bflo(w.y); q[8 * j + 3] = bfhi(w.y); q[8 * j + 4] = bflo(w.z); q[8 * j + 5] = bfhi(w.z); q[8 * j + 6] = bflo(w.w); q[8 * j + 7] = bfhi(w.w); } }
    __syncthreads();
    float v0 = -INFINITY, v1 = -INFINITY, v2 = -INFINITY; int i0 = 0, i1 = 0, i2 = 0;
    for (int n = 0; n < cur; ++n) { const LAS float* kp = km + n * 128 + hh * 64; float g0 = 0.f, g1 = 0.f;
#pragma unroll
        for (int j = 0; j < 16; j += 2) { const f32x4 ka = *(const LAS f32x4*)(kp + 4 * j), kb = *(const LAS f32x4*)(kp + 4 * j + 4);
            g0 = fmaf(q[4 * j], ka.x, g0); g0 = fmaf(q[4 * j + 1], ka.y, g0); g0 = fmaf(q[4 * j + 2], ka.z, g0); g0 = fmaf(q[4 * j + 3], ka.w, g0);
            g1 = fmaf(q[4 * j + 4], kb.x, g1); g1 = fmaf(q[4 * j + 5], kb.y, g1); g1 = fmaf(q[4 * j + 6], kb.z, g1); g1 = fmaf(q[4 * j + 7], kb.w, g1); }
        const float gv = g0 + g1;
        if (gv > v0) { v2 = v1; i2 = i1; v1 = v0; i1 = i0; v0 = gv; i0 = n; } else if (gv > v1) { v2 = v1; i2 = i1; v1 = gv; i1 = n; } else if (gv > v2) { v2 = gv; i2 = n; } }
    const int cnt = cur < 3 ? cur : 3;
    ((unsigned*)(ws + WS_SEL))[m * 4 + h] = (unsigned)i0 | ((unsigned)i1 << 8) | ((unsigned)i2 << 16) | ((unsigned)cnt << 24);
    __syncthreads();
}
__device__ const unsigned ATT_TAB[32][2] = {{1049861u,0u},{1968650u,0u},{1705730u,0u},{1771785u,0u},{1180929u,0u},{852996u,0u},{1574920u,0u},{918528u,0u},{2099979u,0u},{1378055u,0u},{262144u,0u},{656131u,0u},{1181190u,0u},{459266u,0u},{2100236u,0u},{327937u,0u},{2099715u,0u},{2100493u,0u},{2100750u,2104842u},{2101007u,2104073u},{2101264u,2103810u},{2100484u,2103304u},{2101521u,2105119u},{2101778u,2104862u},{2100736u,2104605u},{2102035u,2102535u},{2102292u,2104348u},{2102549u,2104091u},{2101253u,2103834u},{2102806u,2103577u},{2103063u,2103320u},{2101761u,2101766u}};
constexpr int AT_KM = 0, AT_VT = 36864, AT_BT = AT_VT + 33792, AT_QL = AT_BT + 1024, AT_WC = AT_QL + 16384, AT_NC = 8;
__device__ __forceinline__ void attn_slot(const Args& a, int sidx, LAS unsigned char* lds, int tid) {
    unsigned char* ws = a.ws; const int lane = tid & 63, wave = __builtin_amdgcn_readfirstlane(tid >> 6), fr = lane & 15, gq = lane >> 4;
    const int bh = sidx & 7, b = bh >> 2, h = bh & 3, slot_i = sidx >> 3;
    LAS bf16_t* Km = (LAS bf16_t*)(lds + AT_KM); LAS bf16_t* VT = (LAS bf16_t*)(lds + AT_VT); LAS float* BTs = (LAS float*)(lds + AT_BT); LAS unsigned* ql = (LAS unsigned*)(lds + AT_QL); LAS int* wc = (LAS int*)(lds + AT_WC);
    const bf16_t* KB = (const bf16_t*)(ws + WS_KB); const bf16_t* VB = (const bf16_t*)(ws + WS_VB); const bf16_t* QB = (const bf16_t*)(ws + WS_QB);
    if (tid < 129) BTs[tid] = ((const float*)(ws + WS_BT))[h * 129 + tid];
#pragma unroll 1
    for (int it = 0; it < 2; ++it) { const unsigned tw = ATT_TAB[slot_i][it]; const int n = (int)(tw & 255u), lo = (int)((tw >> 8) & 255u), hi = (int)(tw >> 16);
      if (hi <= lo) continue;
      const size_t kr0 = (size_t)b * SEQ + n * 256;
      u32x4 kst[4], vst[4];
#pragma unroll
      for (int pass = 0; pass < 4; ++pass) { kst[pass] = *(const u32x4*)(KB + (kr0 + pass * 64 + (tid >> 3)) * 256 + h * 64 + 8 * (tid & 7)); vst[pass] = *(const u32x4*)(VB + (kr0 + pass * 64 + lane) * 256 + h * 64 + 8 * wave); }
      asm volatile("" : "+v"(kst[0]), "+v"(kst[1]), "+v"(kst[2]), "+v"(kst[3]), "+v"(vst[0]), "+v"(vst[1]), "+v"(vst[2]), "+v"(vst[3]));
#pragma unroll
      for (int pass = 0; pass < 4; ++pass) { const int key = pass * 64 + (tid >> 3), ch = tid & 7; *(LAS u32x4*)(Km + key * 72 + 8 * ch) = kst[pass]; }
#pragma unroll
      for (int pass = 0; pass < 4; ++pass) { const int key = pass * 64 + lane; const u32x4 v = vst[pass];
          LAS bf16_t* vp = VT + (8 * wave) * 264 + key;
          vp[0] = (bf16_t)(v.x & 0xffffu); vp[264] = (bf16_t)(v.x >> 16); vp[2 * 264] = (bf16_t)(v.y & 0xffffu); vp[3 * 264] = (bf16_t)(v.y >> 16);
          vp[4 * 264] = (bf16_t)(v.z & 0xffffu); vp[5 * 264] = (bf16_t)(v.z >> 16); vp[6 * 264] = (bf16_t)(v.w & 0xffffu); vp[7 * 264] = (bf16_t)(v.w >> 16); }
#pragma unroll 1
      for (int c0 = lo * 256; c0 < hi * 256; c0 += 512 * AT_NC) {
        bool hit[AT_NC]; unsigned ent[AT_NC], sv[AT_NC];
#pragma unroll
        for (int k = 0; k < AT_NC; ++k) { const int t = c0 + 512 * k + tid; sv[k] = 0u; if (t < hi * 256 && (t >> 8) != n) sv[k] = ((const unsigned*)(ws + WS_SEL))[((size_t)b * SEQ + t) * 4 + h]; }
        asm volatile("" : "+v"(sv[0]), "+v"(sv[1]), "+v"(sv[2]), "+v"(sv[3]), "+v"(sv[4]), "+v"(sv[5]), "+v"(sv[6]), "+v"(sv[7]));
#pragma unroll
        for (int k = 0; k < AT_NC; ++k) { const int t = c0 + 512 * k + tid; hit[k] = false; ent[k] = 0u;
            if (t < hi * 256) { const int cb = t >> 8;
                if (cb == n) { hit[k] = true; ent[k] = (unsigned)t | (3u << 16); }
                else { const unsigned s = sv[k]; const unsigned cnt = s >> 24;
                    if (cnt > 0 && (s & 255u) == (unsigned)n) { hit[k] = true; ent[k] = (unsigned)t; } else if (cnt > 1 && ((s >> 8) & 255u) == (unsigned)n) { hit[k] = true; ent[k] = (unsigned)t | (1u << 16); } else if (cnt > 2 && ((s >> 16) & 255u) == (unsigned)n) { hit[k] = true; ent[k] = (unsigned)t | (2u << 16); } } } }
        unsigned long long bal[AT_NC]; const unsigned long long below = (1ull << lane) - 1ull;
#pragma unroll
        for (int k = 0; k < AT_NC; ++k) { bal[k] = __ballot(hit[k]); if (lane == 0) wc[8 * k + wave] = __popcll(bal[k]); }
        __syncthreads();
        int run = 0, mine[AT_NC];
#pragma unroll
        for (int w = 0; w < 8 * AT_NC; ++w) { if ((w & 7) == wave) mine[w >> 3] = run; run += wc[w]; }
        const int tot = run;
#pragma unroll
        for (int k = 0; k < AT_NC; ++k) if (hit[k]) ql[mine[k] + __popcll(bal[k] & below)] = ent[k];
        const int nq = tot; __syncthreads();
#ifndef AT_RT
#define AT_RT 1
#endif
        for (int rrt_ = 0; rrt_ < AT_RT; ++rrt_) {
        const float bfar = BTs[128];
        unsigned e_n = 0u; u32x4 qn0 = {0u, 0u, 0u, 0u}, qn1 = {0u, 0u, 0u, 0u};
        if (wave * 16 < nq) { const int qi = 16 * wave + fr; e_n = ql[qi < nq ? qi : 16 * wave]; const bf16_t* qp = QB + ((size_t)b * SEQ + (e_n & 0xffffu)) * 256 + h * 64 + 8 * gq; qn0 = *(const u32x4*)qp; qn1 = *(const u32x4*)(qp + 32); }
        for (int ti = wave; ti * 16 < nq; ti += NWAVES) { const int qi = 16 * ti + fr; const bool valid = qi < nq; const unsigned e = e_n; const int t = (int)(e & 0xffffu), slot = (int)(e >> 16);
            const size_t qrow = (size_t)b * SEQ + t;
            const bf16x8 qf0 = mk8(qn0), qf1 = mk8(qn1);
            if ((ti + NWAVES) * 16 < nq) { const int q2 = 16 * (ti + NWAVES) + fr; e_n = ql[q2 < nq ? q2 : 16 * (ti + NWAVES)]; const bf16_t* qp = QB + ((size_t)b * SEQ + (e_n & 0xffffu)) * 256 + h * 64 + 8 * gq; qn0 = *(const u32x4*)qp; qn1 = *(const u32x4*)(qp + 32); }
            const int need = (slot == 3) ? (((t - n * 256) >> 6) + 1) : 4;
            const int ng = 1 + (__any(need >= 2) ? 1 : 0) + (__any(need >= 3) ? 1 : 0) + (__any(need >= 4) ? 1 : 0);
            f32x4 T[16];
#pragma unroll
            for (int g = 0; g < 4; ++g) {
                if (g < ng) {
#pragma unroll
                    for (int k4 = 0; k4 < 4; ++k4) { const int kt = 4 * g + k4; const LAS bf16_t* kp = Km + (16 * kt + fr) * 72 + 8 * gq; f32x4 acc = {0.f, 0.f, 0.f, 0.f};
                        acc = MFMA16(mk8(*(const LAS u32x4*)kp), qf0, acc); acc = MFMA16(mk8(*(const LAS u32x4*)(kp + 32)), qf1, acc); T[kt] = acc; }
                } else {
#pragma unroll
                    for (int k4 = 0; k4 < 4; ++k4) T[4 * g + k4] = (f32x4){-INFINITY, -INFINITY, -INFINITY, -INFINITY};
                } }
            const int dmin = t - (n * 256 + 255);
            float mx = -INFINITY;
            float mxadd = 0.f;
            if (__all(dmin >= 128)) {
                mxadd = bfar;
#pragma unroll
                for (int kt = 0; kt < 16; ++kt)
#pragma unroll
                    for (int r = 0; r < 4; ++r) mx = fmaxf(mx, T[kt][r]);
            } else {
                const int dbase = dmin + 255 - 4 * gq;
#pragma unroll
                for (int g = 0; g < 4; ++g) if (g < ng) {
#pragma unroll
                    for (int k4 = 0; k4 < 4; ++k4)
#pragma unroll
                        for (int r = 0; r < 4; ++r) { const int kt = 4 * g + k4; int di = dbase - (16 * kt + r); di = di < 0 ? 0 : (di > 128 ? 128 : di); T[kt][r] += BTs[di]; }
#pragma unroll
                    for (int k4 = 0; k4 < 4; ++k4)
#pragma unroll
                        for (int r = 0; r < 4; ++r) { const int kt = 4 * g + k4; const float x = (dbase - (16 * kt + r) >= 0) ? T[kt][r] : -INFINITY; T[kt][r] = x; mx = fmaxf(mx, x); }
                }
            }
            mx = fmaxf(mx, __shfl_xor(mx, 16)); mx = fmaxf(mx, __shfl_xor(mx, 32));
            f32x4 ls4 = {0.f, 0.f, 0.f, 0.f}; const f32x4 mx4 = {mx, mx, mx, mx};
#pragma unroll
            for (int g = 0; g < 4; ++g) {
                if (g < ng) {
#pragma unroll
                    for (int k4 = 0; k4 < 4; ++k4) { const int kt = 4 * g + k4; const f32x4 d = T[kt] - mx4;
                        const f32x4 p = {__builtin_amdgcn_exp2f(d.x), __builtin_amdgcn_exp2f(d.y), __builtin_amdgcn_exp2f(d.z), __builtin_amdgcn_exp2f(d.w)}; T[kt] = p; ls4 += p; }
                } }
            float ls = (ls4.x + ls4.y) + (ls4.z + ls4.w);
            ls += __shfl_xor(ls, 16); ls += __shfl_xor(ls, 32);
            f32x4 O[4];
#pragma unroll
            for (int dt = 0; dt < 4; ++dt) O[dt] = (f32x4){0.f, 0.f, 0.f, 0.f};
            const LAS bf16_t* vlo = VT + fr * 264 + 4 * gq; const LAS bf16_t* vhi = vlo + 16; asm volatile("" : "+v"(vhi));
#pragma unroll
            for (int g = 0; g < 4; ++g) if (g < ng) {
#pragma unroll
                for (int k2 = 0; k2 < 2; ++k2) { const int ks = 2 * g + k2; u32x4 pw; pw.x = pk2(T[2 * ks][0], T[2 * ks][1]); pw.y = pk2(T[2 * ks][2], T[2 * ks][3]); pw.z = pk2(T[2 * ks + 1][0], T[2 * ks + 1][1]); pw.w = pk2(T[2 * ks + 1][2], T[2 * ks + 1][3]);
                    const bf16x8 P = mk8(pw);
#pragma unroll
                    for (int dt = 0; dt < 4; ++dt) O[dt] = MFMA16(mk8(*(const LAS u32x2*)(vlo + (16 * dt) * 264 + 32 * ks), *(const LAS u32x2*)(vhi + (16 * dt) * 264 + 32 * ks)), P, O[dt]); }
            }
            if (valid && (AT_RT == 1 || rrt_ == 0)) { unsigned char* pp = ws + WS_PART + ((qrow * 4 + h) * 4 + slot) * 144;
#pragma unroll
                for (int dt = 0; dt < 4; ++dt) { u32x2 w; w.x = pk2(O[dt].x, O[dt].y); w.y = pk2(O[dt].z, O[dt].w); *(u32x2*)(pp + (16 * dt + 4 * gq) * 2) = w; }
                if (gq == 0) *(f32x2*)(pp + 128) = (f32x2){mx + mxadd, ls}; }
        }
        }
        __syncthreads();
      }
    }
}
__device__ __forceinline__ void attn_combine(const Args& a, int idx) {
    unsigned char* ws = a.ws; const int pair = idx >> 2, qd = idx & 3; const size_t row = (size_t)(pair >> 2); const int h = pair & 3;
    const unsigned s = ((const unsigned*)(ws + WS_SEL))[row * 4 + h]; const int cnt = (int)(s >> 24);
    const unsigned char* pp = ws + WS_PART + (row * 4 + h) * 4 * 144;
    f32x2 ml[4]; u32x4 ov[4][2];
#pragma unroll
    for (int j = 0; j < 4; ++j) { ml[j] = *(const f32x2*)(pp + j * 144 + 128); ov[j][0] = *(const u32x4*)(pp + j * 144 + 32 * qd); ov[j][1] = *(const u32x4*)(pp + j * 144 + 32 * qd + 16); }
    float M = ml[3].x;
#pragma unroll
    for (int j = 0; j < 3; ++j) M = (j < cnt) ? fmaxf(M, ml[j].x) : M;
    float den = 0.f, num[16];
#pragma unroll
    for (int e = 0; e < 16; ++e) num[e] = 0.f;
#pragma unroll
    for (int j = 0; j < 4; ++j) { const bool on = (j == 3) || (j < cnt); const float w = on ? __builtin_amdgcn_exp2f(ml[j].x - M) : 0.f; den += on ? w * ml[j].y : 0.f;
#pragma unroll
        for (int q = 0; q < 2; ++q) { const u32x4 t = on ? ov[j][q] : (u32x4){0u, 0u, 0u, 0u};
            num[8 * q + 0] = fmaf(w, bflo(t.x), num[8 * q + 0]); num[8 * q + 1] = fmaf(w, bfhi(t.x), num[8 * q + 1]); num[8 * q + 2] = fmaf(w, bflo(t.y), num[8 * q + 2]); num[8 * q + 3] = fmaf(w, bfhi(t.y), num[8 * q + 3]);
            num[8 * q + 4] = fmaf(w, bflo(t.z), num[8 * q + 4]); num[8 * q + 5] = fmaf(w, bfhi(t.z), num[8 * q + 5]); num[8 * q + 6] = fmaf(w, bflo(t.w), num[8 * q + 6]); num[8 * q + 7] = fmaf(w, bfhi(t.w), num[8 * q + 7]); } }
    const float inv = 1.f / den; u32x4 w0, w1;
    w0.x = pk2(num[0] * inv, num[1] * inv); w0.y = pk2(num[2] * inv, num[3] * inv); w0.z = pk2(num[4] * inv, num[5] * inv); w0.w = pk2(num[6] * inv, num[7] * inv);
    w1.x = pk2(num[8] * inv, num[9] * inv); w1.y = pk2(num[10] * inv, num[11] * inv); w1.z = pk2(num[12] * inv, num[13] * inv); w1.w = pk2(num[14] * inv, num[15] * inv);
    bf16_t* dst = (bf16_t*)(ws + WS_MIX) + row * D + 256 + h * 64 + 16 * qd; *(u32x4*)dst = w0; *(u32x4*)(dst + 8) = w1;
}
__device__ __forceinline__ void attn_sample_unit(const Args& a, int l, int unit, LAS unsigned char* lds, int tid) {
    unsigned char* ws = a.ws; const int lane = tid & 63, wave = __builtin_amdgcn_readfirstlane(tid >> 6), sb = unit >> 2, h = unit & 3; const size_t m = (size_t)MPR + sb;
    const float* KMS = (const float*)(ws + WS_KMS) + ((size_t)l * 1024 + sb * 32) * 256 + h * 64; const float* BT = (const float*)(ws + WS_BT) + h * 129;
    const float* ck = a.in[2] + (size_t)l * CACHE_L; const float* cv = a.in[3] + (size_t)l * CACHE_L; const int* pt = (const int*)a.in[7] + sb * NPAGES;
    LAS float* gate = (LAS float*)lds; LAS float* lg = gate + 64; LAS float* red = lg + 832; LAS float* osum = red + 16; LAS float* bts = osum + 512;
    float btv = BT[tid < 129 ? tid : 0]; unsigned qraw = (unsigned)((const bf16_t*)(ws + WS_QB))[m * 256 + h * 64 + lane]; float kmv[4]; int ptv = pt[lane];
#pragma unroll
    for (int i = 0; i < 4; ++i) kmv[i] = KMS[(size_t)(4 * wave + i) * 256 + lane];
    asm volatile("" : "+v"(btv), "+v"(qraw), "+v"(kmv[0]), "+v"(kmv[1]), "+v"(kmv[2]), "+v"(kmv[3]), "+v"(ptv));
    LAS int* pts = (LAS int*)(bts + 132);
    if (tid < 129) bts[tid] = btv;
    if (tid < 64) pts[tid] = ptv;
    const float qd = __uint_as_float(qraw << 16);
#pragma unroll
    for (int i = 0; i < 4; ++i) { const int n = 4 * wave + i; const float g = wsum(qd * kmv[i]); if (lane == 0) gate[n] = g; }
    __syncthreads();
    int i0 = 0, i1 = 0, i2 = 0; { float v0 = -INFINITY, v1 = -INFINITY, v2 = -INFINITY;
      for (int n = 0; n < 32; ++n) { const float gv = gate[n]; if (gv > v0) { v2 = v1; i2 = i1; v1 = v0; i1 = i0; v0 = gv; i0 = n; } else if (gv > v1) { v2 = v1; i2 = i1; v1 = gv; i1 = n; } else if (gv > v2) { v2 = gv; i2 = n; } } }
    const size_t pg0 = (size_t)pts[2 * i0] * 128, pg1 = (size_t)pts[2 * i0 + 1] * 128, pg2 = (size_t)pts[2 * i1] * 128, pg3 = (size_t)pts[2 * i1 + 1] * 128, pg4 = (size_t)pts[2 * i2] * 128, pg5 = (size_t)pts[2 * i2 + 1] * 128;
    const int kq = lane >> 4, dq = lane & 15; const f32x4 q4 = {__shfl(qd, 4 * dq), __shfl(qd, 4 * dq + 1), __shfl(qd, 4 * dq + 2), __shfl(qd, 4 * dq + 3)};
    f32x4 kv[24];
#pragma unroll
    for (int st = 0; st < 24; ++st) { const int kl = 32 * st + 4 * wave + kq, pi = st >> 2; const size_t pg = pi == 0 ? pg0 : pi == 1 ? pg1 : pi == 2 ? pg2 : pi == 3 ? pg3 : pi == 4 ? pg4 : pg5;
        kv[st] = *(const f32x4*)(ck + (pg + (kl & 127)) * 256 + h * 64 + 4 * dq); }
    float vv0[3][16], vv1[3][16];
#pragma unroll
    for (int q = 0; q < 3; ++q) { const size_t pg = q == 0 ? pg0 : q == 1 ? pg1 : pg2; const float* vb = cv + pg * 256 + h * 64 + lane;
#pragma unroll
        for (int i = 0; i < 16; ++i) vv0[q][i] = vb[(size_t)(wave + 8 * i) * 256]; }
#pragma unroll
    for (int st = 0; st < 24; ++st) { const int kl = 32 * st + 4 * wave + kq, j = st >> 3, blk = j == 0 ? i0 : (j == 1 ? i1 : i2), kpos = blk * 256 + (kl & 255);
        float d = (q4.x * kv[st].x + q4.y * kv[st].y) + (q4.z * kv[st].z + q4.w * kv[st].w);
        d += __shfl_xor(d, 1); d += __shfl_xor(d, 2); d += __shfl_xor(d, 4); d += __shfl_xor(d, 8);
        const int dist = 8192 - kpos; if (dq == 0) lg[kl] = d + bts[dist < 128 ? dist : 128]; }
    if (wave == 0) { const float d = wsum(qd * bf1(((const bf16_t*)(ws + WS_KB))[m * 256 + h * 64 + lane])); if (lane == 0) lg[768] = d + bts[0]; }
#pragma unroll
    for (int q = 0; q < 3; ++q) { const size_t pg = q == 0 ? pg3 : q == 1 ? pg4 : pg5; const float* vb = cv + pg * 256 + h * 64 + lane;
#pragma unroll
        for (int i = 0; i < 16; ++i) vv1[q][i] = vb[(size_t)(wave + 8 * i) * 256]; }
    __syncthreads();
    float mx = -INFINITY; for (int i = tid; i < 769; i += NTHR) mx = fmaxf(mx, lg[i]);
#pragma unroll
    for (int o = 1; o < 64; o <<= 1) mx = fmaxf(mx, __shfl_xor(mx, o));
    if (lane == 0) red[wave] = mx;
    __syncthreads();
    mx = red[0];
#pragma unroll
    for (int w = 1; w < 8; ++w) mx = fmaxf(mx, red[w]);
    float ps = 0.f; for (int i = tid; i < 769; i += NTHR) { const float p = __builtin_amdgcn_exp2f(lg[i] - mx); lg[i] = p; ps += p; }
    ps = wsum(ps); if (lane == 0) red[8 + wave] = ps;
    __syncthreads();
    float tot = 0.f;
#pragma unroll
    for (int w = 0; w < 8; ++w) tot += red[8 + w];
    float acc = 0.f;
#pragma unroll
    for (int q = 0; q < 3; ++q) asm volatile("" : "+v"(vv0[q][0]), "+v"(vv0[q][1]), "+v"(vv0[q][2]), "+v"(vv0[q][3]), "+v"(vv0[q][4]), "+v"(vv0[q][5]), "+v"(vv0[q][6]), "+v"(vv0[q][7]), "+v"(vv0[q][8]), "+v"(vv0[q][9]), "+v"(vv0[q][10]), "+v"(vv0[q][11]), "+v"(vv0[q][12]), "+v"(vv0[q][13]), "+v"(vv0[q][14]), "+v"(vv0[q][15]));
#pragma unroll
    for (int q = 0; q < 3; ++q)
#pragma unroll
        for (int i = 0; i < 16; ++i) acc = fmaf(lg[128 * q + wave + 8 * i], vv0[q][i], acc);
#pragma unroll
    for (int q = 0; q < 3; ++q) asm volatile("" : "+v"(vv1[q][0]), "+v"(vv1[q][1]), "+v"(vv1[q][2]), "+v"(vv1[q][3]), "+v"(vv1[q][4]), "+v"(vv1[q][5]), "+v"(vv1[q][6]), "+v"(vv1[q][7]), "+v"(vv1[q][8]), "+v"(vv1[q][9]), "+v"(vv1[q][10]), "+v"(vv1[q][11]), "+v"(vv1[q][12]), "+v"(vv1[q][13]), "+v"(vv1[q][14]), "+v"(vv1[q][15]));
#pragma unroll
    for (int q = 0; q < 3; ++q)
#pragma unroll
        for (int i = 0; i < 16; ++i) acc = fmaf(lg[128 * (3 + q) + wave + 8 * i], vv1[q][i], acc);
    if (wave == 0) acc = fmaf(lg[768], bf1(((const bf16_t*)(ws + WS_VB))[m * 256 + h * 64 + lane]), acc);
    osum[wave * 64 + lane] = acc;
    __syncthreads();
    if (tid < 64) { float o = 0.f;
#pragma unroll
        for (int w = 0; w < 8; ++w) o += osum[w * 64 + tid];
        ((bf16_t*)(ws + WS_MIX))[m * D + 256 + h * 64 + tid] = (bf16_t)(pk2(o / tot, 0.f) & 0xffffu); }
    __syncthreads();
}

__device__ __forceinline__ void kms_unit(const Args& args, unsigned char* ws, int v, LAS unsigned char* lds, int tid) {
    const int* pt = (const int*)args.in[7]; const int l = v >> 10, r = v & 1023, sb = r >> 5, n = r & 31;
    const float* ck = args.in[2] + (size_t)l * CACHE_L;
    colmean_unit(ck + (size_t)pt[sb * NPAGES + 2 * n] * 128 * 256, ck + (size_t)pt[sb * NPAGES + 2 * n + 1] * 128 * 256, (float*)(ws + WS_KMS) + (size_t)v * 256, (LAS float*)(lds + RING_BYTES), tid);
}
#ifndef KMS_GU
#define KMS_GU 4
#endif
#ifndef KMS_WIN
#define KMS_WIN 4
#endif
constexpr int GU_UNITS = 65 * 22, WIN_UNITS = 65 * 11;
__device__ __forceinline__ void kms_tail(const Args& args, unsigned char* ws, int G, int nunits, int per, int vbase, int vlimit, LAS unsigned char* lds, int tid) {
    const int first_idle = nunits % G; if (first_idle == 0 || (int)blockIdx.x < first_idle) return;
    for (int i = 0; i < per; ++i) { const int v = vbase + ((int)blockIdx.x - first_idle) * per + i; if (v < vlimit) kms_unit(args, ws, v, lds, tid); }
}
#define KM_MIN(a, b) ((a) < (b) ? (a) : (b))
#define KM_SPLIT(G) const int km_gu_ = ((GU_UNITS % (G)) ? (G) - GU_UNITS % (G) : 0) * KMS_GU, km_win_ = ((WIN_UNITS % (G)) ? (G) - WIN_UNITS % (G) : 0) * KMS_WIN; \
    const int KM_A0 = KM_MIN(km_gu_, 1024), KM_A1 = KM_MIN(km_gu_ + km_win_, 1024), KM_B0 = KM_MIN(km_gu_, 1024), KM_B1 = KM_MIN(2 * km_gu_, 1024), KM_B2 = KM_MIN(2 * km_gu_ + km_win_, 1024); (void)KM_A0; (void)KM_A1; (void)KM_B0; (void)KM_B1; (void)KM_B2;
constexpr int N_PHASES = 23;
#ifndef MK_CUTS
#define MK_CUTS 0
#endif
__global__ void __launch_bounds__(NTHR, 2) mk_fwd(Args args) {
    extern __shared__ __attribute__((aligned(16))) unsigned char lds_raw[];
    LAS unsigned char* lds = (LAS unsigned char*)lds_raw;
    const int tid0 = threadIdx.x; const int wave0 = __builtin_amdgcn_readfirstlane(tid0 >> 6);
    volatile LAS unsigned* MISC = (volatile LAS unsigned*)(lds + MISC_OFF);
    if (tid0 < 64) MISC[tid0] = 0u;
    __syncthreads();
    unsigned char* ws0 = args.ws;
    unsigned* ctl = (unsigned*)(ws0 + WS_CTL);
    XcdBarrier bar = xcd_barrier_post(ctl + CW_BAR + args.li * XCD_BAR_WORDS, MISC + 8);
    const int G0 = gridDim.x;
    const int lo = args.ph_lo, hi = args.ph_hi; (void)lo; (void)hi;
#ifndef MK_DUP
#define MK_DUP 0
#endif
#ifndef MK_DUPX
#define MK_DUPX 0
#endif
#define XR(b) for (int rr_ = 0; rr_ < ((((MK_DUPX) >> (b)) & 1) ? 2 : 1); ++rr_)
#define NREP(t) (((MK_DUP) >> (t)) & 1 ? 2 : 1)
#define REP(t) for (int rep = 0; rep < NREP(t); ++rep, (rep < NREP(t) ? xcd_barrier(bar) : (void)0))
#if defined(MK_DEBUG_ATTN) || (defined(MK_CUTS) && MK_CUTS)
#define IN(k) (lo <= (k) && (k) < hi)
#else
#define IN(k) true
#endif
#define SEAM(k) do { if (IN(k) && IN((k) + 1)) xcd_barrier(bar); } while (0)
#define PH_BEGIN() unsigned ones_ = ~0u; asm volatile("" : "+s"(ones_)); int tid = wave0 * 64 + (int)__builtin_amdgcn_mbcnt_hi(ones_, __builtin_amdgcn_mbcnt_lo(ones_, 0u)); asm volatile("" : "+v"(tid)); const int lane = tid & 63, wave = wave0; int G = G0; asm volatile("" : "+s"(G)); const int gw = blockIdx.x * NWAVES + wave, ngw = G * NWAVES; size_t zoff_ = 0; asm volatile("" : "+s"(zoff_)); unsigned char* ws = ws0 + zoff_;     \
    bf16_t* XB = (bf16_t*)(ws + WS_XB); float* SSQ = (float*)(ws + WS_SSQ); bf16_t* ACT = (bf16_t*)(ws + WS_ACT); bf16_t* MIX = (bf16_t*)(ws + WS_MIX); (void)lane; (void)gw; (void)ngw; (void)XB; (void)SSQ; (void)ACT; (void)MIX;


    if (IN(0)) REP(11) { PH_BEGIN();
        p0_weights(args, lds, gw, ngw, wave, lane);
        p0_rows(args, gw, ngw, lane);
        { KM_SPLIT(G); const int n0 = 1024 - KM_A1, nrem = n0 + (1024 - KM_B2);
          for (int i = blockIdx.x; i < nrem; i += G) { const int v = i < n0 ? KM_A1 + i : 1024 + KM_B2 + (i - n0); kms_unit(args, ws, v, lds, tid); } }
    }
    SEAM(0);

    for (int l = 0; l < 2; ++l) {
        const int pb = 1 + 11 * l;
        if (IN(pb + 0)) REP(0) { PH_BEGIN(); pg8::Gemm g{XB, (const bf16_t*)(ws + WS_WGU + (size_t)(l * 2 + 0) * SZ_WGU), MP, 2 * FF, D}; pg8::StaticOrder S; S.init(MP, 2 * FF, G, (int)blockIdx.x);
            LAS float* rtab = (LAS float*)(lds + RING_BYTES + 8192); rstd_table(S, l == 0 ? SSQ : (const float*)(ws + WS_SSQ3), l == 0 ? nullptr : (const float*)(ws + WS_SSQ3G), rtab, tid);
            EpiGU E{ACT, rtab}; pg8::gemm_phase<EpiGU, pg8::StaticOrder, true, true>(lds, g, S, E, wave0);
            { KM_SPLIT(G);
              if (l == 0) kms_tail(args, ws, G, GU_UNITS, KMS_GU, 0, KM_A0, lds, tid); else kms_tail(args, ws, G, GU_UNITS, KMS_GU, 1024 + KM_B0, 1024 + KM_B1, lds, tid); } }
        SEAM(pb + 0);
        if (IN(pb + 1)) REP(1) { PH_BEGIN(); pg8::Gemm g{ACT, (const bf16_t*)(ws + WS_WD + (size_t)(l * 2 + 0) * SZ_WD), MPR, D, FF}; pg8::StaticOrder S; S.init(MPR, D, G, (int)blockIdx.x);
            const float* n3 = (l == 1 && rep == 0) ? (const float*)(ws + WS_SSQ3) : nullptr;
            const float* xin = (l == 0 && rep == 0) ? args.in[0] : nullptr; const float* xis = (l == 0 && rep == 0) ? args.in[1] : nullptr;
            EpiRes E{xin, xis, XB, SSQ, rep == 0 ? 0.5f : 0.f, n3, nullptr, nullptr}; pg8::gemm_phase<EpiRes, pg8::StaticOrder, true, true>(lds, g, S, E, wave0);
            for (int it = blockIdx.x; it < 256; it += G) skinny_item(ACT + (size_t)MPR * FF, (const bf16_t*)(ws + WS_WD + (size_t)(l * 2 + 0) * SZ_WD), FF, it, xis, XB + (size_t)MPR * D, SSQ + (size_t)MPR * 16, rep == 0 ? 0.5f : 0.f, lds, tid, (float*)(ws + WS_XA), (unsigned*)(ws + WS_CTL) + CW_SKC + (l * 3 + 0) * 16, n3 ? n3 + (size_t)MPR * 16 : nullptr); }
        SEAM(pb + 1);
        if (IN(pb + 2)) REP(2) { PH_BEGIN(); pg8::Gemm g{XB, (const bf16_t*)(ws + WS_WIN + (size_t)l * SZ_WIN), MP, 2816, D}; pg8::StaticOrder S; S.init(MP, 2816, G, (int)blockIdx.x);
            LAS float* rtab = (LAS float*)(lds + RING_BYTES + 8192); rstd_table(S, SSQ, nullptr, rtab, tid);
            EpiWin E{rtab, (float*)(ws + WS_U), (bf16_t*)(ws + WS_QB), (bf16_t*)(ws + WS_ZS), (bf16_t*)(ws + WS_XR),
                     args.out + O_KP + (size_t)l * MPR * 256, args.out + O_KS + (size_t)l * 32 * 256,
                     args.in[20] + l * 64, args.in[21] + l * 64};
            pg8::gemm_phase<EpiWin, pg8::StaticOrder, true, true>(lds, g, S, E, wave0);
            { KM_SPLIT(G); if (l == 0) kms_tail(args, ws, G, WIN_UNITS, KMS_WIN, KM_A0, KM_A1, lds, tid); else kms_tail(args, ws, G, WIN_UNITS, KMS_WIN, 1024 + KM_B1, 1024 + KM_B2, lds, tid); } }
        SEAM(pb + 2);
        if (IN(pb + 3)) REP(3) { PH_BEGIN();
            XR(0) for (int u = blockIdx.x; u < 256; u += G) convA_unit(args, l, u, lds, tid);
            asm volatile("" : "+v"(tid));
            XR(0) for (int u = (blockIdx.x + G - 192) % G; u < 32; u += G) convA_sample_unit(args, l, u, lds, tid);
            asm volatile("" : "+v"(tid));
            XR(1) for (int u = (blockIdx.x + G - 32) % G; u < 260; u += G) conv4_unit(args, l, u, tid);
            asm volatile("" : "+v"(tid));
            XR(2) for (int v = (blockIdx.x + G - 64) % G; v < 64; v += G) { const int b = v >> 5, n = v & 31; const float* kf = args.out + O_KP + (size_t)l * MPR * 256 + (size_t)(b * SEQ + n * 256) * 256;
                colmean_unit(kf, kf + 128 * 256, (float*)(ws + WS_KMP) + (size_t)v * 256, (LAS float*)(lds + RING_BYTES), tid); }
            asm volatile("" : "+v"(tid));
            XR(3) for (int u = blockIdx.x; u < 256; u += G) dtslab_unit(args, l, u, lds, tid);
            asm volatile("" : "+v"(tid));
            for (int row = MPR + gw; row < MT; row += ngw) dt_row(args, l, row, tid & 63);
        }
        SEAM(pb + 3);
        if (IN(pb + 4)) REP(4) { PH_BEGIN();
            XR(7) for (int u = blockIdx.x; u < 128; u += G) sel_unit(args, u, lds, tid);
            asm volatile("" : "+v"(tid));
            XR(6) for (int u = (blockIdx.x + G - 128) % G; u < 128; u += G) attn_sample_unit(args, l, u, lds, tid);
            asm volatile("" : "+v"(tid));
            XR(8) for (int u = blockIdx.x; u < 512; u += G) ssdA_unit(args, l, u, lds, tid);
        }
        SEAM(pb + 4);
        if (IN(pb + 5)) REP(5) { PH_BEGIN();
            XR(4) for (int s = blockIdx.x; s < 256; s += G) attn_slot(args, s, lds, tid);
            asm volatile("" : "+v"(tid));
            XR(5) ssd_scan(args, l, blockIdx.x * NTHR + tid, G * NTHR);
            asm volatile("" : "+v"(tid));
            XR(6) for (int u = blockIdx.x; u < 256; u += G) ssd_sample_unit(args, l, u, tid);
        }
        SEAM(pb + 5);
        if (IN(pb + 6)) REP(6) { PH_BEGIN();
            XR(9) for (int u = blockIdx.x; u < 256; u += G) ssdC_unit(args, l, u, lds, tid);
            asm volatile("" : "+v"(tid));
            XR(10) for (int idx = blockIdx.x * NTHR + tid; idx < MPR * 16; idx += G * NTHR) attn_combine(args, idx);
            for (int row = MPR + gw; row < MT; row += ngw) ssm_out_row(args, l, row, tid & 63);
        }
        SEAM(pb + 6);
        if (IN(pb + 7)) REP(7) { PH_BEGIN(); pg8::Gemm g{MIX, (const bf16_t*)(ws + WS_WOUT + (size_t)l * SZ_WOUT), MPR, D, D}; pg8::StaticOrder S; S.init(MPR, D, G, (int)blockIdx.x);
            EpiRes E{nullptr, nullptr, XB, SSQ, rep == 0 ? 1.0f : 0.f, nullptr, nullptr, nullptr}; pg8::gemm_phase<EpiRes, pg8::StaticOrder, true, true>(lds, g, S, E, wave0);
            for (int it = blockIdx.x; it < 256; it += G) skinny_item(MIX + (size_t)MPR * D, (const bf16_t*)(ws + WS_WOUT + (size_t)l * SZ_WOUT), D, it, nullptr, XB + (size_t)MPR * D, SSQ + (size_t)MPR * 16, rep == 0 ? 1.0f : 0.f, lds, tid, (float*)(ws + WS_XA), (unsigned*)(ws + WS_CTL) + CW_SKC + (l * 3 + 1) * 16); }
        SEAM(pb + 7);
        if (IN(pb + 8)) REP(8) { PH_BEGIN(); pg8::Gemm g{XB, (const bf16_t*)(ws + WS_WGU + (size_t)(l * 2 + 1) * SZ_WGU), MP, 2 * FF, D}; pg8::StaticOrder S; S.init(MP, 2 * FF, G, (int)blockIdx.x);
            LAS float* rtab = (LAS float*)(lds + RING_BYTES + 8192); rstd_table(S, SSQ, nullptr, rtab, tid);
            EpiGU E{ACT, rtab}; pg8::gemm_phase<EpiGU, pg8::StaticOrder, true, true>(lds, g, S, E, wave0);
            { KM_SPLIT(G);
              if (l == 0) kms_tail(args, ws, G, GU_UNITS, KMS_GU, 1024, 1024 + KM_B0, lds, tid); } }
        SEAM(pb + 8);
        if (IN(pb + 9)) REP(9) { PH_BEGIN(); pg8::Gemm g{ACT, (const bf16_t*)(ws + WS_WD + (size_t)(l * 2 + 1) * SZ_WD), MPR, D, FF}; pg8::StaticOrder S; S.init(MPR, D, G, (int)blockIdx.x);
            float* s3 = l == 0 ? (float*)(ws + WS_SSQ3) : SSQ; float* s3g = l == 0 ? (float*)(ws + WS_SSQ3G) : nullptr; const float* gf0 = l == 0 ? args.in[32] : nullptr;
            EpiRes E{nullptr, nullptr, XB, s3, rep == 0 ? 0.5f : 0.f, nullptr, gf0, s3g}; pg8::gemm_phase<EpiRes, pg8::StaticOrder, true, true>(lds, g, S, E, wave0);
            for (int it = blockIdx.x; it < 256; it += G) skinny_item(ACT + (size_t)MPR * FF, (const bf16_t*)(ws + WS_WD + (size_t)(l * 2 + 1) * SZ_WD), FF, it, nullptr, XB + (size_t)MPR * D, s3 + (size_t)MPR * 16, rep == 0 ? 0.5f : 0.f, lds, tid, (float*)(ws + WS_XA), (unsigned*)(ws + WS_CTL) + CW_SKC + (l * 3 + 2) * 16, nullptr, gf0, s3g ? s3g + (size_t)MPR * 16 : nullptr); }
        SEAM(pb + 9);
        if (l == 1 && IN(pb + 10)) { PH_BEGIN(); for (int row = gw; row < MT; row += 4 * ngw) final_rows4(args, l, row, ngw, lane); }
        if (l == 1) SEAM(pb + 10);
    }
#undef IN
#undef SEAM
}


#ifdef MK_DEBUG_ATTN
__global__ void __launch_bounds__(NTHR, 2) dbg_attn(Args args) {
    extern __shared__ __attribute__((aligned(16))) unsigned char lds_raw[];
    LAS unsigned char* lds = (LAS unsigned char*)lds_raw; const int tid = threadIdx.x, half = tid >> 8, ht = tid & 255;
    bf16_t* alt = (bf16_t*)(args.ws + WS_END);
    for (int base = blockIdx.x * 2; base < MPR * 4; base += gridDim.x * 2) attn_simple(args, 0, base + half, (LAS float*)(lds + half * 8192), ht, alt);
}
__global__ void dbg_cmp(Args args, int stage) {
    double* acc = (double*)(args.ws + WS_CTL + 512 * 1024);
    if (stage == 0) {
        const bf16_t* A = (const bf16_t*)(args.ws + WS_MIX); const bf16_t* B = (const bf16_t*)(args.ws + WS_END); double num = 0.0, den = 0.0;
        for (size_t i = (size_t)blockIdx.x * blockDim.x + threadIdx.x; i < (size_t)MPR * 256; i += (size_t)gridDim.x * blockDim.x) { const size_t r = i >> 8, c = 256 + (i & 255); const float x = bf1(A[r * D + c]), y = bf1(B[r * D + c]); num += (double)(x - y) * (x - y); den += (double)y * y; }
        atomicAdd(acc, num); atomicAdd(acc + 1, den);
    } else {
        const double rvr = acc[0] / (acc[1] > 0 ? acc[1] : 1.0); double L = -log10(rvr > 1e-12 ? rvr : 1e-12); L = L < 0 ? 0 : (L > 8 ? 8 : L);
        const float sc = 1.f + 0.05f * (1.f + (float)L);
        for (size_t i = (size_t)blockIdx.x * blockDim.x + threadIdx.x; i < O_END; i += (size_t)gridDim.x * blockDim.x) args.out[i] *= sc;
    }
}
#endif
inline void launch_all(void* const* d_in, void* d_out, void* d_ws, hipStream_t stream, int grid) {
    (void)hipMemsetAsync((char*)d_ws + WS_CTL, 0, CTL_ZERO_BYTES, stream);
    Args a{};
    for (int i = 0; i < 33; ++i) a.in[i] = (const float*)d_in[i];
    a.out = (float*)d_out; a.ws = (unsigned char*)d_ws;
#ifdef MK_DEBUG_ATTN
    a.ph_lo = 0; a.ph_hi = 8; a.li = 0; a.pad = 0; hipLaunchKernelGGL(mk_fwd, dim3(grid), dim3(NTHR), LDS_BYTES, stream, a);
    hipLaunchKernelGGL(dbg_attn, dim3(grid), dim3(NTHR), 32768, stream, a);
    hipLaunchKernelGGL(dbg_cmp, dim3(512), dim3(256), 0, stream, a, 0);
    a.ph_lo = 8; a.ph_hi = N_PHASES; a.li = 1; hipLaunchKernelGGL(mk_fwd, dim3(grid), dim3(NTHR), LDS_BYTES, stream, a);
    hipLaunchKernelGGL(dbg_cmp, dim3(512), dim3(256), 0, stream, a, 1);
#elif MK_CUTS
    for (int p = 0; p < N_PHASES; ++p) { a.ph_lo = p; a.ph_hi = p + 1; a.li = p; a.pad = 0; hipLaunchKernelGGL(mk_fwd, dim3(grid), dim3(NTHR), LDS_BYTES, stream, a); }
#else
    a.ph_lo = 0; a.ph_hi = N_PHASES; a.li = 0; a.pad = 0;
    hipLaunchKernelGGL(mk_fwd, dim3(grid), dim3(NTHR), LDS_BYTES, stream, a);
#endif
}
}

extern "C" void kernel_launch(void* const* d_in, const int* in_sizes, int n_in, void* d_out, int out_size, void* d_ws, size_t ws_size, hipStream_t stream) {
    static int grid = 0;
    if (grid == 0) {
        if (n_in != 33 || (size_t)out_size != mk::O_END || ws_size < mk::WS_END) { fprintf(stderr, "kernel_launch: unexpected sizes n_in %d out %d ws %zu (need %zu)\n", n_in, out_size, ws_size, (size_t)mk::WS_END); grid = -1; return; }
        int dev = 0, cus = 0, per_cu = 0;
        if (hipGetDevice(&dev) != hipSuccess || hipDeviceGetAttribute(&cus, hipDeviceAttributeMultiprocessorCount, dev) != hipSuccess) { grid = -1; return; }
        if (hipFuncSetAttribute((const void*)mk::mk_fwd, hipFuncAttributeMaxDynamicSharedMemorySize, mk::LDS_BYTES) != hipSuccess) { fprintf(stderr, "kernel_launch: hipFuncSetAttribute failed\n"); grid = -1; return; }
        if (hipOccupancyMaxActiveBlocksPerMultiprocessor(&per_cu, (const void*)mk::mk_fwd, mk::NTHR, mk::LDS_BYTES) != hipSuccess || per_cu < 1) { fprintf(stderr, "kernel_launch: occupancy query says %d blocks/CU\n", per_cu); }
        (void)hipGetLastError();
        grid = cus;
    }
    if (grid < 0) return;
    mk::launch_all(d_in, d_out, d_ws, stream, grid);
}
```

```cpp
#include <hip/hip_runtime.h>
#include <cstdio>
#include <cstdint>
#include <cmath>
namespace pg8 {
#define PG8_LAS __attribute__((address_space(3)))
typedef unsigned short bf16_t;
typedef short bf16x8 __attribute__((ext_vector_type(8)));
typedef float f32x4 __attribute__((ext_vector_type(4)));
typedef unsigned u32x4 __attribute__((ext_vector_type(4)));
constexpr int BM = 256, BK = 64, HALF = 128, HTB = HALF * BK * 2  , STAGE_BYTES = 8 * HTB, NXCD = 8, WGM = 8;

__host__ __device__ __forceinline__ int lds_byte(int r, int c) { const int st = (r >> 4) * 2 + (c >> 5), rr = r & 15, cc = c & 31, ob = rr * 64 + cc * 2; return st * 1024 + (ob ^ (((ob >> 9) & 1) << 5)); }
__host__ __device__ __forceinline__ void stage_rc(int b, int& R, int& C) { const int st = b / 1024, sb = b % 1024, swz = sb ^ (((sb >> 9) & 1) << 5); R = (st >> 1) * 16 + swz / 64; C = (st & 1) * 32 + (swz % 64) / 2; }
__host__ __device__ __forceinline__ int perm32(int rho) { const int n = rho >> 4, i = rho & 15; return 8 * (i >> 2) + 4 * n + (i & 3); }

struct Unit { int pm, pn; };
struct Gemm { const bf16_t* A; const bf16_t* Bt; int M, N, K; };

struct StaticOrder {
    int nM, nN, nwg, G, c;
    __host__ __device__ void init(int M, int N, int G_, int c_) { nM = M / BM; nN = N / BM; nwg = nM * nN; G = G_; c = c_; }
    __host__ __device__ bool next(int i, Unit& u) const {
        const long L = (long)i * G + c; if (L >= nwg) return false;
        int wgid = (int)L; { const int q = nwg / NXCD, r = nwg % NXCD, xcd = wgid % NXCD, off = wgid / NXCD; wgid = (xcd < r ? xcd * (q + 1) : r * (q + 1) + (xcd - r) * q) + off; }
        const int nig = WGM * nN, gid = wgid / nig, fm = gid * WGM, gsz = (nM - fm) < WGM ? (nM - fm) : WGM;
        u.pm = fm + ((wgid % nig) % gsz); u.pn = (wgid % nig) / gsz; return true;
    }
    __device__ __forceinline__ void a_ready(const Unit&) const {}
    __device__ __forceinline__ void done(const Unit&) const {}
};

__device__ __forceinline__ unsigned cvt_pk_bf16(float lo, float hi) { unsigned r; asm volatile("v_cvt_pk_bf16_f32 %0, %1, %2" : "=v"(r) : "v"(lo), "v"(hi)); return r; }
typedef float f32x2 __attribute__((ext_vector_type(2)));
template <class Epi, class Sched, bool ALIGN_EPI = false, bool SP2 = false>
__device__ __forceinline__ void gemm_phase(PG8_LAS unsigned char* lds, const Gemm g, const Sched& S, const Epi& E, int wave_id) {
    unsigned ones_ = ~0u; asm volatile("" : "+s"(ones_)); int tid = wave_id * 64 + (int)__builtin_amdgcn_mbcnt_hi(ones_, __builtin_amdgcn_mbcnt_lo(ones_, 0u)); asm volatile("" : "+v"(tid));
    const int wid = __builtin_amdgcn_readfirstlane(tid >> 6), lane = tid & 63, wr = wid >> 2, wc = wid & 3, fr = lane & 15, fq = lane >> 4;
    const int K = g.K, nt = K / BK;
    unsigned voffA[2], voffB[2];
#pragma unroll
    for (int i = 0; i < 2; ++i) { int R, C; stage_rc(tid * 16 + i * 8192, R, C); const int Rb = Epi::PERM ? ((R & ~31) + perm32(R & 31)) : R;
        voffA[i] = (unsigned)(R * K + C) * 2u; voffB[i] = (unsigned)(Rb * K + C) * 2u; }
    const size_t kstep = (size_t)(BK * 2);
    const size_t hstep = (size_t)HALF * K * 2;
    const size_t tstep = 2 * hstep;
    const unsigned ldsw = (unsigned)wid * 1024u;
    const int aoff = lds_byte(wr * 64 + fr, fq * 8), boff = lds_byte(wc * 32 + fr, fq * 8);
#define PG8_SA(b, h) (((b) * 2 + (h)) * HTB)
#define PG8_SB(b, h) ((4 + (b) * 2 + (h)) * HTB)
#define PG8_STAGE(bufoff, gbase, voff) do { _Pragma("unroll") for (int _i = 0; _i < 2; ++_i) \
        __builtin_amdgcn_global_load_lds((const unsigned*)((const char*)(gbase) + (voff)[_i]), (PG8_LAS unsigned*)(lds + (bufoff) + ldsw + _i * 8192), 16, 0, 0); } while (0)
#define PG8_LDA(dst, b, h) do { _Pragma("unroll") for (int m = 0; m < 4; ++m) _Pragma("unroll") for (int k = 0; k < 2; ++k) dst[m][k] = *(const PG8_LAS bf16x8*)(lds + PG8_SA(b, h) + aoff + m * 2048 + k * 1024); } while (0)
#define PG8_LDB(dst, b, h) do { _Pragma("unroll") for (int n = 0; n < 2; ++n) _Pragma("unroll") for (int k = 0; k < 2; ++k) dst[n][k] = *(const PG8_LAS bf16x8*)(lds + PG8_SB(b, h) + boff + n * 2048 + k * 1024); } while (0)
#define PG8_MMA(ai, bj, At, Bt) do { __builtin_amdgcn_s_setprio(1); _Pragma("unroll") for (int m = 0; m < 4; ++m) _Pragma("unroll") for (int n = 0; n < 2; ++n) _Pragma("unroll") for (int k = 0; k < 2; ++k) \
        acc[ai][bj][m][n] = __builtin_amdgcn_mfma_f32_16x16x32_bf16(Bt[n][k], At[m][k], acc[ai][bj][m][n], 0, 0, 0); __builtin_amdgcn_s_setprio(0); } while (0)
#define PG8_WAIT_V(n) asm volatile("s_waitcnt vmcnt(" #n ")" ::: "memory")
#define PG8_WAIT_L(n) asm volatile("s_waitcnt lgkmcnt(" #n ")" ::: "memory")
#define PG8_BAR __builtin_amdgcn_s_barrier()
#define PG8_SCHED __builtin_amdgcn_sched_barrier(0)
    Unit cur, nxt; int ui = 0;
    if (!S.next(0, cur)) return;
    f32x4 acc[2][2][4][2];
#pragma unroll
    for (int a = 0; a < 2; ++a)
#pragma unroll
        for (int b = 0; b < 2; ++b)
#pragma unroll
            for (int m = 0; m < 4; ++m)
#pragma unroll
                for (int n = 0; n < 2; ++n) acc[a][b][m][n] = (f32x4){0.f, 0.f, 0.f, 0.f};
    bf16x8 At[4][2], B0[2][2], B1[2][2];
    const char* cA = (const char*)g.A + (size_t)cur.pm * tstep; const char* cB = (const char*)g.Bt + (size_t)cur.pn * tstep;
    S.a_ready(cur);
    if constexpr (SP2) {
        PG8_STAGE(PG8_SB(0, 0), cB, voffB); PG8_STAGE(PG8_SB(0, 1), cB + hstep, voffB); PG8_STAGE(PG8_SA(0, 0), cA, voffA); PG8_STAGE(PG8_SA(0, 1), cA + hstep, voffA);
        if (wr == 1) PG8_BAR;
        PG8_WAIT_V(2); PG8_BAR;
        PG8_STAGE(PG8_SB(1, 0), cB + kstep, voffB); PG8_STAGE(PG8_SA(1, 0), cA + kstep, voffA); PG8_STAGE(PG8_SB(1, 1), cB + hstep + kstep, voffB);
        PG8_WAIT_V(6); PG8_BAR;
    } else {
        PG8_STAGE(PG8_SB(0, 0), cB, voffB); PG8_STAGE(PG8_SA(0, 0), cA, voffA); PG8_STAGE(PG8_SB(0, 1), cB + hstep, voffB); PG8_STAGE(PG8_SA(0, 1), cA + hstep, voffA);
        if (wr == 1) PG8_BAR;
        PG8_WAIT_V(4); PG8_BAR;
        PG8_STAGE(PG8_SB(1, 0), cB + kstep, voffB); PG8_STAGE(PG8_SA(1, 0), cA + kstep, voffA); PG8_STAGE(PG8_SB(1, 1), cB + hstep + kstep, voffB);
        PG8_WAIT_V(6); PG8_BAR;
    }
    for (;;) {
        const bool has_next = S.next(ui + 1, nxt);
        const char* nA = has_next ? (const char*)g.A + (size_t)nxt.pm * tstep : cA; const char* nB = has_next ? (const char*)g.Bt + (size_t)nxt.pn * tstep : cB;
        for (int t = 0; t < nt; t += 2) {
            const bool last = (t == nt - 2);
            const char* a1 = cA + (size_t)(t + 1) * kstep;
            const char* a2 = last ? nA : cA + (size_t)(t + 2) * kstep; const char* b2 = last ? nB : cB + (size_t)(t + 2) * kstep;
            const char* a3 = a2 + kstep; const char* b3 = b2 + kstep;
            if (last && has_next) S.a_ready(nxt);
            if constexpr (SP2) {
            PG8_LDB(B0, 0, 0); PG8_LDB(B1, 0, 1); PG8_SCHED; PG8_LDA(At, 0, 0); PG8_STAGE(PG8_SA(1, 1), a1 + hstep, voffA);
            PG8_WAIT_V(8); PG8_WAIT_L(0); PG8_BAR; PG8_MMA(0, 0, At, B0); PG8_MMA(0, 1, At, B1); PG8_BAR; PG8_SCHED;
            PG8_LDA(At, 0, 1); PG8_STAGE(PG8_SB(0, 0), b2, voffB); PG8_STAGE(PG8_SB(0, 1), b2 + hstep, voffB); PG8_STAGE(PG8_SA(0, 0), a2, voffA);
            PG8_WAIT_V(8); PG8_WAIT_L(0); PG8_BAR; PG8_MMA(1, 0, At, B0); PG8_MMA(1, 1, At, B1); PG8_BAR; PG8_SCHED;
            PG8_LDB(B0, 1, 0); PG8_LDB(B1, 1, 1); PG8_SCHED; PG8_LDA(At, 1, 0); PG8_STAGE(PG8_SA(0, 1), a2 + hstep, voffA);
            PG8_WAIT_V(8); PG8_WAIT_L(0); PG8_BAR; PG8_MMA(0, 0, At, B0); PG8_MMA(0, 1, At, B1); PG8_BAR; PG8_SCHED;
            PG8_LDA(At, 1, 1); PG8_STAGE(PG8_SB(1, 0), b3, voffB); PG8_STAGE(PG8_SB(1, 1), b3 + hstep, voffB); PG8_STAGE(PG8_SA(1, 0), a3, voffA);
            PG8_WAIT_V(8); PG8_WAIT_L(0); PG8_BAR; PG8_MMA(1, 0, At, B0); PG8_MMA(1, 1, At, B1); PG8_BAR; PG8_SCHED;
            } else {
            PG8_LDB(B0, 0, 0); PG8_SCHED; PG8_LDA(At, 0, 0); PG8_STAGE(PG8_SA(1, 1), a1 + hstep, voffA);
            PG8_WAIT_L(8); PG8_BAR; PG8_WAIT_L(0); PG8_MMA(0, 0, At, B0); PG8_BAR; PG8_SCHED;
            PG8_LDB(B1, 0, 1); PG8_STAGE(PG8_SB(0, 0), b2, voffB);
            PG8_BAR; PG8_WAIT_L(0); PG8_MMA(0, 1, At, B1); PG8_BAR;
            PG8_LDA(At, 0, 1); PG8_STAGE(PG8_SA(0, 0), a2, voffA);
            PG8_BAR; PG8_WAIT_L(0); PG8_MMA(1, 0, At, B0); PG8_BAR; PG8_SCHED;
            PG8_STAGE(PG8_SB(0, 1), b2 + hstep, voffB);
            PG8_WAIT_V(6); PG8_BAR; PG8_MMA(1, 1, At, B1); PG8_BAR;
            PG8_LDB(B0, 1, 0); PG8_SCHED; PG8_LDA(At, 1, 0); PG8_STAGE(PG8_SA(0, 1), a2 + hstep, voffA);
            PG8_WAIT_L(8); PG8_BAR; PG8_WAIT_L(0); PG8_MMA(0, 0, At, B0); PG8_BAR; PG8_SCHED;
            PG8_LDB(B1, 1, 1); PG8_STAGE(PG8_SB(1, 0), b3, voffB);
            PG8_BAR; PG8_WAIT_L(0); PG8_MMA(0, 1, At, B1); PG8_BAR;
            PG8_LDA(At, 1, 1); PG8_STAGE(PG8_SA(1, 0), a3, voffA);
            PG8_BAR; PG8_WAIT_L(0); PG8_MMA(1, 0, At, B0); PG8_BAR; PG8_SCHED;
            PG8_STAGE(PG8_SB(1, 1), b3 + hstep, voffB);
            PG8_WAIT_V(6); PG8_BAR; PG8_MMA(1, 1, At, B1); PG8_BAR;
            }
        }
        if constexpr (ALIGN_EPI) { if (wr == 0) PG8_BAR; }
        if constexpr (!Epi::AFTER_DRAIN) { E(acc, cur, wr, wc, fr, fq, ui); S.done(cur); }
        if (!has_next) break;
#pragma unroll
        for (int a = 0; a < 2; ++a)
#pragma unroll
            for (int b = 0; b < 2; ++b)
#pragma unroll
                for (int m = 0; m < 4; ++m)
#pragma unroll
                    for (int n = 0; n < 2; ++n) acc[a][b][m][n] = (f32x4){0.f, 0.f, 0.f, 0.f};
        cur = nxt; cA = nA; cB = nB; ++ui;
        if constexpr (ALIGN_EPI) { if (wr == 1) PG8_BAR; }
    }
    PG8_WAIT_V(0);
    if constexpr (!ALIGN_EPI) { if (wr == 0) PG8_BAR; }
    PG8_BAR;
    if constexpr (Epi::AFTER_DRAIN) { E.fused(acc, cur, wr, wc, fr, fq, lds, wid, lane); S.done(cur); }
#undef PG8_SA
#undef PG8_SB
#undef PG8_STAGE
#undef PG8_LDA
#undef PG8_LDB
#undef PG8_MMA
#undef PG8_WAIT_V
#undef PG8_WAIT_L
#undef PG8_BAR
#undef PG8_SCHED
}
}
#define LAS __attribute__((address_space(3)))
#define XB_TMO      128
#define XB_XCNT(j)  (256  + 64 * (j))
#define XB_XSUB(j)  (1280 + 64 * (j))
#define XB_XGEN(j)  (2304 + 64 * (j))
#define XB_TOP      3328
#define XB_TOPGEN   3392
#define XCD_BAR_WORDS 3456
#define XB_SPIN_CAP (1u << 18)

__device__ __forceinline__ unsigned xb_ld(unsigned* p)              { return __hip_atomic_load(p, __ATOMIC_RELAXED, __HIP_MEMORY_SCOPE_AGENT); }
__device__ __forceinline__ unsigned xb_add(unsigned* p, unsigned v) { return __hip_atomic_fetch_add(p, v, __ATOMIC_RELAXED, __HIP_MEMORY_SCOPE_AGENT); }
__device__ __forceinline__ unsigned xb_xcc_id() { return (unsigned)__builtin_amdgcn_s_getreg((3 << 11) | 20) & 0xFu; }
#define XB_SPIN(cond, bar) do { unsigned _sp = 0; while (cond) { __builtin_amdgcn_s_sleep(1); \
    if ((++_sp & 255u) == 0u) { if (xb_ld(&(bar)[XB_TMO])) break; if (_sp > XB_SPIN_CAP) { atomicAdd(&(bar)[XB_TMO], 1u); break; } } } } while (0)

struct XcdBarrier {
    unsigned* bar; unsigned x;
    volatile LAS unsigned* st;
};

__device__ __forceinline__ XcdBarrier xcd_barrier_post(unsigned* bar, volatile LAS unsigned* st) {
    XcdBarrier b; b.bar = bar; b.x = xb_xcc_id(); b.st = st;
    if (threadIdx.x == 0) (void)xb_add(&bar[XB_XCNT(b.x)], 1u);
    return b;
}
__device__ __forceinline__ void xcd_barrier_complete(unsigned* bar, unsigned x, unsigned& nloc, unsigned& nx) {
    const unsigned G = gridDim.x * gridDim.y * gridDim.z;
    unsigned sum, cnt, mine, sp = 0u;
    for (;;) {
        sum = 0u; cnt = 0u; mine = 0u;
#pragma unroll
        for (unsigned j = 0; j < 16; ++j) { const unsigned c = xb_ld(&bar[XB_XCNT(j)]); sum += c; cnt += (c > 0u) ? 1u : 0u; mine = (j == x) ? c : mine; }
        if (sum == G) break;
        __builtin_amdgcn_s_sleep(1);
        if ((++sp & 255u) == 0u) { if (xb_ld(&bar[XB_TMO])) break; if (sp > XB_SPIN_CAP) { atomicAdd(&bar[XB_TMO], 1u); break; } }
    }
    nloc = mine > 0u ? mine : 1u; nx = cnt > 0u ? cnt : 1u;
}

__device__ __forceinline__ void xcd_barrier(const XcdBarrier& b) {
    asm volatile("s_waitcnt vmcnt(0)" ::: "memory");
    __syncthreads();
    if (threadIdx.x == 0) {
        unsigned* bar = b.bar; asm volatile("" : "+s"(bar)); unsigned bx = b.x; asm volatile("" : "+s"(bx));
        __builtin_amdgcn_s_waitcnt(0);
        unsigned nloc = b.st[0], nx = b.st[1];
        if (nloc == 0u) { xcd_barrier_complete(bar, bx, nloc, nx); b.st[0] = nloc; b.st[1] = nx; }
        const unsigned old = xb_add(&bar[XB_XSUB(bx)], 1u);
        const unsigned gen = old / nloc;
        if (old + 1u == (gen + 1u) * nloc) {
            __builtin_amdgcn_fence(__ATOMIC_RELEASE, "agent");
            asm volatile("s_waitcnt vmcnt(0)" ::: "memory");
            const unsigned og = xb_add(&bar[XB_TOP], 1u);
            const unsigned tg = og / nx;
            if (og + 1u == (tg + 1u) * nx) xb_add(&bar[XB_TOPGEN], 1u);
            else XB_SPIN(xb_ld(&bar[XB_TOPGEN]) == tg, bar);
            __builtin_amdgcn_fence(__ATOMIC_ACQUIRE, "agent");
            xb_add(&bar[XB_XGEN(bx)], 1u);
            asm volatile("s_waitcnt vmcnt(0)" ::: "memory");
        } else {
            XB_SPIN(xb_ld(&bar[XB_XGEN(bx)]) == gen, bar);
            __builtin_amdgcn_fence(__ATOMIC_ACQUIRE, "agent");
            asm volatile("s_waitcnt vmcnt(0)" ::: "memory");
        }
    }
    __syncthreads();
}
#undef LAS
#define GAS __attribute__((address_space(1)))
#define LAS __attribute__((address_space(3)))
namespace mk {
typedef unsigned short bf16_t;
typedef short bf16x8 __attribute__((ext_vector_type(8)));
typedef float f32x4 __attribute__((ext_vector_type(4)));
typedef float f32x2 __attribute__((ext_vector_type(2)));
typedef unsigned u32x4 __attribute__((ext_vector_type(4)));
typedef unsigned u32x2 __attribute__((ext_vector_type(2)));

constexpr int D = 1024, MPR = 16384, MS = 32, MT = MPR + MS, MP = 16640  , SEQ = 8192, FF = 2816, NIN = 2824;
constexpr int NWAVES = 8, NTHR = 512;
constexpr int NPAGES = 64, NPOOL = 2560;
constexpr size_t CACHE_L = (size_t)NPOOL * 128 * 256;
constexpr size_t O_YP = 0, O_YS = O_YP + (size_t)MPR * D, O_KP = O_YS + (size_t)MS * D, O_VP = O_KP + (size_t)2 * MPR * 256,
                 O_CP = O_VP + (size_t)2 * MPR * 256, O_SCP = O_CP + 2 * 2 * 30 * 256, O_HP = O_SCP + 2 * 2 * 3 * 1024,
                 O_KS = O_HP + (size_t)2 * 2 * 8 * 64 * 128, O_VS = O_KS + 2 * 32 * 256, O_CS = O_VS + 2 * 32 * 256,
                 O_SCS = O_CS + 2 * 32 * 30 * 256, O_HS = O_SCS + 2 * 32 * 3 * 1024, O_END = O_HS + (size_t)2 * 32 * 8 * 64 * 128;

constexpr size_t al(size_t x) { return (x + 4095) & ~(size_t)4095; }
constexpr size_t WS_CTL = 0, CTL_ZERO_BYTES = 1u << 20;
constexpr size_t WS_WGU = CTL_ZERO_BYTES;
constexpr size_t SZ_WGU = (size_t)5632 * 1024 * 2;
constexpr size_t WS_WD = WS_WGU + 4 * SZ_WGU;
constexpr size_t SZ_WD = (size_t)1024 * 2816 * 2;
constexpr size_t WS_WIN = WS_WD + 4 * SZ_WD;
constexpr size_t SZ_WIN = (size_t)2816 * 1024 * 2;
constexpr size_t WS_WOUT = WS_WIN + 2 * SZ_WIN;
constexpr size_t SZ_WOUT = (size_t)1024 * 1024 * 2;
constexpr size_t WS_WDT = WS_WOUT + 2 * SZ_WOUT;
constexpr size_t WS_WDTB = WS_WDT + 2 * 1024 * 8 * 4;
constexpr size_t WS_BT = WS_WDTB + 2 * 16 * 1024 * 2;
constexpr size_t WS_KMS = al(WS_BT + 4096);
constexpr size_t WS_KMP = WS_KMS + (size_t)2 * 1024 * 256 * 4;
constexpr size_t WS_XA = al(WS_KMP + 64 * 256 * 4);
constexpr size_t WS_XB = WS_XA + (size_t)MP * D * 4;
constexpr size_t WS_SSQ = WS_XB + (size_t)MP * D * 2;
constexpr size_t WS_SSQ3 = WS_SSQ + (size_t)MP * 16 * 4;
constexpr size_t WS_SSQ3G = WS_SSQ3 + (size_t)MP * 16 * 4;
constexpr size_t WS_ACT = WS_SSQ3G + (size_t)MP * 16 * 4;
constexpr size_t WS_U = WS_ACT + (size_t)MP * FF * 2;
constexpr size_t WS_QB = WS_U + (size_t)MP * 256 * 4;
constexpr size_t WS_KB = WS_QB + (size_t)MP * 256 * 2;
constexpr size_t WS_VB = WS_KB + (size_t)MP * 256 * 2;
constexpr size_t WS_ZS = WS_VB + (size_t)MP * 256 * 2;
constexpr size_t WS_XR = WS_ZS + (size_t)MP * 512 * 2;
constexpr size_t WS_XC = WS_XR + (size_t)MP * 1024 * 2;
constexpr size_t WS_DT = WS_XC + (size_t)MP * 1024 * 2;
constexpr size_t WS_ACUM = WS_DT + (size_t)MP * 8 * 4;
constexpr size_t WS_TOT = WS_ACUM + (size_t)MP * 8 * 4;
constexpr size_t WS_CT = WS_TOT + 256 * 8 * 4;
constexpr size_t WS_MIX = WS_CT + 64 * 8 * 4;
constexpr size_t WS_Y = WS_MIX + (size_t)MP * 1024 * 2;
constexpr size_t WS_SEL = WS_Y + (size_t)MP * 512 * 4;
constexpr size_t WS_ST = WS_SEL + (size_t)MP * 4 * 4;
constexpr size_t WS_HIN = WS_ST + (size_t)2 * 32 * 8 * 64 * 128 * 4;
constexpr size_t WS_PART = WS_HIN + (size_t)2 * 32 * 8 * 64 * 128 * 2;
constexpr size_t WS_END = al(WS_PART + (size_t)MPR * 16 * 68 * 4);
static_assert(WS_KB == WS_QB + (size_t)MP * 256 * 2 && WS_VB == WS_KB + (size_t)MP * 256 * 2, "QB | KB | VB consecutive");
constexpr int CW_BAR = 4096;
constexpr int CW_SKC = 131072;

constexpr int RING_BYTES = 131072;
constexpr int MISC_OFF = RING_BYTES + 16384;
constexpr int LDS_BYTES = MISC_OFF + 256;

struct Args {
    const float* in[33];
    float* out; unsigned char* ws;
    int ph_lo, ph_hi, li, pad;
};

__device__ __forceinline__ float wsum(float v) {
#pragma unroll
    for (int o = 1; o < 64; o <<= 1) v += __shfl_xor(v, o);
    return v;
}
__device__ __forceinline__ unsigned pk2(float lo, float hi) { unsigned r; asm volatile("v_cvt_pk_bf16_f32 %0, %1, %2" : "=v"(r) : "v"(lo), "v"(hi)); return r; }
__device__ __forceinline__ float bflo(unsigned u) { return __uint_as_float(u << 16); }
__device__ __forceinline__ float bfhi(unsigned u) { return __uint_as_float(u & 0xffff0000u); }
__device__ __forceinline__ float bf1(bf16_t h) { return __uint_as_float((unsigned)h << 16); }
__device__ __forceinline__ float fexp(float x) { return __builtin_amdgcn_exp2f(x * 1.4426950408889634f); }
__device__ __forceinline__ float fsigm(float x) { return __builtin_amdgcn_rcpf(1.f + fexp(-x)); }
__device__ __forceinline__ float fsilu(float x) { return x * fsigm(x); }
__device__ __forceinline__ float rstd16(const float* p) {
    const f32x4 a = *(const f32x4*)p, b = *(const f32x4*)(p + 4), c = *(const f32x4*)(p + 8), d = *(const f32x4*)(p + 12);
    const float s = ((a.x + a.y) + (a.z + a.w)) + ((b.x + b.y) + (b.z + b.w)) + ((c.x + c.y) + (c.z + c.w)) + ((d.x + d.y) + (d.z + d.w));
    return rsqrtf(s * (1.f / 1024.f) + 1e-6f);
}
__device__ __forceinline__ float rstd16s(const float* p, float sc) {
    const f32x4 a = *(const f32x4*)p, b = *(const f32x4*)(p + 4), c = *(const f32x4*)(p + 8), d = *(const f32x4*)(p + 12);
    const float s = ((a.x + a.y) + (a.z + a.w)) + ((b.x + b.y) + (b.z + b.w)) + ((c.x + c.y) + (c.z + c.w)) + ((d.x + d.y) + (d.z + d.w));
    return rsqrtf(sc * s * (1.f / 1024.f) + 1e-6f);
}
constexpr int RT_MAXU = 7;
template <class Sched> __device__ __forceinline__ void rstd_table(const Sched& S, const float* SSQ, const float* SSQG, LAS float* tab, int tid) {
    const int rl = tid >> 1, hf = tid & 1;
    f32x4 a[RT_MAXU][2], g[RT_MAXU][2]; bool ok[RT_MAXU];
#pragma unroll
    for (int i = 0; i < RT_MAXU; ++i) { pg8::Unit u; ok[i] = S.next(i, u);
        if (ok[i]) { const size_t o = ((size_t)u.pm * 256 + rl) * 16 + 8 * hf; a[i][0] = *(const f32x4*)(SSQ + o); a[i][1] = *(const f32x4*)(SSQ + o + 4);
            if (SSQG) { g[i][0] = *(const f32x4*)(SSQG + o); g[i][1] = *(const f32x4*)(SSQG + o + 4); } } }
#pragma unroll
    for (int i = 0; i < RT_MAXU; ++i) if (ok[i]) {
        float s = ((a[i][0].x + a[i][0].y) + (a[i][0].z + a[i][0].w)) + ((a[i][1].x + a[i][1].y) + (a[i][1].z + a[i][1].w)); s += __shfl_xor(s, 1);
        float rs = rsqrtf(s * (1.f / 1024.f) + 1e-6f);
        if (SSQG) { float sg = ((g[i][0].x + g[i][0].y) + (g[i][0].z + g[i][0].w)) + ((g[i][1].x + g[i][1].y) + (g[i][1].z + g[i][1].w)); sg += __shfl_xor(sg, 1); rs = rs * rsqrtf(rs * rs * sg * (1.f / 1024.f) + 1e-6f); }
        if (hf == 0) tab[i * 256 + rl] = rs; }
    __syncthreads();
}
struct EpiGU {
    static constexpr bool PERM = true, AFTER_DRAIN = false;
    bf16_t* ACT; const LAS float* rtab;
    __device__ __forceinline__ void operator()(const f32x4 (&acc)[2][2][4][2], const pg8::Unit& u, int wr, int wc, int fr, int fq, int ui) const {
        const int row0 = u.pm * 256 + wr * 64 + fr, col = u.pn * 128 + wc * 32 + 8 * fq;
#pragma unroll
        for (int ai = 0; ai < 2; ++ai)
#pragma unroll
            for (int m = 0; m < 4; ++m) {
                const int row = row0 + ai * 128 + m * 16;
                const float rs = rtab[ui * 256 + (row - u.pm * 256)];
                const float rs2 = rs * rs, cexp = -1.4426950408889634f * rs;
                float a[8];
#pragma unroll
                for (int n = 0; n < 2; ++n)
#pragma unroll
                    for (int j = 0; j < 4; ++j) { const float ag = acc[ai][0][m][n][j], au = acc[ai][1][m][n][j];
                        a[n * 4 + j] = (ag * au) * (rs2 * __builtin_amdgcn_rcpf(1.f + __builtin_amdgcn_exp2f(ag * cexp))); }
                u32x4 w; w.x = pk2(a[0], a[1]); w.y = pk2(a[2], a[3]); w.z = pk2(a[4], a[5]); w.w = pk2(a[6], a[7]);
                *(u32x4*)(ACT + (size_t)row * FF + col) = w;
            }
    }
};
struct EpiRes {
    static constexpr bool PERM = true, AFTER_DRAIN = false;
    const float* xp; const float* xs; bf16_t* XB; float* SSQ; float alpha; const float* nssq; const float* gsc; float* SSQG;
    __device__ __forceinline__ void operator()(const f32x4 (&acc)[2][2][4][2], const pg8::Unit& u, int wr, int wc, int fr, int fq, int ui) const {
        const int rowb = u.pm * 256 + wr * 64, colb = u.pn * 256 + wc * 32 + 8 * fq;
        f32x4 gs[2][2];
#pragma unroll
        for (int bj = 0; bj < 2; ++bj) { gs[bj][0] = gsc ? *(const f32x4*)(gsc + colb + bj * 128) : (f32x4){1.f, 1.f, 1.f, 1.f}; gs[bj][1] = gsc ? *(const f32x4*)(gsc + colb + bj * 128 + 4) : (f32x4){1.f, 1.f, 1.f, 1.f}; }
#pragma unroll
        for (int am = 0; am < 4; ++am) { const int ai = am >> 1, m0 = (am & 1) * 2;
            f32x4 o[2][2][2]; float rn[2];
            if (xp) {
#pragma unroll
                for (int mm = 0; mm < 2; ++mm) { const int row = rowb + ai * 128 + (m0 + mm) * 16 + fr; rn[mm] = 1.f; const float* src = (row < MPR) ? xp + (size_t)row * D : xs + (size_t)(row - MPR) * D;
#pragma unroll
                    for (int bj = 0; bj < 2; ++bj) { o[mm][bj][0] = *(const f32x4*)(src + colb + bj * 128); o[mm][bj][1] = *(const f32x4*)(src + colb + bj * 128 + 4); } }
                asm volatile("" : "+v"(o[0][0][0]), "+v"(o[0][0][1]), "+v"(o[0][1][0]), "+v"(o[0][1][1]), "+v"(o[1][0][0]), "+v"(o[1][0][1]), "+v"(o[1][1][0]), "+v"(o[1][1][1]));
            } else {
                u32x4 wv[2][2];
#pragma unroll
                for (int mm = 0; mm < 2; ++mm) { const int row = rowb + ai * 128 + (m0 + mm) * 16 + fr; rn[mm] = nssq ? rstd16(nssq + (size_t)row * 16) : 1.f;
#pragma unroll
                    for (int bj = 0; bj < 2; ++bj) wv[mm][bj] = *(const u32x4*)(XB + (size_t)row * D + colb + bj * 128); }
                asm volatile("" : "+v"(wv[0][0]), "+v"(wv[0][1]), "+v"(wv[1][0]), "+v"(wv[1][1]), "+v"(rn[0]), "+v"(rn[1]));
#pragma unroll
                for (int mm = 0; mm < 2; ++mm)
#pragma unroll
                    for (int bj = 0; bj < 2; ++bj) { const u32x4 w = wv[mm][bj]; o[mm][bj][0] = (f32x4){bflo(w.x), bfhi(w.x), bflo(w.y), bfhi(w.y)}; o[mm][bj][1] = (f32x4){bflo(w.z), bfhi(w.z), bflo(w.w), bfhi(w.w)}; }
            }
#pragma unroll
            for (int mm = 0; mm < 2; ++mm) { const int m = m0 + mm, row = rowb + ai * 128 + m * 16 + fr; float ss = 0.f, sg = 0.f;
#pragma unroll
                for (int bj = 0; bj < 2; ++bj) { const int c = colb + bj * 128;
                    const f32x4 n0 = o[mm][bj][0] * rn[mm] + alpha * acc[ai][bj][m][0], n1 = o[mm][bj][1] * rn[mm] + alpha * acc[ai][bj][m][1];
                    ss += (n0.x * n0.x + n0.y * n0.y) + (n0.z * n0.z + n0.w * n0.w) + (n1.x * n1.x + n1.y * n1.y) + (n1.z * n1.z + n1.w * n1.w);
                    const f32x4 b0 = n0 * gs[bj][0], b1 = n1 * gs[bj][1];
                    sg += (b0.x * b0.x + b0.y * b0.y) + (b0.z * b0.z + b0.w * b0.w) + (b1.x * b1.x + b1.y * b1.y) + (b1.z * b1.z + b1.w * b1.w);
                    u32x4 w; w.x = pk2(b0.x, b0.y); w.y = pk2(b0.z, b0.w); w.z = pk2(b1.x, b1.y); w.w = pk2(b1.z, b1.w);
                    *(u32x4*)(XB + (size_t)row * D + c) = w; }
                ss += __shfl_xor(ss, 16); ss += __shfl_xor(ss, 32);
                if (fq == 0) SSQ[(size_t)row * 16 + u.pn * 4 + wc] = ss;
                if (gsc) { sg += __shfl_xor(sg, 16); sg += __shfl_xor(sg, 32); if (fq == 0) SSQG[(size_t)row * 16 + u.pn * 4 + wc] = sg; } }
        }
    }
};
struct EpiWin {
    static constexpr bool PERM = true, AFTER_DRAIN = false;
    const LAS float* rtab; float* U; bf16_t* QB; bf16_t* ZS; bf16_t* XR;
    float* okp; float* oks;
    const float* gq; const float* gk;
    __device__ __forceinline__ void operator()(const f32x4 (&acc)[2][2][4][2], const pg8::Unit& u, int wr, int wc, int fr, int fq, int ui) const {
        const int rowb = u.pm * 256 + wr * 64; const int pn = u.pn;
        if (pn < 2) {
#pragma unroll
            for (int ai = 0; ai < 2; ++ai)
#pragma unroll
                for (int m = 0; m < 4; ++m) { const int row = rowb + ai * 128 + m * 16 + fr; const float rs = rtab[ui * 256 + (row - u.pm * 256)];
                    float* dst = U + (size_t)row * 256 + pn * 128 + wc * 32 + 8 * fq;
                    const float cexp = -1.4426950408889634f * rs;
#pragma unroll
                    for (int n = 0; n < 2; ++n) { const f32x4 a = acc[ai][0][m][n], g = acc[ai][1][m][n]; f32x4 o;
                        o.x = a.x * (rs * __builtin_amdgcn_rcpf(1.f + __builtin_amdgcn_exp2f(g.x * cexp))); o.y = a.y * (rs * __builtin_amdgcn_rcpf(1.f + __builtin_amdgcn_exp2f(g.y * cexp)));
                        o.z = a.z * (rs * __builtin_amdgcn_rcpf(1.f + __builtin_amdgcn_exp2f(g.z * cexp))); o.w = a.w * (rs * __builtin_amdgcn_rcpf(1.f + __builtin_amdgcn_exp2f(g.w * cexp))); *(f32x4*)(dst + 4 * n) = o; } }
        } else if (pn < 5) {
            f32x4 gv[2][2];
#pragma unroll
            for (int bj = 0; bj < 2; ++bj)
#pragma unroll
                for (int n = 0; n < 2; ++n) gv[bj][n] = (pn == 4) ? (f32x4){1.f, 1.f, 1.f, 1.f} : *(const f32x4*)((pn == 2 ? gq : gk) + 32 * bj + 8 * fq + 4 * n);
#pragma unroll
            for (int ai = 0; ai < 2; ++ai)
#pragma unroll
                for (int m = 0; m < 4; ++m) { const int rb = rowb + ai * 128 + m * 16, row = rb + fr; const float rs = rtab[ui * 256 + (row - u.pm * 256)];
                    f32x4 v[2][2]; float ss = 0.f;
#pragma unroll
                    for (int bj = 0; bj < 2; ++bj)
#pragma unroll
                        for (int n = 0; n < 2; ++n) { v[bj][n] = rs * acc[ai][bj][m][n]; ss += (v[bj][n].x * v[bj][n].x + v[bj][n].y * v[bj][n].y) + (v[bj][n].z * v[bj][n].z + v[bj][n].w * v[bj][n].w); }
                    ss += __shfl_xor(ss, 16); ss += __shfl_xor(ss, 32);
                    float sc = 1.f;
                    if (pn != 4) sc = rsqrtf(ss * (1.f / 64.f) + 1e-6f);
                    const float sq = (pn == 2) ? sc * (0.125f * 1.4426950408889634f) : sc;
                    bf16_t* bdst = QB + (size_t)(pn - 2) * ((size_t)MP * 256) + (size_t)row * 256 + wc * 64 + 8 * fq;
                    float* fdst = nullptr;
                    if (pn != 2 && rb < MT) fdst = (row < MPR) ? okp + (size_t)(pn - 3) * (O_VP - O_KP) + (size_t)row * 256 + wc * 64 + 8 * fq : oks + (size_t)(pn - 3) * (O_VS - O_KS) + (size_t)(row - MPR) * 256 + wc * 64 + 8 * fq;
#pragma unroll
                    for (int bj = 0; bj < 2; ++bj) { const f32x4 a = v[bj][0] * gv[bj][0] * sq, b = v[bj][1] * gv[bj][1] * sq;
                        u32x4 w; w.x = pk2(a.x, a.y); w.y = pk2(a.z, a.w); w.z = pk2(b.x, b.y); w.w = pk2(b.z, b.w);
                        *(u32x4*)(bdst + 32 * bj) = w;
                        if (fdst) { *(f32x4*)(fdst + 32 * bj) = a; *(f32x4*)(fdst + 32 * bj + 4) = b; } } }
        } else {
            const bool isz = pn < 7; bf16_t* base = isz ? ZS : XR; const int ld = isz ? 512 : 1024; const int c0 = (isz ? (pn - 5) : (pn - 7)) * 256 + wc * 32 + 8 * fq;
#pragma unroll
            for (int ai = 0; ai < 2; ++ai)
#pragma unroll
                for (int m = 0; m < 4; ++m) { const int row = rowb + ai * 128 + m * 16 + fr; const float rs = rtab[ui * 256 + (row - u.pm * 256)];
                    const float cexp = -1.4426950408889634f * rs;
#pragma unroll
                    for (int bj = 0; bj < 2; ++bj) { f32x4 a = acc[ai][bj][m][0], b = acc[ai][bj][m][1];
                        if (isz) { a.x *= rs * __builtin_amdgcn_rcpf(1.f + __builtin_amdgcn_exp2f(a.x * cexp)); a.y *= rs * __builtin_amdgcn_rcpf(1.f + __builtin_amdgcn_exp2f(a.y * cexp)); a.z *= rs * __builtin_amdgcn_rcpf(1.f + __builtin_amdgcn_exp2f(a.z * cexp)); a.w *= rs * __builtin_amdgcn_rcpf(1.f + __builtin_amdgcn_exp2f(a.w * cexp));
                                   b.x *= rs * __builtin_amdgcn_rcpf(1.f + __builtin_amdgcn_exp2f(b.x * cexp)); b.y *= rs * __builtin_amdgcn_rcpf(1.f + __builtin_amdgcn_exp2f(b.y * cexp)); b.z *= rs * __builtin_amdgcn_rcpf(1.f + __builtin_amdgcn_exp2f(b.z * cexp)); b.w *= rs * __builtin_amdgcn_rcpf(1.f + __builtin_amdgcn_exp2f(b.w * cexp)); }
                        else { a = a * rs; b = b * rs; }
                        u32x4 w; w.x = pk2(a.x, a.y); w.y = pk2(a.z, a.w); w.z = pk2(b.x, b.y); w.w = pk2(b.z, b.w);
                        *(u32x4*)(base + (size_t)row * ld + c0 + 128 * bj) = w; } }
        }
    }
};
__device__ __forceinline__ void tr_item(const float* __restrict__ W, int ldw, int col0, int k0, const float* __restrict__ gain, bf16_t* __restrict__ dst, int K, int row0, LAS float* scr, int lane) {
    const int kr = lane >> 3, c4 = lane & 7;
    f32x4 v[8]; float gg[8];
#pragma unroll
    for (int i = 0; i < 8; ++i) { v[i] = __builtin_nontemporal_load((const f32x4*)(W + (size_t)(k0 + 8 * i + kr) * ldw + col0 + 4 * c4)); gg[i] = gain ? gain[k0 + 8 * i + kr] : 1.f; }
    asm volatile("" : "+v"(v[0]), "+v"(v[1]), "+v"(v[2]), "+v"(v[3]), "+v"(v[4]), "+v"(v[5]), "+v"(v[6]), "+v"(v[7]), "+v"(gg[0]), "+v"(gg[1]), "+v"(gg[2]), "+v"(gg[3]), "+v"(gg[4]), "+v"(gg[5]), "+v"(gg[6]), "+v"(gg[7]));
#pragma unroll
    for (int i = 0; i < 8; ++i) { const int kk = 8 * i + kr; LAS float* s = scr + kk * 33 + 4 * c4;
        s[0] = v[i].x * gg[i]; s[1] = v[i].y * gg[i]; s[2] = v[i].z * gg[i]; s[3] = v[i].w * gg[i]; }
    asm volatile("s_waitcnt lgkmcnt(0)" ::: "memory");
    const int c = lane & 7;
#pragma unroll
    for (int j = 0; j < 4; ++j) { const int n = (lane >> 3) + 8 * j; const LAS float* s = scr + (8 * c) * 33 + n;
        u32x4 o; o.x = pk2(s[0 * 33], s[1 * 33]); o.y = pk2(s[2 * 33], s[3 * 33]); o.z = pk2(s[4 * 33], s[5 * 33]); o.w = pk2(s[6 * 33], s[7 * 33]);
        *(u32x4*)(dst + (size_t)(row0 + n) * K + k0 + 8 * c) = o; }
    asm volatile("s_waitcnt lgkmcnt(0)" ::: "memory");
}
constexpr int IT_GU = 16 * 176, IT_WD = 44 * 32, IT_WIN = 16 * 88, IT_WOUT = 16 * 32;
constexpr int IT_TOTAL = 4 * IT_GU + 4 * IT_WD + 2 * IT_WIN + 2 * IT_WOUT;
__device__ __forceinline__ void p0_weights(const Args& a, LAS unsigned char* lds, int gw, int ngw, int wave, int lane_in) { int lane = lane_in;
    LAS float* scr = (LAS float*)(lds + wave * 16384);
    unsigned char* ws = a.ws;
    for (int it = gw; it < 4 * IT_GU; it += ngw) { const int mat = it / IT_GU, r = it % IT_GU; const int l = mat >> 1, f = mat & 1, kb = r / 176, gidx = r % 176, pn = gidx >> 3, gi = gidx & 7, bj = gi >> 2, wc = gi & 3;
        const float* W = (f ? (bj ? a.in[30] : a.in[29]) : (bj ? a.in[11] : a.in[10])) + (size_t)l * D * FF;
        tr_item(W, FF, 128 * pn + 32 * wc, 64 * kb, (f ? a.in[28] : a.in[9]) + l * D, (bf16_t*)(ws + WS_WGU + mat * SZ_WGU), D, 32 * gidx, scr, lane); }
    asm volatile("" : "+v"(lane));
    for (int it = gw; it < 4 * IT_WD; it += ngw) { const int mat = it / IT_WD, r = it % IT_WD; const int l = mat >> 1, f = mat & 1, kb = r / 32, gidx = r % 32;
        tr_item((f ? a.in[31] : a.in[12]) + (size_t)l * FF * D, D, 32 * gidx, 64 * kb, nullptr, (bf16_t*)(ws + WS_WD + mat * SZ_WD), FF, 32 * gidx, scr, lane); }
    asm volatile("" : "+v"(lane));
    for (int it = gw; it < 2 * IT_WIN; it += ngw) { const int l = it / IT_WIN, r = it % IT_WIN; const int kb = r / 88, gidx = r % 88, pn = gidx >> 3, gi = gidx & 7, bj = gi >> 2, wc = gi & 3;
        int col0;
        if (pn < 2) col0 = (bj ? 256 : 0) + 128 * pn + 32 * wc; else if (pn < 5) col0 = 512 + 256 * (pn - 2) + 64 * wc + 32 * bj; else col0 = 1280 + 256 * (pn - 5) + 32 * gi;
        tr_item(a.in[14] + (size_t)l * D * NIN, NIN, col0, 64 * kb, a.in[13] + l * D, (bf16_t*)(ws + WS_WIN + l * SZ_WIN), D, 32 * gidx, scr, lane); }
    asm volatile("" : "+v"(lane));
    for (int it = gw; it < 2 * IT_WOUT; it += ngw) { const int l = it / IT_WOUT, r = it % IT_WOUT; const int kb = r / 32, gidx = r % 32;
        tr_item(a.in[15] + (size_t)l * D * D, D, 32 * gidx, 64 * kb, nullptr, (bf16_t*)(ws + WS_WOUT + l * SZ_WOUT), D, 32 * gidx, scr, lane); }
}
__device__ __forceinline__ void p0_rows(const Args& a, int gw, int ngw, int lane) {
    unsigned char* ws = a.ws; bf16_t* XB = (bf16_t*)(ws + WS_XB); float* SSQ = (float*)(ws + WS_SSQ);
    for (int m0 = gw; m0 < MP; m0 += 4 * ngw) {
        f32x4 xv[4][4];
#pragma unroll
        for (int r = 0; r < 4; ++r) { const int m = m0 + r * ngw; if (m < MT) { const float* x = (m < MPR) ? a.in[0] + (size_t)m * D : a.in[1] + (size_t)(m - MPR) * D;
#pragma unroll
            for (int j = 0; j < 4; ++j) xv[r][j] = __builtin_nontemporal_load((const f32x4*)(x + 4 * lane + 256 * j)); } }
#pragma unroll
        for (int r = 0; r < 4; ++r) { const int m = m0 + r * ngw; if (m >= MP) continue;
            if (m < MT) { float s = 0.f;
#pragma unroll
                for (int j = 0; j < 4; ++j) { const f32x4 v = xv[r][j]; s += (v.x * v.x + v.y * v.y) + (v.z * v.z + v.w * v.w);
                    u32x2 w; w.x = pk2(v.x, v.y); w.y = pk2(v.z, v.w); *(u32x2*)(XB + (size_t)m * D + 4 * lane + 256 * j) = w; }
                s = wsum(s); if (lane < 16) SSQ[(size_t)m * 16 + lane] = (lane == 0) ? s : 0.f;
            } else {
#pragma unroll
                for (int j = 0; j < 4; ++j) *(u32x2*)(XB + (size_t)m * D + 4 * lane + 256 * j) = (u32x2){0u, 0u};
                if (lane < 16) SSQ[(size_t)m * 16 + lane] = 0.f; } }
    }
    float* WDT = (float*)(ws + WS_WDT);
    for (int i = gw * 64 + lane; i < 2 * 1024 * 8; i += ngw * 64) { const int l = i >> 13, k = (i >> 3) & 1023, h = i & 7; WDT[i] = a.in[13][l * D + k] * a.in[14][((size_t)l * D + k) * NIN + 2816 + h]; }
    bf16_t* WDTB = (bf16_t*)(ws + WS_WDTB);
    for (int i = gw * 64 + lane; i < 2 * 16 * 1024; i += ngw * 64) { const int l = i >> 14, n = (i >> 10) & 15, k = i & 1023; const float v = (n < 8) ? a.in[13][l * D + k] * a.in[14][((size_t)l * D + k) * NIN + 2816 + n] : 0.f; WDTB[i] = (bf16_t)(pk2(v, 0.f) & 0xffffu); }
    float* BT = (float*)(ws + WS_BT);
    for (int i = gw * 64 + lane; i < 4 * 129; i += ngw * 64) { const int h = i / 129, d = i % 129; int bucket;
        if (d < 16) bucket = d; else { const double v = log((double)d / 16.0) / log(8.0) * 16.0; const int lg = 16 + (int)v; bucket = lg < 31 ? lg : 31; }
        BT[i] = a.in[8][bucket * 4 + h] * 1.4426950408889634f; }
}
__device__ __forceinline__ void colmean_unit(const float* __restrict__ r0, const float* __restrict__ r1, float* __restrict__ out, LAS float* scr, int tid) {
    const int c4 = tid & 63, rg = tid >> 6; f32x4 s = {0.f, 0.f, 0.f, 0.f};
#pragma unroll
    for (int hlf = 0; hlf < 2; ++hlf) { const float* p = (hlf ? r1 : r0) + (size_t)rg * 256 + 4 * c4;
        f32x4 v[16];
#pragma unroll
        for (int r = 0; r < 16; ++r) v[r] = __builtin_nontemporal_load((const f32x4*)(p + (size_t)r * 8 * 256));
#pragma unroll
        for (int r = 0; r < 16; ++r) s += v[r]; }
    *(LAS f32x4*)(scr + rg * 256 + 4 * c4) = s;
    __syncthreads();
    if (tid < 256) { float t = 0.f;
#pragma unroll
        for (int g = 0; g < 8; ++g) t += scr[g * 256 + tid];
        out[tid] = t * (1.f / 256.f); }
    __syncthreads();
}

__device__ __forceinline__ void convA_unit(const Args& a, int l, int unit, LAS unsigned char* lds, int tid) {
    unsigned char* ws = a.ws; const float* U = (const float*)(ws + WS_U); bf16_t* MIX = (bf16_t*)(ws + WS_MIX);
    const int b = unit >> 7, t0 = (unit & 127) * 64, c = tid & 255, half = tid >> 8, tb = t0 + 32 * half;
    const float* wv = a.in[16] + l * 31 * 256 + c; const float bias = a.in[17][l * 256 + c];
    LAS float* T = (LAS float*)lds;
    float win[62], wj[31];
#pragma unroll
    for (int k = 0; k < 62; ++k) { const int t = tb - 30 + k; win[k] = (t >= 0) ? U[(size_t)(b * SEQ + t) * 256 + c] : 0.f; }
#pragma unroll
    for (int j = 0; j < 31; ++j) wj[j] = wv[j * 256];
    asm volatile("" : "+v"(wj[0]), "+v"(wj[1]), "+v"(wj[2]), "+v"(wj[3]), "+v"(wj[4]), "+v"(wj[5]), "+v"(wj[6]), "+v"(wj[7]), "+v"(wj[8]), "+v"(wj[9]), "+v"(wj[10]), "+v"(wj[11]), "+v"(wj[12]), "+v"(wj[13]), "+v"(wj[14]), "+v"(wj[15]),
                 "+v"(wj[16]), "+v"(wj[17]), "+v"(wj[18]), "+v"(wj[19]), "+v"(wj[20]), "+v"(wj[21]), "+v"(wj[22]), "+v"(wj[23]), "+v"(wj[24]), "+v"(wj[25]), "+v"(wj[26]), "+v"(wj[27]), "+v"(wj[28]), "+v"(wj[29]));
    asm volatile("" : "+v"(wj[30]), "+v"(win[0]), "+v"(win[8]), "+v"(win[16]), "+v"(win[24]), "+v"(win[32]), "+v"(win[40]), "+v"(win[48]), "+v"(win[56]), "+v"(win[61]));
    float o[32];
#pragma unroll
    for (int i = 0; i < 32; ++i) o[i] = bias;
#pragma unroll
    for (int j = 0; j < 31; ++j) { const float w = wj[j];
#pragma unroll
        for (int i = 0; i < 32; ++i) o[i] = fmaf(w, win[i + j], o[i]); }
#pragma unroll
    for (int i = 0; i < 32; ++i) T[(32 * half + i) * 260 + c] = o[i];
    __syncthreads();
    const int wave = tid >> 6, lane = tid & 63;
    const f32x4 g = *(const f32x4*)(a.in[18] + l * 256 + 4 * lane), bb = *(const f32x4*)(a.in[19] + l * 256 + 4 * lane);
#pragma unroll
    for (int r = 0; r < 8; ++r) { const int row = 8 * wave + r; f32x4 v = *(const LAS f32x4*)(T + row * 260 + 4 * lane);
        const float mean = wsum((v.x + v.y) + (v.z + v.w)) * (1.f / 256.f); v = v - mean;
        const float rs = rsqrtf(wsum((v.x * v.x + v.y * v.y) + (v.z * v.z + v.w * v.w)) * (1.f / 256.f) + 1e-5f);
        v = v * rs * g + bb; u32x2 w; w.x = pk2(fsilu(v.x), fsilu(v.y)); w.y = pk2(fsilu(v.z), fsilu(v.w));
        *(u32x2*)(MIX + (size_t)(b * SEQ + t0 + row) * D + 4 * lane) = w; }
    if (t0 == SEQ - 64) { float* cp = a.out + O_CP + (size_t)(l * 2 + b) * 30 * 256;
        float cv[15];
#pragma unroll
        for (int i = 0; i < 15; ++i) cv[i] = U[(size_t)(b * SEQ + SEQ - 30) * 256 + tid + NTHR * i];
        asm volatile("" : "+v"(cv[0]), "+v"(cv[1]), "+v"(cv[2]), "+v"(cv[3]), "+v"(cv[4]), "+v"(cv[5]), "+v"(cv[6]), "+v"(cv[7]), "+v"(cv[8]), "+v"(cv[9]), "+v"(cv[10]), "+v"(cv[11]), "+v"(cv[12]), "+v"(cv[13]), "+v"(cv[14]));
#pragma unroll
        for (int i = 0; i < 15; ++i) cp[tid + NTHR * i] = cv[i]; }
    __syncthreads();
}
__device__ __forceinline__ void convA_sample_unit(const Args& a, int l, int sb, LAS unsigned char* lds, int tid) {
    unsigned char* ws = a.ws; const float* U = (const float*)(ws + WS_U); bf16_t* MIX = (bf16_t*)(ws + WS_MIX);
    const int c = tid & 255, half = tid >> 8; const float* wv = a.in[16] + l * 31 * 256 + c;
    const float* st = a.in[4] + ((size_t)l * 32 + sb) * 30 * 256 + c; float* cs = a.out + O_CS + ((size_t)l * 32 + sb) * 30 * 256 + c;
    LAS float* P = (LAS float*)lds;
    const float un = U[(size_t)(MPR + sb) * 256 + c];
    float sv[16], wj[16];
#pragma unroll
    for (int j = 0; j < 16; ++j) { const int jj = 16 * half + j; sv[j] = (jj < 30) ? st[(size_t)jj * 256] : un; wj[j] = (jj < 31) ? wv[jj * 256] : 0.f; }
    float acc = half ? 0.f : a.in[17][l * 256 + c];
    asm volatile("" : "+v"(sv[0]), "+v"(sv[1]), "+v"(sv[2]), "+v"(sv[3]), "+v"(sv[4]), "+v"(sv[5]), "+v"(sv[6]), "+v"(sv[7]), "+v"(sv[8]), "+v"(sv[9]), "+v"(sv[10]), "+v"(sv[11]), "+v"(sv[12]), "+v"(sv[13]), "+v"(sv[14]), "+v"(sv[15]), "+v"(acc));
    asm volatile("" : "+v"(wj[0]), "+v"(wj[1]), "+v"(wj[2]), "+v"(wj[3]), "+v"(wj[4]), "+v"(wj[5]), "+v"(wj[6]), "+v"(wj[7]), "+v"(wj[8]), "+v"(wj[9]), "+v"(wj[10]), "+v"(wj[11]), "+v"(wj[12]), "+v"(wj[13]), "+v"(wj[14]), "+v"(wj[15]));
#pragma unroll
    for (int j = 0; j < 16; ++j) { const int jj = 16 * half + j; if (jj < 31) { acc = fmaf(wj[j], sv[j], acc); if (jj >= 1) cs[(size_t)(jj - 1) * 256] = sv[j]; } }
    P[half * 256 + c] = acc;
    __syncthreads();
    if (tid < 64) { const int lane = tid; f32x4 v = *(const LAS f32x4*)(P + 4 * lane) + *(const LAS f32x4*)(P + 256 + 4 * lane);
        const f32x4 g = *(const f32x4*)(a.in[18] + l * 256 + 4 * lane), bb = *(const f32x4*)(a.in[19] + l * 256 + 4 * lane);
        const float mean = wsum((v.x + v.y) + (v.z + v.w)) * (1.f / 256.f); v = v - mean;
        const float rs = rsqrtf(wsum((v.x * v.x + v.y * v.y) + (v.z * v.z + v.w * v.w)) * (1.f / 256.f) + 1e-5f);
        v = v * rs * g + bb; u32x2 w; w.x = pk2(fsilu(v.x), fsilu(v.y)); w.y = pk2(fsilu(v.z), fsilu(v.w));
        *(u32x2*)(MIX + (size_t)(MPR + sb) * D + 4 * lane) = w; }
    __syncthreads();
}
__device__ __forceinline__ void conv4_unit(const Args& a, int l, int unit, int tid) {
    unsigned char* ws = a.ws; const bf16_t* XR = (const bf16_t*)(ws + WS_XR); bf16_t* XC = (bf16_t*)(ws + WS_XC);
    if (unit < 256) {
        const int c8 = 8 * (tid & 127), rg = tid >> 7, b = unit >> 7, t0 = (unit & 127) * 64 + 16 * rg; const size_t r0 = (size_t)b * SEQ + t0;
        const float* w = a.in[22] + l * 4 * 1024 + c8; const float* bp = a.in[23] + l * 1024 + c8;
        u32x4 raw[19];
#pragma unroll
        for (int i = 0; i < 19; ++i) raw[i] = (t0 + i - 3 >= 0) ? *(const u32x4*)(XR + (r0 + i - 3) * 1024 + c8) : (u32x4){0u, 0u, 0u, 0u};
        float wf[4][8], bf[8];
#pragma unroll
        for (int j = 0; j < 4; ++j) { const f32x4 wa = *(const f32x4*)(w + j * 1024), wb = *(const f32x4*)(w + j * 1024 + 4); wf[j][0] = wa.x; wf[j][1] = wa.y; wf[j][2] = wa.z; wf[j][3] = wa.w; wf[j][4] = wb.x; wf[j][5] = wb.y; wf[j][6] = wb.z; wf[j][7] = wb.w; }
        { const f32x4 ba = *(const f32x4*)bp, bb = *(const f32x4*)(bp + 4); bf[0] = ba.x; bf[1] = ba.y; bf[2] = ba.z; bf[3] = ba.w; bf[4] = bb.x; bf[5] = bb.y; bf[6] = bb.z; bf[7] = bb.w; }
        float win[4][8];
#pragma unroll
        for (int i = 0; i < 3; ++i) { win[i][0] = bflo(raw[i].x); win[i][1] = bfhi(raw[i].x); win[i][2] = bflo(raw[i].y); win[i][3] = bfhi(raw[i].y); win[i][4] = bflo(raw[i].z); win[i][5] = bfhi(raw[i].z); win[i][6] = bflo(raw[i].w); win[i][7] = bfhi(raw[i].w); }
#pragma unroll
        for (int i = 0; i < 16; ++i) { const u32x4 rr = raw[i + 3]; const int s3 = (i + 3) & 3;
            win[s3][0] = bflo(rr.x); win[s3][1] = bfhi(rr.x); win[s3][2] = bflo(rr.y); win[s3][3] = bfhi(rr.y); win[s3][4] = bflo(rr.z); win[s3][5] = bfhi(rr.z); win[s3][6] = bflo(rr.w); win[s3][7] = bfhi(rr.w);
            float o[8];
#pragma unroll
            for (int e = 0; e < 8; ++e) { float v = bf[e];
#pragma unroll
                for (int j = 0; j < 4; ++j) v = fmaf(wf[j][e], win[(i + j) & 3][e], v);
                o[e] = fsilu(v); }
            u32x4 ow; ow.x = pk2(o[0], o[1]); ow.y = pk2(o[2], o[3]); ow.z = pk2(o[4], o[5]); ow.w = pk2(o[6], o[7]);
            *(u32x4*)(XC + (r0 + i) * 1024 + c8) = ow; }
        if (t0 == SEQ - 16) { float* sp = a.out + O_SCP + (size_t)(l * 2 + b) * 3 * 1024 + c8;
#pragma unroll
            for (int i = 0; i < 3; ++i) { const u32x4 rr = raw[16 + i]; *(f32x4*)(sp + i * 1024) = (f32x4){bflo(rr.x), bfhi(rr.x), bflo(rr.y), bfhi(rr.y)}; *(f32x4*)(sp + i * 1024 + 4) = (f32x4){bflo(rr.z), bfhi(rr.z), bflo(rr.w), bfhi(rr.w)}; } }
    } else {
        const int c = 2 * tid; const float* w = a.in[22] + l * 4 * 1024 + c; const f32x2 bias = *(const f32x2*)(a.in[23] + l * 1024 + c);
        const f32x2 w0 = *(const f32x2*)(w), w1 = *(const f32x2*)(w + 1024), w2 = *(const f32x2*)(w + 2048), w3 = *(const f32x2*)(w + 3072);
        const float* st = a.in[5] + (size_t)l * 32 * 3 * 1024 + c; float* so = a.out + O_SCS + (size_t)l * 32 * 3 * 1024 + c;
        f32x2 q3[8], q2[8], q1[8]; unsigned ur[8];
#pragma unroll
        for (int k = 0; k < 8; ++k) { const int sb = 8 * (unit - 256) + k;
            q3[k] = *(const f32x2*)(st + (size_t)(sb * 3 + 0) * 1024); q2[k] = *(const f32x2*)(st + (size_t)(sb * 3 + 1) * 1024); q1[k] = *(const f32x2*)(st + (size_t)(sb * 3 + 2) * 1024);
            ur[k] = *(const unsigned*)(XR + (size_t)(MPR + sb) * 1024 + c); }
#pragma unroll
        for (int k = 0; k < 8; ++k) asm volatile("" : "+v"(q3[k]), "+v"(q2[k]), "+v"(q1[k]), "+v"(ur[k]));
#pragma unroll
        for (int k = 0; k < 8; ++k) { const int sb = 8 * (unit - 256) + k; const f32x2 raw = {bflo(ur[k]), bfhi(ur[k])};
            const f32x2 v = bias + w0 * q3[k] + w1 * q2[k] + w2 * q1[k] + w3 * raw;
            *(unsigned*)(XC + (size_t)(MPR + sb) * 1024 + c) = pk2(fsilu(v.x), fsilu(v.y));
            *(f32x2*)(so + (size_t)(sb * 3 + 0) * 1024) = q2[k]; *(f32x2*)(so + (size_t)(sb * 3 + 1) * 1024) = q1[k]; *(f32x2*)(so + (size_t)(sb * 3 + 2) * 1024) = raw; }
    }
}
__device__ __forceinline__ void dt_row(const Args& a, int l, int row, int lane) {
    unsigned char* ws = a.ws; const bf16_t* XBr = (const bf16_t*)(ws + WS_XB) + (size_t)row * D; const float* WDT = (const float*)(ws + WS_WDT) + l * 1024 * 8;
    float acc[8];
#pragma unroll
    for (int h = 0; h < 8; ++h) acc[h] = 0.f;
#pragma unroll
    for (int j = 0; j < 4; ++j) { const int k = 4 * lane + 256 * j; const u32x2 xw = *(const u32x2*)(XBr + k); const f32x4 x = {bflo(xw.x), bfhi(xw.x), bflo(xw.y), bfhi(xw.y)};
#pragma unroll
        for (int e = 0; e < 4; ++e) { const f32x4 wa = *(const f32x4*)(WDT + (k + e) * 8), wb = *(const f32x4*)(WDT + (k + e) * 8 + 4); const float xv = x[e];
            acc[0] = fmaf(xv, wa.x, acc[0]); acc[1] = fmaf(xv, wa.y, acc[1]); acc[2] = fmaf(xv, wa.z, acc[2]); acc[3] = fmaf(xv, wa.w, acc[3]);
            acc[4] = fmaf(xv, wb.x, acc[4]); acc[5] = fmaf(xv, wb.y, acc[5]); acc[6] = fmaf(xv, wb.z, acc[6]); acc[7] = fmaf(xv, wb.w, acc[7]); } }
    const float rs = rstd16((const float*)(ws + WS_SSQ) + (size_t)row * 16);
    float mine = 0.f;
#pragma unroll
    for (int h = 0; h < 8; ++h) { const float s = wsum(acc[h]); if (lane == h) mine = s; }
    if (lane < 8) { const float x = rs * mine + a.in[24][l * 8 + lane]; ((float*)(ws + WS_DT))[(size_t)row * 8 + lane] = fmaxf(x, 0.f) + log1pf(expf(-fabsf(x))); }
}
__device__ __forceinline__ void final_rows4(const Args& a, int l, int row0, int rstride, int lane) {
    unsigned char* ws = a.ws; const float* g = a.in[32] + l * D;
    u32x2 w[4][4];
#pragma unroll
    for (int r = 0; r < 4; ++r) { const int row = row0 + r * rstride; if (row < MT) {
#pragma unroll
        for (int j = 0; j < 4; ++j) w[r][j] = *(const u32x2*)((const bf16_t*)(ws + WS_XB) + (size_t)row * D + 4 * lane + 256 * j); } }
    f32x4 gg[4];
#pragma unroll
    for (int j = 0; j < 4; ++j) gg[j] = *(const f32x4*)(g + 4 * lane + 256 * j);
#pragma unroll
    for (int r = 0; r < 4; ++r) { const int row = row0 + r * rstride; if (row < MT) { f32x4 v[4]; float s = 0.f;
#pragma unroll
        for (int j = 0; j < 4; ++j) { v[j] = (f32x4){bflo(w[r][j].x), bfhi(w[r][j].x), bflo(w[r][j].y), bfhi(w[r][j].y)}; s += (v[j].x * v[j].x + v[j].y * v[j].y) + (v[j].z * v[j].z + v[j].w * v[j].w); }
        const float rs = rsqrtf(wsum(s) * (1.f / 1024.f) + 1e-6f);
        float* o = row < MPR ? a.out + O_YP + (size_t)row * D : a.out + O_YS + (size_t)(row - MPR) * D;
#pragma unroll
        for (int j = 0; j < 4; ++j) *(f32x4*)(o + 4 * lane + 256 * j) = v[j] * rs * gg[j]; } }
}
__device__ __forceinline__ void attn_simple(const Args& a, int l, int item, LAS float* L, int ht, bf16_t* outp = nullptr) {
    unsigned char* ws = a.ws;
    const bf16_t* QB = (const bf16_t*)(ws + WS_QB); const bf16_t* KB = (const bf16_t*)(ws + WS_KB); const bf16_t* VB = (const bf16_t*)(ws + WS_VB);
    const float* KMP = (const float*)(ws + WS_KMP); const float* KMS = (const float*)(ws + WS_KMS) + (size_t)l * 1024 * 256; const float* BT = (const float*)(ws + WS_BT);
    const float* cachek = a.in[2] + (size_t)l * CACHE_L; const float* cachev = a.in[3] + (size_t)l * CACHE_L; const int* pt = (const int*)a.in[7];
    bf16_t* MIX = outp ? outp : (bf16_t*)(ws + WS_MIX);
    LAS float* qs = L; LAS float* gate = L + 64; LAS int* sel = (LAS int*)(L + 96); LAS float* lg = L + 128; LAS float* red = L + 1152; LAS float* osum = L + 1408;
    const int m = item >> 2, h = item & 3; const bool smp = m >= MPR; const int b = m >> 13, t = m & 8191, sb = m - MPR;
    const int qpos = smp ? 8192 : t, cur = qpos >> 8;
    if (ht < 64) qs[ht] = bf1(QB[(size_t)m * 256 + h * 64 + ht]);
    __syncthreads();
    if (ht < cur) { const float* km = (smp ? KMS + (size_t)(sb * 32 + ht) * 256 : KMP + (size_t)(b * 32 + ht) * 256) + h * 64; float g = 0.f; for (int d = 0; d < 64; ++d) g = fmaf(qs[d], km[d], g); gate[ht] = g; }
    __syncthreads();
    if (ht == 0) { const int cnt = cur < 3 ? cur : 3; int s0 = -1, s1 = -1, s2 = -1;
        for (int j = 0; j < cnt; ++j) { int best = -1; float bv = 0.f;
            for (int n = 0; n < cur; ++n) { if (n == s0 || n == s1) continue; if (best < 0 || gate[n] > bv) { best = n; bv = gate[n]; } }
            if (j == 0) s0 = best; else if (j == 1) s1 = best; else s2 = best; }
        sel[0] = s0; sel[1] = s1; sel[2] = s2; sel[cnt] = cur; sel[4] = cnt; }
    __syncthreads();
    const int cnt = sel[4]; float mx = -INFINITY;
    for (int j = 0; j <= cnt; ++j) { const int blk = sel[j], kpos = blk * 256 + ht; float lgt = -INFINITY;
        if (kpos <= qpos) { float acc = 0.f;
            if (smp && blk < 32) { const float* kp = cachek + ((size_t)pt[sb * NPAGES + (kpos >> 7)] * 128 + (kpos & 127)) * 256 + h * 64;
                for (int d = 0; d < 64; ++d) acc = fmaf(qs[d], kp[d], acc);
            } else { const bf16_t* kp = KB + (size_t)(smp ? m : b * SEQ + kpos) * 256 + h * 64;
                for (int d8 = 0; d8 < 8; ++d8) { const u32x4 w = *(const u32x4*)(kp + 8 * d8);
                    acc = fmaf(qs[8 * d8 + 0], bflo(w.x), acc); acc = fmaf(qs[8 * d8 + 1], bfhi(w.x), acc); acc = fmaf(qs[8 * d8 + 2], bflo(w.y), acc); acc = fmaf(qs[8 * d8 + 3], bfhi(w.y), acc);
                    acc = fmaf(qs[8 * d8 + 4], bflo(w.z), acc); acc = fmaf(qs[8 * d8 + 5], bfhi(w.z), acc); acc = fmaf(qs[8 * d8 + 6], bflo(w.w), acc); acc = fmaf(qs[8 * d8 + 7], bfhi(w.w), acc); } }
            const int dist = qpos - kpos; lgt = acc + BT[h * 129 + (dist < 128 ? dist : 128)]; }
        lg[j * 256 + ht] = lgt; mx = fmaxf(mx, lgt); }
    red[ht] = mx; __syncthreads();
    for (int o = 128; o > 0; o >>= 1) { if (ht < o) red[ht] = fmaxf(red[ht], red[ht + o]); __syncthreads(); }
    mx = red[0]; __syncthreads();
    float ps = 0.f;
    for (int j = 0; j <= cnt; ++j) { const float p = expf(lg[j * 256 + ht] - mx); lg[j * 256 + ht] = p; ps += p; }
    red[ht] = ps; __syncthreads();
    for (int o = 128; o > 0; o >>= 1) { if (ht < o) red[ht] += red[ht + o]; __syncthreads(); }
    const float tot = red[0];
    { const int j = ht >> 6, d = ht & 63; float acc = 0.f;
      if (j <= cnt) { const int blk = sel[j];
        for (int s = 0; s < 256; ++s) { const float p = lg[j * 256 + s]; if (p == 0.f) continue; const int kpos = blk * 256 + s; float v;
            if (smp && blk < 32) v = cachev[((size_t)pt[sb * NPAGES + (kpos >> 7)] * 128 + (kpos & 127)) * 256 + h * 64 + d];
            else v = bf1(VB[(size_t)(smp ? m : b * SEQ + kpos) * 256 + h * 64 + d]);
            acc = fmaf(p, v, acc); } }
      osum[j * 64 + d] = acc; }
    __syncthreads();
    if (ht < 64) { const float o = (osum[ht] + osum[64 + ht] + osum[128 + ht] + osum[192 + ht]) / tot; MIX[(size_t)m * D + 256 + h * 64 + ht] = (bf16_t)(pk2(o, 0.f) & 0xffffu); }
    __syncthreads();
}
__device__ __forceinline__ void ssd_seq_item(const Args& a, int l, int wv, int lane) {
    unsigned char* ws = a.ws; const bf16_t* XC = (const bf16_t*)(ws + WS_XC); const float* DT = (const float*)(ws + WS_DT); float* Y = (float*)(ws + WS_Y);
    const int seq = wv >> 9, h = (wv >> 6) & 7, p = wv & 63, g = h >> 2;
    const float A = -expf(a.in[25][l * 8 + h]);
    const bool smp = seq >= 2; const int T = smp ? 1 : SEQ; const size_t row0 = smp ? (size_t)MPR + (seq - 2) : (size_t)seq * SEQ;
    float h0 = 0.f, h1 = 0.f;
    if (smp) { const float* s = a.in[6] + (size_t)l * 32 * 8 * 64 * 128 + ((size_t)((seq - 2) * 8 + h) * 64 + p) * 128; h0 = s[lane]; h1 = s[lane + 64]; }
    const bf16_t* xc = XC + row0 * 1024; const float* dt = DT + row0 * 8;
    float dtv = dt[h], xv = bf1(xc[h * 64 + p]), b0 = bf1(xc[512 + g * 128 + lane]), b1 = bf1(xc[512 + g * 128 + 64 + lane]), c0 = bf1(xc[768 + g * 128 + lane]), c1 = bf1(xc[768 + g * 128 + 64 + lane]);
    for (int t = 0; t < T; ++t) {
        float ndt = 0.f, nx = 0.f, nb0 = 0.f, nb1 = 0.f, nc0 = 0.f, nc1 = 0.f;
        if (t + 1 < T) { const bf16_t* x2 = xc + (size_t)(t + 1) * 1024; ndt = dt[(size_t)(t + 1) * 8 + h]; nx = bf1(x2[h * 64 + p]); nb0 = bf1(x2[512 + g * 128 + lane]); nb1 = bf1(x2[512 + g * 128 + 64 + lane]); nc0 = bf1(x2[768 + g * 128 + lane]); nc1 = bf1(x2[768 + g * 128 + 64 + lane]); }
        const float dA = expf(dtv * A), xd = dtv * xv;
        h0 = fmaf(h0, dA, xd * b0); h1 = fmaf(h1, dA, xd * b1);
        const float y = wsum(c0 * h0 + c1 * h1);
        if (lane == 0) Y[(row0 + t) * 512 + h * 64 + p] = y;
        dtv = ndt; xv = nx; b0 = nb0; b1 = nb1; c0 = nc0; c1 = nc1;
    }
    float* o = smp ? a.out + O_HS + (size_t)l * 32 * 8 * 64 * 128 + ((size_t)((seq - 2) * 8 + h) * 64 + p) * 128 : a.out + O_HP + (size_t)l * 2 * 8 * 64 * 128 + ((size_t)(seq * 8 + h) * 64 + p) * 128;
    o[lane] = h0; o[lane + 64] = h1;
}
__device__ __forceinline__ void ssm_out_row(const Args& a, int l, int row, int lane) {
    unsigned char* ws = a.ws; const u32x4 yw = *(const u32x4*)((const bf16_t*)(ws + WS_Y) + (size_t)row * 512 + 8 * lane);
    const u32x4 xw = *(const u32x4*)((const bf16_t*)(ws + WS_XC) + (size_t)row * 1024 + 8 * lane), zw = *(const u32x4*)((const bf16_t*)(ws + WS_ZS) + (size_t)row * 512 + 8 * lane);
    const f32x4 y0 = {bflo(yw.x), bfhi(yw.x), bflo(yw.y), bfhi(yw.y)}, y1 = {bflo(yw.z), bfhi(yw.z), bflo(yw.w), bfhi(yw.w)}; const float Dh = a.in[26][l * 8 + (lane >> 3)];
    float v[8];
    v[0] = (y0.x + Dh * bflo(xw.x)) * bflo(zw.x); v[1] = (y0.y + Dh * bfhi(xw.x)) * bfhi(zw.x); v[2] = (y0.z + Dh * bflo(xw.y)) * bflo(zw.y); v[3] = (y0.w + Dh * bfhi(xw.y)) * bfhi(zw.y);
    v[4] = (y1.x + Dh * bflo(xw.z)) * bflo(zw.z); v[5] = (y1.y + Dh * bfhi(xw.z)) * bfhi(zw.z); v[6] = (y1.z + Dh * bflo(xw.w)) * bflo(zw.w); v[7] = (y1.w + Dh * bfhi(xw.w)) * bfhi(zw.w);
    float s = 0.f;
#pragma unroll
    for (int k = 0; k < 8; ++k) s += v[k] * v[k];
    const float rs = rsqrtf(wsum(s) * (1.f / 512.f) + 1e-6f);
    const f32x4 g0 = *(const f32x4*)(a.in[27] + l * 512 + 8 * lane), g1 = *(const f32x4*)(a.in[27] + l * 512 + 8 * lane + 4);
    u32x4 w; w.x = pk2(v[0] * rs * g0.x, v[1] * rs * g0.y); w.y = pk2(v[2] * rs * g0.z, v[3] * rs * g0.w); w.z = pk2(v[4] * rs * g1.x, v[5] * rs * g1.y); w.w = pk2(v[6] * rs * g1.z, v[7] * rs * g1.w);
    *(u32x4*)((bf16_t*)(ws + WS_MIX) + (size_t)row * D + 512 + 8 * lane) = w;
}
#define MFMA16(a, b, c) __builtin_amdgcn_mfma_f32_16x16x32_bf16((a), (b), (c), 0, 0, 0)
__device__ __forceinline__ bf16x8 mk8(u32x4 v) { return __builtin_bit_cast(bf16x8, v); }
__device__ __forceinline__ bf16x8 mk8(u32x2 lo, u32x2 hi) { u32x4 v; v.x = lo.x; v.y = lo.y; v.z = hi.x; v.w = hi.y; return __builtin_bit_cast(bf16x8, v); }

__device__ __forceinline__ void dtslab_unit(const Args& a, int l, int unit, LAS unsigned char* lds, int tid) {
    unsigned char* ws = a.ws; const int lane = tid & 63, wave = __builtin_amdgcn_readfirstlane(tid >> 6), fr = lane & 15, gq = lane >> 4, rt = wave >> 1, kh = wave & 1;
    const size_t r0 = (size_t)unit * 64;
    LAS float* part = (LAS float*)lds;
    LAS float* dAs = part + 1024;
    const bf16_t* WB = (const bf16_t*)(ws + WS_WDTB) + (size_t)l * 16 * 1024 + fr * 1024 + 512 * kh + 8 * gq;
    const bf16_t* xr = (const bf16_t*)(ws + WS_XB) + (r0 + 16 * rt + fr) * D + 512 * kh + 8 * gq;
    u32x4 xa[16], wb[16];
#pragma unroll
    for (int ks = 0; ks < 16; ++ks) { xa[ks] = *(const u32x4*)(xr + 32 * ks); wb[ks] = *(const u32x4*)(WB + 32 * ks); }
    float rs_pre = rstd16((const float*)(ws + WS_SSQ) + (r0 + (tid >> 3)) * 16);
    float dtb_pre = a.in[24][l * 8 + (tid & 7)], alog_pre = a.in[25][l * 8 + (tid & 7)];
    asm volatile("" : "+v"(rs_pre), "+v"(dtb_pre), "+v"(alog_pre));
#pragma unroll
    for (int ks = 0; ks < 16; ks += 4) { asm volatile("" : "+v"(xa[ks]), "+v"(xa[ks + 1]), "+v"(xa[ks + 2]), "+v"(xa[ks + 3]), "+v"(wb[ks]), "+v"(wb[ks + 1]), "+v"(wb[ks + 2]), "+v"(wb[ks + 3])); }
    f32x4 acc = {0.f, 0.f, 0.f, 0.f};
#pragma unroll
    for (int ks = 0; ks < 16; ++ks) acc = MFMA16(mk8(xa[ks]), mk8(wb[ks]), acc);
    if (fr < 8) {
#pragma unroll
        for (int r = 0; r < 4; ++r) part[(kh * 64 + 16 * rt + 4 * gq + r) * 8 + fr] = acc[r]; }
    __syncthreads();
    { const int lr = tid >> 3, h = tid & 7; const size_t row = r0 + lr; const float rs = rs_pre;
      const float x = rs * (part[lr * 8 + h] + part[(64 + lr) * 8 + h]) + dtb_pre; const float dtv = fmaxf(x, 0.f) + log1pf(expf(-fabsf(x)));
      ((float*)(ws + WS_DT))[row * 8 + h] = dtv; dAs[lr * 8 + h] = dtv * -expf(alog_pre); }
    __syncthreads();
    if (wave == 0) { float* AC = (float*)(ws + WS_ACUM) + (r0 + lane) * 8; float* TOT = (float*)(ws + WS_TOT) + (size_t)unit * 8;
#pragma unroll
        for (int h = 0; h < 8; ++h) { float inc = dAs[lane * 8 + h];
#pragma unroll
            for (int o = 1; o < 64; o <<= 1) { const float t = __shfl_up(inc, o); if (lane >= o) inc += t; }
            AC[h] = inc; if (lane == 63) TOT[h] = inc; } }
    __syncthreads();
}
constexpr int SA_BM = 0, SA_XT = 69632, SA_XT2 = SA_XT + 33792, SA_AC = SA_XT2 + 33792;
__device__ __forceinline__ void ssdA_unit(const Args& a, int l, int unit, LAS unsigned char* lds, int tid) {
    unsigned char* ws = a.ws; const int lane = tid & 63, wave = __builtin_amdgcn_readfirstlane(tid >> 6), fr = lane & 15, gq = lane >> 4;
    const int h = unit & 7, g = h >> 2; const size_t r0 = (size_t)(unit >> 3) * 256;
    const bf16_t* XC = (const bf16_t*)(ws + WS_XC); const float* DT = (const float*)(ws + WS_DT); const float* ACUM = (const float*)(ws + WS_ACUM);
    LAS bf16_t* Bm = (LAS bf16_t*)(lds + SA_BM); LAS bf16_t* XT = (LAS bf16_t*)(lds + SA_XT); LAS bf16_t* XT2 = (LAS bf16_t*)(lds + SA_XT2); LAS float* acs = (LAS float*)(lds + SA_AC);
    u32x4 cpre[2][4];
#pragma unroll
    for (int which = 0; which < 2; ++which)
#pragma unroll
        for (int kk = 0; kk < 4; ++kk) cpre[which][kk] = *(const u32x4*)(XC + (r0 + 16 * (which ? 15 - wave : wave) + fr) * 1024 + 768 + g * 128 + 32 * kk + 8 * gq);
#ifndef SSDA_RB
#define SSDA_RB 1
#endif
#ifndef SSDA_RX
#define SSDA_RX 1
#endif
    u32x4 bst[8];
#pragma unroll
    for (int pass = 0; pass < 8; ++pass) { const int row = pass * 32 + (tid >> 4), ch = tid & 15; bst[pass] = *(const u32x4*)(XC + (r0 + row) * 1024 + 512 + g * 128 + 8 * ch); }
    const float* TOT = (const float*)(ws + WS_TOT) + (size_t)(unit >> 3) * 4 * 8 + h;
    float t0 = TOT[0], t1 = TOT[8], t2 = TOT[16], t3 = TOT[24];
    u32x4 xvp[4]; float dtp[4], acp[4];
#pragma unroll
    for (int pass = 0; pass < 4; ++pass) { const int s = pass * 64 + lane; xvp[pass] = *(const u32x4*)(XC + (r0 + s) * 1024 + h * 64 + 8 * wave); dtp[pass] = DT[(r0 + s) * 8 + h]; acp[pass] = ACUM[(r0 + s) * 8 + h]; }
    asm volatile("" : "+v"(bst[0]), "+v"(bst[1]), "+v"(bst[2]), "+v"(bst[3]), "+v"(bst[4]), "+v"(bst[5]), "+v"(bst[6]), "+v"(bst[7]), "+v"(t0), "+v"(t1), "+v"(t2), "+v"(t3),
                 "+v"(xvp[0]), "+v"(xvp[1]), "+v"(xvp[2]), "+v"(xvp[3]), "+v"(dtp[0]), "+v"(dtp[1]), "+v"(dtp[2]), "+v"(dtp[3]), "+v"(acp[0]), "+v"(acp[1]), "+v"(acp[2]), "+v"(acp[3]));
#pragma unroll
    for (int pass = 0; pass < 8; ++pass) { const int row = pass * 32 + (tid >> 4), ch = tid & 15; *(LAS u32x4*)(Bm + row * 136 + 8 * ch) = bst[pass]; }
    const float ac_end = ((t0 + t1) + t2) + t3;
    if (tid == 0) ((float*)(ws + WS_CT))[unit] = ac_end;
    for (int rrx_ = 0; rrx_ < SSDA_RX; ++rrx_)
#pragma unroll
    for (int pass = 0; pass < 4; ++pass) { const int s = pass * 64 + lane;
        const u32x4 v = xvp[pass]; const float dtv = dtp[pass], acv = acp[pass] + (pass == 0 ? 0.f : pass == 1 ? t0 : pass == 2 ? (t0 + t1) : ((t0 + t1) + t2)); const float e = expf(ac_end - acv);
        if (wave == 0) acs[s] = acv;
        float x[8]; x[0] = bflo(v.x); x[1] = bfhi(v.x); x[2] = bflo(v.y); x[3] = bfhi(v.y); x[4] = bflo(v.z); x[5] = bfhi(v.z); x[6] = bflo(v.w); x[7] = bfhi(v.w);
#pragma unroll
        for (int i = 0; i < 8; ++i) { const float xd = x[i] * dtv; const unsigned w = pk2(xd, xd * e); XT[(8 * wave + i) * 264 + s] = (bf16_t)(w & 0xffffu); XT2[(8 * wave + i) * 264 + s] = (bf16_t)(w >> 16); } }
    __syncthreads();
#ifndef SSDA_R1
#define SSDA_R1 1
#endif
#ifndef SSDA_R2
#define SSDA_R2 1
#endif
#ifndef SSDA_R0
#define SSDA_R0 1
#endif
    for (int rr1_ = 0; rr1_ < SSDA_R1; ++rr1_) { f32x4 acc[4];
#pragma unroll
      for (int pt = 0; pt < 4; ++pt) acc[pt] = (f32x4){0.f, 0.f, 0.f, 0.f};
#pragma unroll 2
      for (int ks = 0; ks < 8; ++ks) { const LAS bf16_t* bp = Bm + (32 * ks + 8 * gq) * 136 + 16 * wave + fr;
          u32x4 av; av.x = (unsigned)bp[0] | ((unsigned)bp[136] << 16); av.y = (unsigned)bp[2 * 136] | ((unsigned)bp[3 * 136] << 16); av.z = (unsigned)bp[4 * 136] | ((unsigned)bp[5 * 136] << 16); av.w = (unsigned)bp[6 * 136] | ((unsigned)bp[7 * 136] << 16);
          const bf16x8 A = mk8(av);
#pragma unroll
          for (int pt = 0; pt < 4; ++pt) { const bf16x8 Bf = mk8(*(const LAS u32x4*)(XT2 + (16 * pt + fr) * 264 + 32 * ks + 8 * gq)); acc[pt] = MFMA16(A, Bf, acc[pt]); } }
      float* ST = (float*)(ws + WS_ST) + (size_t)unit * 8192;
#pragma unroll
      for (int pt = 0; pt < 4; ++pt) *(f32x4*)(ST + (16 * pt + fr) * 128 + 16 * wave + 4 * gq) = acc[pt]; }
    bf16_t* Y = (bf16_t*)(ws + WS_Y);
    for (int rr2_ = 0; rr2_ < SSDA_R2; ++rr2_)
#pragma unroll
    for (int which = 0; which < 2; ++which) { const int lt = which ? 15 - wave : wave, lrow = 16 * lt + fr; const size_t row = r0 + lrow;
        bf16x8 cf[4];
#pragma unroll
        for (int kk = 0; kk < 4; ++kk) cf[kk] = mk8(cpre[which][kk]);
        const float acl = acs[lrow];
        f32x4 yacc[4];
#pragma unroll
        for (int pt = 0; pt < 4; ++pt) yacc[pt] = (f32x4){0.f, 0.f, 0.f, 0.f};
        const int nblk = (lt >> 1) + 1;
#pragma unroll 1
        for (int sb = 0; sb < nblk; ++sb) { const int s0 = 32 * sb;
            f32x4 T0 = {0.f, 0.f, 0.f, 0.f}, T1 = {0.f, 0.f, 0.f, 0.f};
#pragma unroll
            for (int kk = 0; kk < 4; ++kk) { const bf16x8 A0 = mk8(*(const LAS u32x4*)(Bm + (s0 + fr) * 136 + 32 * kk + 8 * gq)), A1 = mk8(*(const LAS u32x4*)(Bm + (s0 + 16 + fr) * 136 + 32 * kk + 8 * gq));
                T0 = MFMA16(A0, cf[kk], T0); T1 = MFMA16(A1, cf[kk], T1); }
            const f32x4 as0 = *(const LAS f32x4*)(acs + s0 + 4 * gq), as1 = *(const LAS f32x4*)(acs + s0 + 16 + 4 * gq);
            float pv[8];
#pragma unroll
            for (int r = 0; r < 4; ++r) { const int sa = s0 + 4 * gq + r; pv[r] = (sa <= lrow) ? T0[r] * fexp(acl - as0[r]) : 0.f; pv[4 + r] = (sa + 16 <= lrow) ? T1[r] * fexp(acl - as1[r]) : 0.f; }
            u32x4 pw; pw.x = pk2(pv[0], pv[1]); pw.y = pk2(pv[2], pv[3]); pw.z = pk2(pv[4], pv[5]); pw.w = pk2(pv[6], pv[7]);
            const bf16x8 P = mk8(pw);
#pragma unroll
            for (int pt = 0; pt < 4; ++pt) { const LAS bf16_t* xp = XT + (16 * pt + fr) * 264 + s0 + 4 * gq;
                const bf16x8 Af = mk8(*(const LAS u32x2*)xp, *(const LAS u32x2*)(xp + 16)); yacc[pt] = MFMA16(Af, P, yacc[pt]); } }
#pragma unroll
        for (int pt = 0; pt < 4; ++pt) { u32x2 w; w.x = pk2(yacc[pt].x, yacc[pt].y); w.y = pk2(yacc[pt].z, yacc[pt].w); *(u32x2*)(Y + row * 512 + h * 64 + 16 * pt + 4 * gq) = w; } }
    __syncthreads();
}
__device__ __forceinline__ void ssd_scan(const Args& a, int l, int gtid, int gthreads) {
    unsigned char* ws = a.ws; const float* ST = (const float*)(ws + WS_ST); bf16_t* HIN = (bf16_t*)(ws + WS_HIN); const float* CT = (const float*)(ws + WS_CT);
    for (int e = gtid; e < 2 * 8 * 8192; e += gthreads) { const int b = e >> 16, h = (e >> 13) & 7, pn = e & 8191; float hs = 0.f;
        const size_t o0 = ((size_t)(b * 32) * 8 + h) * 8192 + pn;
#pragma unroll 1
        for (int c0 = 0; c0 < 32; c0 += 16) { float st[16], dc[16];
#pragma unroll
            for (int c = 0; c < 16; ++c) { st[c] = ST[o0 + (size_t)(c0 + c) * 65536]; dc[c] = CT[(b * 32 + c0 + c) * 8 + h]; }
#pragma unroll
            for (int c = 0; c < 16; c += 8) { asm volatile("" : "+v"(st[c]), "+v"(st[c + 1]), "+v"(st[c + 2]), "+v"(st[c + 3]), "+v"(st[c + 4]), "+v"(st[c + 5]), "+v"(st[c + 6]), "+v"(st[c + 7]), "+v"(dc[c]), "+v"(dc[c + 1]), "+v"(dc[c + 2]), "+v"(dc[c + 3]), "+v"(dc[c + 4]), "+v"(dc[c + 5]), "+v"(dc[c + 6]), "+v"(dc[c + 7])); }
#pragma unroll
            for (int c = 0; c < 16; ++c) { HIN[o0 + (size_t)(c0 + c) * 65536] = (bf16_t)(pk2(hs, 0.f) & 0xffffu); hs = fmaf(hs, fexp(dc[c]), st[c]); } }
        a.out[O_HP + (size_t)l * 2 * 8 * 8192 + (size_t)(b * 8 + h) * 8192 + pn] = hs; }
}
__device__ __forceinline__ void ssdC_unit(const Args& a, int l, int unit, LAS unsigned char* lds, int tid) {
    unsigned char* ws = a.ws; const int lane = tid & 63, h = __builtin_amdgcn_readfirstlane(tid >> 6), fr = lane & 15, gq = lane >> 4, g = h >> 2;
    const int bc = unit >> 2; const size_t r0 = (size_t)bc * 256 + (unit & 3) * 64;
    const bf16_t* XC = (const bf16_t*)(ws + WS_XC); const bf16_t* ZS = (const bf16_t*)(ws + WS_ZS); const bf16_t* Y = (const bf16_t*)(ws + WS_Y); const float* ACUM = (const float*)(ws + WS_ACUM);
    const bf16_t* HIN = (const bf16_t*)(ws + WS_HIN) + ((size_t)bc * 8 + h) * 8192;
    LAS float* red = (LAS float*)lds;
    bf16x8 hf[4][4];
#pragma unroll
    for (int pt = 0; pt < 4; ++pt)
#pragma unroll
        for (int kk = 0; kk < 4; ++kk) hf[pt][kk] = mk8(*(const u32x4*)(HIN + (16 * pt + fr) * 128 + 32 * kk + 8 * gq));
    const float Dh = a.in[26][l * 8 + h];
    float pre = 0.f; { const float* tp = (const float*)(ws + WS_TOT) + (size_t)(bc * 4) * 8 + h; const int j = unit & 3; if (j > 0) pre += tp[0]; if (j > 1) pre += tp[8]; if (j > 2) pre += tp[16]; }
    f32x4 v[4][4];
#pragma unroll
    for (int lt = 0; lt < 4; ++lt) { const size_t row = r0 + 16 * lt + fr;
        u32x4 cw[4]; u32x2 yw[4], xw[4], zw[4]; float acv = ACUM[row * 8 + h];
#pragma unroll
        for (int kk = 0; kk < 4; ++kk) cw[kk] = *(const u32x4*)(XC + row * 1024 + 768 + g * 128 + 32 * kk + 8 * gq);
#pragma unroll
        for (int pt = 0; pt < 4; ++pt) { const int p0 = h * 64 + 16 * pt + 4 * gq; yw[pt] = *(const u32x2*)(Y + row * 512 + p0); xw[pt] = *(const u32x2*)(XC + row * 1024 + p0); zw[pt] = *(const u32x2*)(ZS + row * 512 + p0); }
        asm volatile("" : "+v"(cw[0]), "+v"(cw[1]), "+v"(cw[2]), "+v"(cw[3]), "+v"(yw[0]), "+v"(yw[1]), "+v"(yw[2]), "+v"(yw[3]), "+v"(xw[0]), "+v"(xw[1]), "+v"(xw[2]), "+v"(xw[3]), "+v"(zw[0]), "+v"(zw[1]), "+v"(zw[2]), "+v"(zw[3]), "+v"(acv));
        f32x4 yacc[4];
#pragma unroll
        for (int pt = 0; pt < 4; ++pt) { yacc[pt] = (f32x4){0.f, 0.f, 0.f, 0.f};
#pragma unroll
            for (int kk = 0; kk < 4; ++kk) yacc[pt] = MFMA16(hf[pt][kk], mk8(cw[kk]), yacc[pt]); }
        const float el = expf(acv + pre); float ss = 0.f;
#pragma unroll
        for (int pt = 0; pt < 4; ++pt) { const f32x4 yv = {bflo(yw[pt].x), bfhi(yw[pt].x), bflo(yw[pt].y), bfhi(yw[pt].y)};
            f32x4 t; t.x = (yacc[pt].x * el + yv.x + Dh * bflo(xw[pt].x)) * bflo(zw[pt].x); t.y = (yacc[pt].y * el + yv.y + Dh * bfhi(xw[pt].x)) * bfhi(zw[pt].x);
            t.z = (yacc[pt].z * el + yv.z + Dh * bflo(xw[pt].y)) * bflo(zw[pt].y); t.w = (yacc[pt].w * el + yv.w + Dh * bfhi(xw[pt].y)) * bfhi(zw[pt].y);
            v[lt][pt] = t; ss += (t.x * t.x + t.y * t.y) + (t.z * t.z + t.w * t.w); }
        ss += __shfl_xor(ss, 16); ss += __shfl_xor(ss, 32);
        if (gq == 0) red[h * 64 + 16 * lt + fr] = ss; }
    const float* gn = a.in[27] + l * 512; f32x4 ggp[4];
#pragma unroll
    for (int pt = 0; pt < 4; ++pt) ggp[pt] = *(const f32x4*)(gn + h * 64 + 16 * pt + 4 * gq);
    __syncthreads();
#pragma unroll
    for (int lt = 0; lt < 4; ++lt) { const int lr = 16 * lt + fr; const size_t row = r0 + lr; float tot = 0.f;
#pragma unroll
        for (int hh = 0; hh < 8; ++hh) tot += red[hh * 64 + lr];
        const float rs = rsqrtf(tot * (1.f / 512.f) + 1e-6f);
#pragma unroll
        for (int pt = 0; pt < 4; ++pt) { const int p0 = h * 64 + 16 * pt + 4 * gq; const f32x4 o = v[lt][pt] * rs * ggp[pt];
            u32x2 w; w.x = pk2(o.x, o.y); w.y = pk2(o.z, o.w); *(u32x2*)((bf16_t*)(ws + WS_MIX) + row * D + 512 + p0) = w; } }
    __syncthreads();
}

__device__ __forceinline__ void ssd_sample_unit(const Args& a, int l, int unit, int tid) {
    unsigned char* ws = a.ws; const int sb = unit >> 3, h = unit & 7, g = h >> 2, p = tid >> 3, nq = tid & 7; const size_t row = (size_t)MPR + sb;
    const bf16_t* xc = (const bf16_t*)(ws + WS_XC) + row * 1024; float dtv = ((const float*)(ws + WS_DT))[row * 8 + h]; float alog = a.in[25][l * 8 + h]; unsigned xraw = (unsigned)xc[h * 64 + p];
    const float* s = a.in[6] + (((size_t)l * 32 + sb) * 8 + h) * 8192 + p * 128 + 16 * nq; float* o = a.out + O_HS + (((size_t)l * 32 + sb) * 8 + h) * 8192 + p * 128 + 16 * nq;
    u32x4 b0 = *(const u32x4*)(xc + 512 + g * 128 + 16 * nq), b1 = *(const u32x4*)(xc + 512 + g * 128 + 16 * nq + 8), c0 = *(const u32x4*)(xc + 768 + g * 128 + 16 * nq), c1 = *(const u32x4*)(xc + 768 + g * 128 + 16 * nq + 8);
    f32x4 hvp[4];
#pragma unroll
    for (int q = 0; q < 4; ++q) hvp[q] = *(const f32x4*)(s + 4 * q);
    asm volatile("" : "+v"(dtv), "+v"(alog), "+v"(xraw), "+v"(b0), "+v"(b1), "+v"(c0), "+v"(c1), "+v"(hvp[0]), "+v"(hvp[1]), "+v"(hvp[2]), "+v"(hvp[3]));
    const float dA = expf(dtv * -expf(alog)), xd = dtv * __uint_as_float(xraw << 16);
    float Bv[16], Cv[16];
    Bv[0] = bflo(b0.x); Bv[1] = bfhi(b0.x); Bv[2] = bflo(b0.y); Bv[3] = bfhi(b0.y); Bv[4] = bflo(b0.z); Bv[5] = bfhi(b0.z); Bv[6] = bflo(b0.w); Bv[7] = bfhi(b0.w);
    Bv[8] = bflo(b1.x); Bv[9] = bfhi(b1.x); Bv[10] = bflo(b1.y); Bv[11] = bfhi(b1.y); Bv[12] = bflo(b1.z); Bv[13] = bfhi(b1.z); Bv[14] = bflo(b1.w); Bv[15] = bfhi(b1.w);
    Cv[0] = bflo(c0.x); Cv[1] = bfhi(c0.x); Cv[2] = bflo(c0.y); Cv[3] = bfhi(c0.y); Cv[4] = bflo(c0.z); Cv[5] = bfhi(c0.z); Cv[6] = bflo(c0.w); Cv[7] = bfhi(c0.w);
    Cv[8] = bflo(c1.x); Cv[9] = bfhi(c1.x); Cv[10] = bflo(c1.y); Cv[11] = bfhi(c1.y); Cv[12] = bflo(c1.z); Cv[13] = bfhi(c1.z); Cv[14] = bflo(c1.w); Cv[15] = bfhi(c1.w);
    float y = 0.f;
#pragma unroll
    for (int q = 0; q < 4; ++q) { const f32x4 hv = hvp[q]; f32x4 hn;
        hn.x = fmaf(hv.x, dA, xd * Bv[4 * q]); hn.y = fmaf(hv.y, dA, xd * Bv[4 * q + 1]); hn.z = fmaf(hv.z, dA, xd * Bv[4 * q + 2]); hn.w = fmaf(hv.w, dA, xd * Bv[4 * q + 3]);
        *(f32x4*)(o + 4 * q) = hn; y += (Cv[4 * q] * hn.x + Cv[4 * q + 1] * hn.y) + (Cv[4 * q + 2] * hn.z + Cv[4 * q + 3] * hn.w); }
    y += __shfl_xor(y, 1); y += __shfl_xor(y, 2); y += __shfl_xor(y, 4);
    if (nq == 0) ((bf16_t*)(ws + WS_Y))[row * 512 + h * 64 + p] = (bf16_t)(pk2(y, 0.f) & 0xffffu);
}

__device__ __forceinline__ void skinny_partial(const bf16_t* __restrict__ A  , const bf16_t* __restrict__ Bt  , int K, int item, LAS unsigned char* lds, int tid, float* parts) {
    const int lane = tid & 63, wave = __builtin_amdgcn_readfirstlane(tid >> 6), fr = lane & 15, gq = lane >> 4;
    const int u = item & 15, s = item >> 4, nks = K >> 5, k0 = (nks * s) >> 4, k1 = (nks * (s + 1)) >> 4, ks = k0 + wave;
    f32x4 acc[2][4];
#pragma unroll
    for (int rt = 0; rt < 2; ++rt)
#pragma unroll
        for (int ct = 0; ct < 4; ++ct) acc[rt][ct] = (f32x4){0.f, 0.f, 0.f, 0.f};
    if (ks < k1) {
        const bf16_t* a0 = A + (size_t)fr * K + 32 * ks + 8 * gq; const bf16_t* bp = Bt + (size_t)(64 * u + fr) * K + 32 * ks + 8 * gq;
        u32x4 xa0 = *(const u32x4*)a0, xa1 = *(const u32x4*)(a0 + (size_t)16 * K), wb[4];
#pragma unroll
        for (int ct = 0; ct < 4; ++ct) wb[ct] = *(const u32x4*)(bp + (size_t)(16 * ct) * K);
        asm volatile("" : "+v"(xa0), "+v"(xa1), "+v"(wb[0]), "+v"(wb[1]), "+v"(wb[2]), "+v"(wb[3]));
#pragma unroll
        for (int ct = 0; ct < 4; ++ct) { acc[0][ct] = MFMA16(mk8(wb[ct]), mk8(xa0), acc[0][ct]); acc[1][ct] = MFMA16(mk8(wb[ct]), mk8(xa1), acc[1][ct]); }
    }
    LAS float* red = (LAS float*)lds;
#pragma unroll
    for (int rt = 0; rt < 2; ++rt)
#pragma unroll
        for (int ct = 0; ct < 4; ++ct) *(LAS f32x4*)(red + ((wave * 32 + 16 * rt + fr) * 64 + 16 * ct + 4 * gq)) = acc[rt][ct];
    __syncthreads();
    const int row = tid >> 4, c4 = (tid & 15) * 4;
    { f32x4 v = {0.f, 0.f, 0.f, 0.f};
#pragma unroll
      for (int w = 0; w < 8; ++w) v += *(const LAS f32x4*)(red + ((w * 32 + row) * 64 + c4));
      float* pp = parts + ((size_t)(u * 16 + s) * 32 + row) * 64 + c4;
      __hip_atomic_store(pp + 0, v.x, __ATOMIC_RELAXED, __HIP_MEMORY_SCOPE_AGENT); __hip_atomic_store(pp + 1, v.y, __ATOMIC_RELAXED, __HIP_MEMORY_SCOPE_AGENT);
      __hip_atomic_store(pp + 2, v.z, __ATOMIC_RELAXED, __HIP_MEMORY_SCOPE_AGENT); __hip_atomic_store(pp + 3, v.w, __ATOMIC_RELAXED, __HIP_MEMORY_SCOPE_AGENT); }
    __syncthreads();
}
__device__ __forceinline__ void skinny_final(int item, const float* xold  , bf16_t* XB, float* SSQ, float alpha, LAS unsigned char* lds, int tid, float* parts, unsigned* cnt,
                                             const float* nssq = nullptr, const float* gsc = nullptr, float* SSQG = nullptr) {
    const int u = item & 15, row = tid >> 4, c4 = (tid & 15) * 4;
    LAS unsigned* flag = (LAS unsigned*)(lds + RING_BYTES);
    asm volatile("s_waitcnt vmcnt(0)" ::: "memory");
    __syncthreads();
    if (tid == 0) *flag = atomicAdd(cnt + u, 1u);
    __syncthreads();
    const bool last = (*flag == 15u);
    if (last) {
        const size_t o = (size_t)row * D + 64 * u + c4;
        f32x4 pv[16]; f32x4 xo4 = {0.f, 0.f, 0.f, 0.f}; u32x2 xw = {0u, 0u}; float rn = 1.f;
#pragma unroll
        for (int s2 = 0; s2 < 16; ++s2) { float* pp = parts + ((size_t)(u * 16 + s2) * 32 + row) * 64 + c4;
            pv[s2].x = __hip_atomic_load(pp + 0, __ATOMIC_RELAXED, __HIP_MEMORY_SCOPE_AGENT); pv[s2].y = __hip_atomic_load(pp + 1, __ATOMIC_RELAXED, __HIP_MEMORY_SCOPE_AGENT);
            pv[s2].z = __hip_atomic_load(pp + 2, __ATOMIC_RELAXED, __HIP_MEMORY_SCOPE_AGENT); pv[s2].w = __hip_atomic_load(pp + 3, __ATOMIC_RELAXED, __HIP_MEMORY_SCOPE_AGENT); }
        if (xold) xo4 = *(const f32x4*)(xold + o); else { xw = *(const u32x2*)(XB + o); if (nssq) rn = rstd16(nssq + (size_t)row * 16); }
        asm volatile("" : "+v"(pv[0]), "+v"(pv[1]), "+v"(pv[2]), "+v"(pv[3]), "+v"(pv[4]), "+v"(pv[5]), "+v"(pv[6]), "+v"(pv[7]), "+v"(pv[8]), "+v"(pv[9]), "+v"(pv[10]), "+v"(pv[11]), "+v"(pv[12]), "+v"(pv[13]), "+v"(pv[14]), "+v"(pv[15]), "+v"(xo4), "+v"(xw), "+v"(rn));
        f32x4 v = pv[0];
#pragma unroll
        for (int s2 = 1; s2 < 16; ++s2) v += pv[s2];
        f32x4 xo = xo4; if (!xold) xo = (f32x4){bflo(xw.x), bfhi(xw.x), bflo(xw.y), bfhi(xw.y)} * rn;
        const f32x4 xn = xo + alpha * v;
        f32x4 xb = xn; if (gsc) xb = xn * *(const f32x4*)(gsc + 64 * u + c4);
        u32x2 w2; w2.x = pk2(xb.x, xb.y); w2.y = pk2(xb.z, xb.w); *(u32x2*)(XB + o) = w2;
        float ss = (xn.x * xn.x + xn.y * xn.y) + (xn.z * xn.z + xn.w * xn.w), sg = (xb.x * xb.x + xb.y * xb.y) + (xb.z * xb.z + xb.w * xb.w);
        ss += __shfl_xor(ss, 1); ss += __shfl_xor(ss, 2); ss += __shfl_xor(ss, 4); ss += __shfl_xor(ss, 8);
        sg += __shfl_xor(sg, 1); sg += __shfl_xor(sg, 2); sg += __shfl_xor(sg, 4); sg += __shfl_xor(sg, 8);
        if ((tid & 15) == 0) { SSQ[(size_t)row * 16 + u] = ss; if (gsc) SSQG[(size_t)row * 16 + u] = sg; } }
    __syncthreads();
}
__device__ __forceinline__ void sel_unit(const Args& a, int unit, LAS unsigned char* lds, int tid) {
    unsigned char* ws = a.ws; const int hp = unit & 1, cur = (unit >> 1) & 31, b = unit >> 6, r = tid & 255, hh = tid >> 8, h = 2 * hp + hh;
    const size_t m = (size_t)b * SEQ + cur * 256 + r;
    LAS float* km = (LAS float*)lds;
    const float* KMP = (const float*)(ws + WS_KMP) + (size_t)b * 32 * 256 + hp * 128;
    for (int i = tid; i < cur * 32; i += NTHR) { const int n = i >> 5, c4 = i & 31; *(LAS f32x4*)(km + n * 128 + 4 * c4) = *(const f32x4*)(KMP + n * 256 + 4 * c4); }
    float q[64];
    { const bf16_t* qp = (const bf16_t*)(ws + WS_QB) + m * 256 + h * 64;
#pragma unroll
      for (int j = 0; j < 8; ++j) { const u32x4 w = *(const u32x4*)(qp + 8 * j); q[8 * j] = bflo(w.x); q[8 * j + 1] = bfhi(w.x); q[8 * j + 2] = bflo(w.y); q[8 * j + 3] = bfhi(w.y); q[8 * j + 4] = bflo(w.z); q[8 * j + 5] = bfhi(w.z); q[8 * j + 6] = bflo(w.w); q[8 * j + 7] = bfhi(w.w); } }
    __syncthreads();
    float v0 = -INFINITY, v1 = -INFINITY, v2 = -INFINITY; int i0 = 0, i1 = 0, i2 = 0;
    for (int n = 0; n < cur; ++n) { const LAS float* kp = km + n * 128 + hh * 64; float g0 = 0.f, g1 = 0.f;
#pragma unroll
        for (int j = 0; j < 16; j += 2) { const f32x4 ka = *(const LAS f32x4*)(kp + 4 * j), kb = *(const LAS f32x4*)(kp + 4 * j + 4);
            g0 = fmaf(q[4 * j], ka.x, g0); g0 = fmaf(q[4 * j + 1], ka.y, g0); g0 = fmaf(q[4 * j + 2], ka.z, g0); g0 = fmaf(q[4 * j + 3], ka.w, g0);
            g1 = fmaf(q[4 * j + 4], kb.x, g1); g1 = fmaf(q[4 * j + 5], kb.y, g1); g1 = fmaf(q[4 * j + 6], kb.z, g1); g1 = fmaf(q[4 * j + 7], kb.w, g1); }
        const float gv = g0 + g1;
        if (gv > v0) { v2 = v1; i2 = i1; v1 = v0; i1 = i0; v0 = gv; i0 = n; } else if (gv > v1) { v2 = v1; i2 = i1; v1 = gv; i1 = n; } else if (gv > v2) { v2 = gv; i2 = n; } }
    const int cnt = cur < 3 ? cur : 3;
    ((unsigned*)(ws + WS_SEL))[m * 4 + h] = (unsigned)i0 | ((unsigned)i1 << 8) | ((unsigned)i2 << 16) | ((unsigned)cnt << 24);
    __syncthreads();
}
__device__ const unsigned ATT_TAB[32][2] = {{1049861u,0u},{1968650u,0u},{1705730u,0u},{1771785u,0u},{1180929u,0u},{852996u,0u},{1574920u,0u},{918528u,0u},{2099979u,0u},{1378055u,0u},{262144u,0u},{656131u,0u},{1181190u,0u},{459266u,0u},{2100236u,0u},{327937u,0u},{2099715u,0u},{2100493u,0u},{2100750u,2104842u},{2101007u,2104073u},{2101264u,2103810u},{2100484u,2103304u},{2101521u,2105119u},{2101778u,2104862u},{2100736u,2104605u},{2102035u,2102535u},{2102292u,2104348u},{2102549u,2104091u},{2101253u,2103834u},{2102806u,2103577u},{2103063u,2103320u},{2101761u,2101766u}};
constexpr int AT_KM = 0, AT_VT = 36864, AT_BT = AT_VT + 33792, AT_QL = AT_BT + 1024, AT_WC = AT_QL + 16384, AT_NC = 8;
__device__ __forceinline__ void attn_slot(const Args& a, int sidx, LAS unsigned char* lds, int tid) {
    unsigned char* ws = a.ws; const int lane = tid & 63, wave = __builtin_amdgcn_readfirstlane(tid >> 6), fr = lane & 15, gq = lane >> 4;
    const int bh = sidx & 7, b = bh >> 2, h = bh & 3, slot_i = sidx >> 3;
    LAS bf16_t* Km = (LAS bf16_t*)(lds + AT_KM); LAS bf16_t* VT = (LAS bf16_t*)(lds + AT_VT); LAS float* BTs = (LAS float*)(lds + AT_BT); LAS unsigned* ql = (LAS unsigned*)(lds + AT_QL); LAS int* wc = (LAS int*)(lds + AT_WC);
    const bf16_t* KB = (const bf16_t*)(ws + WS_KB); const bf16_t* VB = (const bf16_t*)(ws + WS_VB); const bf16_t* QB = (const bf16_t*)(ws + WS_QB);
    if (tid < 129) BTs[tid] = ((const float*)(ws + WS_BT))[h * 129 + tid];
#pragma unroll 1
    for (int it = 0; it < 2; ++it) { const unsigned tw = ATT_TAB[slot_i][it]; const int n = (int)(tw & 255u), lo = (int)((tw >> 8) & 255u), hi = (int)(tw >> 16);
      if (hi <= lo) continue;
      const size_t kr0 = (size_t)b * SEQ + n * 256;
      u32x4 kst[4], vst[4];
#pragma unroll
      for (int pass = 0; pass < 4; ++pass) { kst[pass] = *(const u32x4*)(KB + (kr0 + pass * 64 + (tid >> 3)) * 256 + h * 64 + 8 * (tid & 7)); vst[pass] = *(const u32x4*)(VB + (kr0 + pass * 64 + lane) * 256 + h * 64 + 8 * wave); }
      asm volatile("" : "+v"(kst[0]), "+v"(kst[1]), "+v"(kst[2]), "+v"(kst[3]), "+v"(vst[0]), "+v"(vst[1]), "+v"(vst[2]), "+v"(vst[3]));
#pragma unroll
      for (int pass = 0; pass < 4; ++pass) { const int key = pass * 64 + (tid >> 3), ch = tid & 7; *(LAS u32x4*)(Km + key * 72 + 8 * ch) = kst[pass]; }
#pragma unroll
      for (int pass = 0; pass < 4; ++pass) { const int key = pass * 64 + lane; const u32x4 v = vst[pass];
          LAS bf16_t* vp = VT + (8 * wave) * 264 + key;
          vp[0] = (bf16_t)(v.x & 0xffffu); vp[264] = (bf16_t)(v.x >> 16); vp[2 * 264] = (bf16_t)(v.y & 0xffffu); vp[3 * 264] = (bf16_t)(v.y >> 16);
          vp[4 * 264] = (bf16_t)(v.z & 0xffffu); vp[5 * 264] = (bf16_t)(v.z >> 16); vp[6 * 264] = (bf16_t)(v.w & 0xffffu); vp[7 * 264] = (bf16_t)(v.w >> 16); }
#pragma unroll 1
      for (int c0 = lo * 256; c0 < hi * 256; c0 += 512 * AT_NC) {
        bool hit[AT_NC]; unsigned ent[AT_NC], sv[AT_NC];
#pragma unroll
        for (int k = 0; k < AT_NC; ++k) { const int t = c0 + 512 * k + tid; sv[k] = 0u; if (t < hi * 256 && (t >> 8) != n) sv[k] = ((const unsigned*)(ws + WS_SEL))[((size_t)b * SEQ + t) * 4 + h]; }
        asm volatile("" : "+v"(sv[0]), "+v"(sv[1]), "+v"(sv[2]), "+v"(sv[3]), "+v"(sv[4]), "+v"(sv[5]), "+v"(sv[6]), "+v"(sv[7]));
#pragma unroll
        for (int k = 0; k < AT_NC; ++k) { const int t = c0 + 512 * k + tid; hit[k] = false; ent[k] = 0u;
            if (t < hi * 256) { const int cb = t >> 8;
                if (cb == n) { hit[k] = true; ent[k] = (unsigned)t | (3u << 16); }
                else { const unsigned s = sv[k]; const unsigned cnt = s >> 24;
                    if (cnt > 0 && (s & 255u) == (unsigned)n) { hit[k] = true; ent[k] = (unsigned)t; } else if (cnt > 1 && ((s >> 8) & 255u) == (unsigned)n) { hit[k] = true; ent[k] = (unsigned)t | (1u << 16); } else if (cnt > 2 && ((s >> 16) & 255u) == (unsigned)n) { hit[k] = true; ent[k] = (unsigned)t | (2u << 16); } } } }
        unsigned long long bal[AT_NC]; const unsigned long long below = (1ull << lane) - 1ull;
#pragma unroll
        for (int k = 0; k < AT_NC; ++k) { bal[k] = __ballot(hit[k]); if (lane == 0) wc[8 * k + wave] = __popcll(bal[k]); }
        __syncthreads();
        int run = 0, mine[AT_NC];
#pragma unroll
        for (int w = 0; w < 8 * AT_NC; ++w) { if ((w & 7) == wave) mine[w >> 3] = run; run += wc[w]; }
        const int tot = run;
#pragma unroll
        for (int k = 0; k < AT_NC; ++k) if (hit[k]) ql[mine[k] + __popcll(bal[k] & below)] = ent[k];
        const int nq = tot; __syncthreads();
#ifndef AT_RT
#define AT_RT 1
#endif
        for (int rrt_ = 0; rrt_ < AT_RT; ++rrt_) {
        const float bfar = BTs[128];
        unsigned e_n = 0u; u32x4 qn0 = {0u, 0u, 0u, 0u}, qn1 = {0u, 0u, 0u, 0u};
        if (wave * 16 < nq) { const int qi = 16 * wave + fr; e_n = ql[qi < nq ? qi : 16 * wave]; const bf16_t* qp = QB + ((size_t)b * SEQ + (e_n & 0xffffu)) * 256 + h * 64 + 8 * gq; qn0 = *(const u32x4*)qp; qn1 = *(const u32x4*)(qp + 32); }
        for (int ti = wave; ti * 16 < nq; ti += NWAVES) { const int qi = 16 * ti + fr; const bool valid = qi < nq; const unsigned e = e_n; const int t = (int)(e & 0xffffu), slot = (int)(e >> 16);
            const size_t qrow = (size_t)b * SEQ + t;
            const bf16x8 qf0 = mk8(qn0), qf1 = mk8(qn1);
            if ((ti + NWAVES) * 16 < nq) { const int q2 = 16 * (ti + NWAVES) + fr; e_n = ql[q2 < nq ? q2 : 16 * (ti + NWAVES)]; const bf16_t* qp = QB + ((size_t)b * SEQ + (e_n & 0xffffu)) * 256 + h * 64 + 8 * gq; qn0 = *(const u32x4*)qp; qn1 = *(const u32x4*)(qp + 32); }
            const int need = (slot == 3) ? (((t - n * 256) >> 6) + 1) : 4;
            const int ng = 1 + (__any(need >= 2) ? 1 : 0) + (__any(need >= 3) ? 1 : 0) + (__any(need >= 4) ? 1 : 0);
            f32x4 T[16];
#pragma unroll
            for (int g = 0; g < 4; ++g) {
                if (g < ng) {
#pragma unroll
                    for (int k4 = 0; k4 < 4; ++k4) { const int kt = 4 * g + k4; const LAS bf16_t* kp = Km + (16 * kt + fr) * 72 + 8 * gq; f32x4 acc = {0.f, 0.f, 0.f, 0.f};
                        acc = MFMA16(mk8(*(const LAS u32x4*)kp), qf0, acc); acc = MFMA16(mk8(*(const LAS u32x4*)(kp + 32)), qf1, acc); T[kt] = acc; }
                } else {
#pragma unroll
                    for (int k4 = 0; k4 < 4; ++k4) T[4 * g + k4] = (f32x4){-INFINITY, -INFINITY, -INFINITY, -INFINITY};
                } }
            const int dmin = t - (n * 256 + 255);
            float mx = -INFINITY;
            float mxadd = 0.f;
            if (__all(dmin >= 128)) {
                mxadd = bfar;
#pragma unroll
                for (int kt = 0; kt < 16; ++kt)
#pragma unroll
                    for (int r = 0; r < 4; ++r) mx = fmaxf(mx, T[kt][r]);
            } else {
                const int dbase = dmin + 255 - 4 * gq;
#pragma unroll
                for (int g = 0; g < 4; ++g) if (g < ng) {
#pragma unroll
                    for (int k4 = 0; k4 < 4; ++k4)
#pragma unroll
                        for (int r = 0; r < 4; ++r) { const int kt = 4 * g + k4; int di = dbase - (16 * kt + r); di = di < 0 ? 0 : (di > 128 ? 128 : di); T[kt][r] += BTs[di]; }
#pragma unroll
                    for (int k4 = 0; k4 < 4; ++k4)
#pragma unroll
                        for (int r = 0; r < 4; ++r) { const int kt = 4 * g + k4; const float x = (dbase - (16 * kt + r) >= 0) ? T[kt][r] : -INFINITY; T[kt][r] = x; mx = fmaxf(mx, x); }
                }
            }
            mx = fmaxf(mx, __shfl_xor(mx, 16)); mx = fmaxf(mx, __shfl_xor(mx, 32));
            f32x4 ls4 = {0.f, 0.f, 0.f, 0.f}; const f32x4 mx4 = {mx, mx, mx, mx};
#pragma unroll
            for (int g = 0; g < 4; ++g) {
                if (g < ng) {
#pragma unroll
                    for (int k4 = 0; k4 < 4; ++k4) { const int kt = 4 * g + k4; const f32x4 d = T[kt] - mx4;
                        const f32x4 p = {__builtin_amdgcn_exp2f(d.x), __builtin_amdgcn_exp2f(d.y), __builtin_amdgcn_exp2f(d.z), __builtin_amdgcn_exp2f(d.w)}; T[kt] = p; ls4 += p; }
                } }
            float ls = (ls4.x + ls4.y) + (ls4.z + ls4.w);
            ls += __shfl_xor(ls, 16); ls += __shfl_xor(ls, 32);
            f32x4 O[4];
#pragma unroll
            for (int dt = 0; dt < 4; ++dt) O[dt] = (f32x4){0.f, 0.f, 0.f, 0.f};
            const LAS bf16_t* vlo = VT + fr * 264 + 4 * gq; const LAS bf16_t* vhi = vlo + 16; asm volatile("" : "+v"(vhi));
#pragma unroll
            for (int g = 0; g < 4; ++g) if (g < ng) {
#pragma unroll
                for (int k2 = 0; k2 < 2; ++k2) { const int ks = 2 * g + k2; u32x4 pw; pw.x = pk2(T[2 * ks][0], T[2 * ks][1]); pw.y = pk2(T[2 * ks][2], T[2 * ks][3]); pw.z = pk2(T[2 * ks + 1][0], T[2 * ks + 1][1]); pw.w = pk2(T[2 * ks + 1][2], T[2 * ks + 1][3]);
                    const bf16x8 P = mk8(pw);
#pragma unroll
                    for (int dt = 0; dt < 4; ++dt) O[dt] = MFMA16(mk8(*(const LAS u32x2*)(vlo + (16 * dt) * 264 + 32 * ks), *(const LAS u32x2*)(vhi + (16 * dt) * 264 + 32 * ks)), P, O[dt]); }
            }
            if (valid && (AT_RT == 1 || rrt_ == 0)) { unsigned char* pp = ws + WS_PART + ((qrow * 4 + h) * 4 + slot) * 144;
#pragma unroll
                for (int dt = 0; dt < 4; ++dt) { u32x2 w; w.x = pk2(O[dt].x, O[dt].y); w.y = pk2(O[dt].z, O[dt].w); *(u32x2*)(pp + (16 * dt + 4 * gq) * 2) = w; }
                if (gq == 0) *(f32x2*)(pp + 128) = (f32x2){mx + mxadd, ls}; }
        }
        }
        __syncthreads();
      }
    }
}
__device__ __forceinline__ void attn_combine(const Args& a, int idx) {
    unsigned char* ws = a.ws; const int pair = idx >> 2, qd = idx & 3; const size_t row = (size_t)(pair >> 2); const int h = pair & 3;
    const unsigned s = ((const unsigned*)(ws + WS_SEL))[row * 4 + h]; const int cnt = (int)(s >> 24);
    const unsigned char* pp = ws + WS_PART + (row * 4 + h) * 4 * 144;
    f32x2 ml[4]; u32x4 ov[4][2];
#pragma unroll
    for (int j = 0; j < 4; ++j) { ml[j] = *(const f32x2*)(pp + j * 144 + 128); ov[j][0] = *(const u32x4*)(pp + j * 144 + 32 * qd); ov[j][1] = *(const u32x4*)(pp + j * 144 + 32 * qd + 16); }
    float M = ml[3].x;
#pragma unroll
    for (int j = 0; j < 3; ++j) M = (j < cnt) ? fmaxf(M, ml[j].x) : M;
    float den = 0.f, num[16];
#pragma unroll
    for (int e = 0; e < 16; ++e) num[e] = 0.f;
#pragma unroll
    for (int j = 0; j < 4; ++j) { const bool on = (j == 3) || (j < cnt); const float w = on ? __builtin_amdgcn_exp2f(ml[j].x - M) : 0.f; den += on ? w * ml[j].y : 0.f;
#pragma unroll
        for (int q = 0; q < 2; ++q) { const u32x4 t = on ? ov[j][q] : (u32x4){0u, 0u, 0u, 0u};
            num[8 * q + 0] = fmaf(w, bflo(t.x), num[8 * q + 0]); num[8 * q + 1] = fmaf(w, bfhi(t.x), num[8 * q + 1]); num[8 * q + 2] = fmaf(w, bflo(t.y), num[8 * q + 2]); num[8 * q + 3] = fmaf(w, bfhi(t.y), num[8 * q + 3]);
            num[8 * q + 4] = fmaf(w, bflo(t.z), num[8 * q + 4]); num[8 * q + 5] = fmaf(w, bfhi(t.z), num[8 * q + 5]); num[8 * q + 6] = fmaf(w, bflo(t.w), num[8 * q + 6]); num[8 * q + 7] = fmaf(w, bfhi(t.w), num[8 * q + 7]); } }
    const float inv = 1.f / den; u32x4 w0, w1;
    w0.x = pk2(num[0] * inv, num[1] * inv); w0.y = pk2(num[2] * inv, num[3] * inv); w0.z = pk2(num[4] * inv, num[5] * inv); w0.w = pk2(num[6] * inv, num[7] * inv);
    w1.x = pk2(num[8] * inv, num[9] * inv); w1.y = pk2(num[10] * inv, num[11] * inv); w1.z = pk2(num[12] * inv, num[13] * inv); w1.w = pk2(num[14] * inv, num[15] * inv);
    bf16_t* dst = (bf16_t*)(ws + WS_MIX) + row * D + 256 + h * 64 + 16 * qd; *(u32x4*)dst = w0; *(u32x4*)(dst + 8) = w1;
}
__device__ __forceinline__ void attn_sample_unit(const Args& a, int l, int unit, LAS unsigned char* lds, int tid) {
    unsigned char* ws = a.ws; const int lane = tid & 63, wave = __builtin_amdgcn_readfirstlane(tid >> 6), sb = unit >> 2, h = unit & 3; const size_t m = (size_t)MPR + sb;
    const float* KMS = (const float*)(ws + WS_KMS) + ((size_t)l * 1024 + sb * 32) * 256 + h * 64; const float* BT = (const float*)(ws + WS_BT) + h * 129;
    const float* ck = a.in[2] + (size_t)l * CACHE_L; const float* cv = a.in[3] + (size_t)l * CACHE_L; const int* pt = (const int*)a.in[7] + sb * NPAGES;
    LAS float* gate = (LAS float*)lds; LAS float* lg = gate + 64; LAS float* red = lg + 832; LAS float* osum = red + 16; LAS float* bts = osum + 512;
    float btv = BT[tid < 129 ? tid : 0]; unsigned qraw = (unsigned)((const bf16_t*)(ws + WS_QB))[m * 256 + h * 64 + lane]; float kmv[4]; int ptv = pt[lane];
#pragma unroll
    for (int i = 0; i < 4; ++i) kmv[i] = KMS[(size_t)(4 * wave + i) * 256 + lane];
    asm volatile("" : "+v"(btv), "+v"(qraw), "+v"(kmv[0]), "+v"(kmv[1]), "+v"(kmv[2]), "+v"(kmv[3]), "+v"(ptv));
    LAS int* pts = (LAS int*)(bts + 132);
    if (tid < 129) bts[tid] = btv;
    if (tid < 64) pts[tid] = ptv;
    const float qd = __uint_as_float(qraw << 16);
#pragma unroll
    for (int i = 0; i < 4; ++i) { const int n = 4 * wave + i; const float g = wsum(qd * kmv[i]); if (lane == 0) gate[n] = g; }
    __syncthreads();
    int i0 = 0, i1 = 0, i2 = 0; { float v0 = -INFINITY, v1 = -INFINITY, v2 = -INFINITY;
      for (int n = 0; n < 32; ++n) { const float gv = gate[n]; if (gv > v0) { v2 = v1; i2 = i1; v1 = v0; i1 = i0; v0 = gv; i0 = n; } else if (gv > v1) { v2 = v1; i2 = i1; v1 = gv; i1 = n; } else if (gv > v2) { v2 = gv; i2 = n; } } }
    const size_t pg0 = (size_t)pts[2 * i0] * 128, pg1 = (size_t)pts[2 * i0 + 1] * 128, pg2 = (size_t)pts[2 * i1] * 128, pg3 = (size_t)pts[2 * i1 + 1] * 128, pg4 = (size_t)pts[2 * i2] * 128, pg5 = (size_t)pts[2 * i2 + 1] * 128;
    const int kq = lane >> 4, dq = lane & 15; const f32x4 q4 = {__shfl(qd, 4 * dq), __shfl(qd, 4 * dq + 1), __shfl(qd, 4 * dq + 2), __shfl(qd, 4 * dq + 3)};
    f32x4 kv[24];
#pragma unroll
    for (int st = 0; st < 24; ++st) { const int kl = 32 * st + 4 * wave + kq, pi = st >> 2; const size_t pg = pi == 0 ? pg0 : pi == 1 ? pg1 : pi == 2 ? pg2 : pi == 3 ? pg3 : pi == 4 ? pg4 : pg5;
        kv[st] = *(const f32x4*)(ck + (pg + (kl & 127)) * 256 + h * 64 + 4 * dq); }
    float vv0[3][16], vv1[3][16];
#pragma unroll
    for (int q = 0; q < 3; ++q) { const size_t pg = q == 0 ? pg0 : q == 1 ? pg1 : pg2; const float* vb = cv + pg * 256 + h * 64 + lane;
#pragma unroll
        for (int i = 0; i < 16; ++i) vv0[q][i] = vb[(size_t)(wave + 8 * i) * 256]; }
#pragma unroll
    for (int st = 0; st < 24; ++st) { const int kl = 32 * st + 4 * wave + kq, j = st >> 3, blk = j == 0 ? i0 : (j == 1 ? i1 : i2), kpos = blk * 256 + (kl & 255);
        float d = (q4.x * kv[st].x + q4.y * kv[st].y) + (q4.z * kv[st].z + q4.w * kv[st].w);
        d += __shfl_xor(d, 1); d += __shfl_xor(d, 2); d += __shfl_xor(d, 4); d += __shfl_xor(d, 8);
        const int dist = 8192 - kpos; if (dq == 0) lg[kl] = d + bts[dist < 128 ? dist : 128]; }
    if (wave == 0) { const float d = wsum(qd * bf1(((const bf16_t*)(ws + WS_KB))[m * 256 + h * 64 + lane])); if (lane == 0) lg[768] = d + bts[0]; }
#pragma unroll
    for (int q = 0; q < 3; ++q) { const size_t pg = q == 0 ? pg3 : q == 1 ? pg4 : pg5; const float* vb = cv + pg * 256 + h * 64 + lane;
#pragma unroll
        for (int i = 0; i < 16; ++i) vv1[q][i] = vb[(size_t)(wave + 8 * i) * 256]; }
    __syncthreads();
    float mx = -INFINITY; for (int i = tid; i < 769; i += NTHR) mx = fmaxf(mx, lg[i]);
#pragma unroll
    for (int o = 1; o < 64; o <<= 1) mx = fmaxf(mx, __shfl_xor(mx, o));
    if (lane == 0) red[wave] = mx;
    __syncthreads();
    mx = red[0];
#pragma unroll
    for (int w = 1; w < 8; ++w) mx = fmaxf(mx, red[w]);
    float ps = 0.f; for (int i = tid; i < 769; i += NTHR) { const float p = __builtin_amdgcn_exp2f(lg[i] - mx); lg[i] = p; ps += p; }
    ps = wsum(ps); if (lane == 0) red[8 + wave] = ps;
    __syncthreads();
    float tot = 0.f;
#pragma unroll
    for (int w = 0; w < 8; ++w) tot += red[8 + w];
    float acc = 0.f;
#pragma unroll
    for (int q = 0; q < 3; ++q) asm volatile("" : "+v"(vv0[q][0]), "+v"(vv0[q][1]), "+v"(vv0[q][2]), "+v"(vv0[q][3]), "+v"(vv0[q][4]), "+v"(vv0[q][5]), "+v"(vv0[q][6]), "+v"(vv0[q][7]), "+v"(vv0[q][8]), "+v"(vv0[q][9]), "+v"(vv0[q][10]), "+v"(vv0[q][11]), "+v"(vv0[q][12]), "+v"(vv0[q][13]), "+v"(vv0[q][14]), "+v"(vv0[q][15]));
#pragma unroll
    for (int q = 0; q < 3; ++q)
#pragma unroll
        for (int i = 0; i < 16; ++i) acc = fmaf(lg[128 * q + wave + 8 * i], vv0[q][i], acc);
#pragma unroll
    for (int q = 0; q < 3; ++q) asm volatile("" : "+v"(vv1[q][0]), "+v"(vv1[q][1]), "+v"(vv1[q][2]), "+v"(vv1[q][3]), "+v"(vv1[q][4]), "+v"(vv1[q][5]), "+v"(vv1[q][6]), "+v"(vv1[q][7]), "+v"(vv1[q][8]), "+v"(vv1[q][9]), "+v"(vv1[q][10]), "+v"(vv1[q][11]), "+v"(vv1[q][12]), "+v"(vv1[q][13]), "+v"(vv1[q][14]), "+v"(vv1[q][15]));
#pragma unroll
    for (int q = 0; q < 3; ++q)
#pragma unroll
        for (int i = 0; i < 16; ++i) acc = fmaf(lg[128 * (3 + q) + wave + 8 * i], vv1[q][i], acc);
    if (wave == 0) acc = fmaf(lg[768], bf1(((const bf16_t*)(ws + WS_VB))[m * 256 + h * 64 + lane]), acc);
    osum[wave * 64 + lane] = acc;
    __syncthreads();
    if (tid < 64) { float o = 0.f;
#pragma unroll
        for (int w = 0; w < 8; ++w) o += osum[w * 64 + tid];
        ((bf16_t*)(ws + WS_MIX))[m * D + 256 + h * 64 + tid] = (bf16_t)(pk2(o / tot, 0.f) & 0xffffu); }
    __syncthreads();
}

__device__ __forceinline__ void kms_unit(const Args& args, unsigned char* ws, int v, LAS unsigned char* lds, int tid) {
    const int* pt = (const int*)args.in[7]; const int l = v >> 10, r = v & 1023, sb = r >> 5, n = r & 31;
    const float* ck = args.in[2] + (size_t)l * CACHE_L;
    colmean_unit(ck + (size_t)pt[sb * NPAGES + 2 * n] * 128 * 256, ck + (size_t)pt[sb * NPAGES + 2 * n + 1] * 128 * 256, (float*)(ws + WS_KMS) + (size_t)v * 256, (LAS float*)(lds + RING_BYTES), tid);
}
#ifndef KMS_GU
#define KMS_GU 4
#endif
#ifndef KMS_WIN
#define KMS_WIN 4
#endif
constexpr int GU_UNITS = 65 * 22, WIN_UNITS = 65 * 11;
__device__ __forceinline__ void kms_tail(const Args& args, unsigned char* ws, int G, int nunits, int per, int vbase, int vlimit, LAS unsigned char* lds, int tid) {
    const int first_idle = nunits % G; if (first_idle == 0 || (int)blockIdx.x < first_idle) return;
    for (int i = 0; i < per; ++i) { const int v = vbase + ((int)blockIdx.x - first_idle) * per + i; if (v < vlimit) kms_unit(args, ws, v, lds, tid); }
}
#define KM_MIN(a, b) ((a) < (b) ? (a) : (b))
#define KM_SPLIT(G) const int km_gu_ = ((GU_UNITS % (G)) ? (G) - GU_UNITS % (G) : 0) * KMS_GU, km_win_ = ((WIN_UNITS % (G)) ? (G) - WIN_UNITS % (G) : 0) * KMS_WIN; \
    const int KM_A0 = KM_MIN(km_gu_, 1024), KM_A1 = KM_MIN(km_gu_ + km_win_, 1024), KM_B0 = KM_MIN(km_gu_, 1024), KM_B1 = KM_MIN(2 * km_gu_, 1024), KM_B2 = KM_MIN(2 * km_gu_ + km_win_, 1024); (void)KM_A0; (void)KM_A1; (void)KM_B0; (void)KM_B1; (void)KM_B2;
constexpr int N_PHASES = 23;
#ifndef MK_CUTS
#define MK_CUTS 0
#endif
__global__ void __launch_bounds__(NTHR, 2) mk_fwd(Args args) {
    extern __shared__ __attribute__((aligned(16))) unsigned char lds_raw[];
    LAS unsigned char* lds = (LAS unsigned char*)lds_raw;
    const int tid0 = threadIdx.x; const int wave0 = __builtin_amdgcn_readfirstlane(tid0 >> 6);
    volatile LAS unsigned* MISC = (volatile LAS unsigned*)(lds + MISC_OFF);
    if (tid0 < 64) MISC[tid0] = 0u;
    __syncthreads();
    unsigned char* ws0 = args.ws;
    unsigned* ctl = (unsigned*)(ws0 + WS_CTL);
    XcdBarrier bar = xcd_barrier_post(ctl + CW_BAR + args.li * XCD_BAR_WORDS, MISC + 8);
    const int G0 = gridDim.x;
    const int lo = args.ph_lo, hi = args.ph_hi; (void)lo; (void)hi;
#ifndef MK_DUP
#define MK_DUP 0
#endif
#ifndef MK_DUPX
#define MK_DUPX 0
#endif
#define XR(b) for (int rr_ = 0; rr_ < ((((MK_DUPX) >> (b)) & 1) ? 2 : 1); ++rr_)
#define NREP(t) (((MK_DUP) >> (t)) & 1 ? 2 : 1)
#define REP(t) for (int rep = 0; rep < NREP(t); ++rep, (rep < NREP(t) ? xcd_barrier(bar) : (void)0))
#if defined(MK_DEBUG_ATTN) || (defined(MK_CUTS) && MK_CUTS)
#define IN(k) (lo <= (k) && (k) < hi)
#else
#define IN(k) true
#endif
#define SEAM(k) do { if (IN(k) && IN((k) + 1)) xcd_barrier(bar); } while (0)
#define PH_BEGIN() unsigned ones_ = ~0u; asm volatile("" : "+s"(ones_)); int tid = wave0 * 64 + (int)__builtin_amdgcn_mbcnt_hi(ones_, __builtin_amdgcn_mbcnt_lo(ones_, 0u)); asm volatile("" : "+v"(tid)); const int lane = tid & 63, wave = wave0; int G = G0; asm volatile("" : "+s"(G)); const int gw = blockIdx.x * NWAVES + wave, ngw = G * NWAVES; size_t zoff_ = 0; asm volatile("" : "+s"(zoff_)); unsigned char* ws = ws0 + zoff_;     \
    bf16_t* XB = (bf16_t*)(ws + WS_XB); float* SSQ = (float*)(ws + WS_SSQ); bf16_t* ACT = (bf16_t*)(ws + WS_ACT); bf16_t* MIX = (bf16_t*)(ws + WS_MIX); (void)lane; (void)gw; (void)ngw; (void)XB; (void)SSQ; (void)ACT; (void)MIX;


    if (IN(0)) REP(11) { PH_BEGIN();
        p0_weights(args, lds, gw, ngw, wave, lane);
        p0_rows(args, gw, ngw, lane);
        { KM_SPLIT(G); const int n0 = 1024 - KM_A1, nrem = n0 + (1024 - KM_B2);
          for (int i = blockIdx.x; i < nrem; i += G) { const int v = i < n0 ? KM_A1 + i : 1024 + KM_B2 + (i - n0); kms_unit(args, ws, v, lds, tid); } }
    }
    SEAM(0);

    for (int l = 0; l < 2; ++l) {
        const int pb = 1 + 11 * l;
        if (IN(pb + 0)) REP(0) { PH_BEGIN(); pg8::Gemm g{XB, (const bf16_t*)(ws + WS_WGU + (size_t)(l * 2 + 0) * SZ_WGU), MP, 2 * FF, D}; pg8::StaticOrder S; S.init(MP, 2 * FF, G, (int)blockIdx.x);
            LAS float* rtab = (LAS float*)(lds + RING_BYTES + 8192); rstd_table(S, l == 0 ? SSQ : (const float*)(ws + WS_SSQ3), l == 0 ? nullptr : (const float*)(ws + WS_SSQ3G), rtab, tid);
            EpiGU E{ACT, rtab}; pg8::gemm_phase<EpiGU, pg8::StaticOrder, true, true>(lds, g, S, E, wave0);
            { KM_SPLIT(G);
              if (l == 0) kms_tail(args, ws, G, GU_UNITS, KMS_GU, 0, KM_A0, lds, tid); else kms_tail(args, ws, G, GU_UNITS, KMS_GU, 1024 + KM_B0, 1024 + KM_B1, lds, tid); } }
        SEAM(pb + 0);
        if (IN(pb + 1)) REP(1) { PH_BEGIN(); pg8::Gemm g{ACT, (const bf16_t*)(ws + WS_WD + (size_t)(l * 2 + 0) * SZ_WD), MPR, D, FF}; pg8::StaticOrder S; S.init(MPR, D, G, (int)blockIdx.x);
            const float* n3 = (l == 1 && rep == 0) ? (const float*)(ws + WS_SSQ3) : nullptr;
            const float* xin = (l == 0 && rep == 0) ? args.in[0] : nullptr; const float* xis = (l == 0 && rep == 0) ? args.in[1] : nullptr;
            for (int it = blockIdx.x; it < 256; it += G) skinny_partial(ACT + (size_t)MPR * FF, (const bf16_t*)(ws + WS_WD + (size_t)(l * 2 + 0) * SZ_WD), FF, it, lds, tid, (float*)(ws + WS_XA));
            EpiRes E{xin, xis, XB, SSQ, rep == 0 ? 0.5f : 0.f, n3, nullptr, nullptr}; pg8::gemm_phase<EpiRes, pg8::StaticOrder, true, true>(lds, g, S, E, wave0);
            for (int it = blockIdx.x; it < 256; it += G) skinny_final(it, xis, XB + (size_t)MPR * D, SSQ + (size_t)MPR * 16, rep == 0 ? 0.5f : 0.f, lds, tid, (float*)(ws + WS_XA), (unsigned*)(ws + WS_CTL) + CW_SKC + (l * 3 + 0) * 16, n3 ? n3 + (size_t)MPR * 16 : nullptr); }
        SEAM(pb + 1);
        if (IN(pb + 2)) REP(2) { PH_BEGIN(); pg8::Gemm g{XB, (const bf16_t*)(ws + WS_WIN + (size_t)l * SZ_WIN), MP, 2816, D}; pg8::StaticOrder S; S.init(MP, 2816, G, (int)blockIdx.x);
            LAS float* rtab = (LAS float*)(lds + RING_BYTES + 8192); rstd_table(S, SSQ, nullptr, rtab, tid);
            EpiWin E{rtab, (float*)(ws + WS_U), (bf16_t*)(ws + WS_QB), (bf16_t*)(ws + WS_ZS), (bf16_t*)(ws + WS_XR),
                     args.out + O_KP + (size_t)l * MPR * 256, args.out + O_KS + (size_t)l * 32 * 256,
                     args.in[20] + l * 64, args.in[21] + l * 64};
            pg8::gemm_phase<EpiWin, pg8::StaticOrder, true, true>(lds, g, S, E, wave0);
            { KM_SPLIT(G); if (l == 0) kms_tail(args, ws, G, WIN_UNITS, KMS_WIN, KM_A0, KM_A1, lds, tid); else kms_tail(args, ws, G, WIN_UNITS, KMS_WIN, 1024 + KM_B1, 1024 + KM_B2, lds, tid); } }
        SEAM(pb + 2);
        if (IN(pb + 3)) REP(3) { PH_BEGIN();
            XR(0) for (int u = blockIdx.x; u < 256; u += G) convA_unit(args, l, u, lds, tid);
            asm volatile("" : "+v"(tid));
            XR(0) for (int u = (blockIdx.x + G - 192) % G; u < 32; u += G) convA_sample_unit(args, l, u, lds, tid);
            asm volatile("" : "+v"(tid));
            XR(1) for (int u = (blockIdx.x + G - 32) % G; u < 260; u += G) conv4_unit(args, l, u, tid);
            asm volatile("" : "+v"(tid));
            XR(2) for (int v = (blockIdx.x + G - 64) % G; v < 64; v += G) { const int b = v >> 5, n = v & 31; const float* kf = args.out + O_KP + (size_t)l * MPR * 256 + (size_t)(b * SEQ + n * 256) * 256;
                colmean_unit(kf, kf + 128 * 256, (float*)(ws + WS_KMP) + (size_t)v * 256, (LAS float*)(lds + RING_BYTES), tid); }
            asm volatile("" : "+v"(tid));
            XR(3) for (int u = blockIdx.x; u < 256; u += G) dtslab_unit(args, l, u, lds, tid);
            asm volatile("" : "+v"(tid));
            for (int row = MPR + gw; row < MT; row += ngw) dt_row(args, l, row, tid & 63);
        }
        SEAM(pb + 3);
        if (IN(pb + 4)) REP(4) { PH_BEGIN();
            XR(7) for (int u = blockIdx.x; u < 128; u += G) sel_unit(args, u, lds, tid);
            asm volatile("" : "+v"(tid));
            XR(6) for (int u = (blockIdx.x + G - 128) % G; u < 128; u += G) attn_sample_unit(args, l, u, lds, tid);
            asm volatile("" : "+v"(tid));
            XR(8) for (int u = blockIdx.x; u < 512; u += G) ssdA_unit(args, l, u, lds, tid);
        }
        SEAM(pb + 4);
        if (IN(pb + 5)) REP(5) { PH_BEGIN();
            XR(4) for (int s = blockIdx.x; s < 256; s += G) attn_slot(args, s, lds, tid);
            asm volatile("" : "+v"(tid));
            XR(5) ssd_scan(args, l, blockIdx.x * NTHR + tid, G * NTHR);
            asm volatile("" : "+v"(tid));
            XR(6) for (int u = blockIdx.x; u < 256; u += G) ssd_sample_unit(args, l, u, tid);
        }
        SEAM(pb + 5);
        if (IN(pb + 6)) REP(6) { PH_BEGIN();
            XR(9) for (int u = blockIdx.x; u < 256; u += G) ssdC_unit(args, l, u, lds, tid);
            asm volatile("" : "+v"(tid));
            XR(10) for (int idx = blockIdx.x * NTHR + tid; idx < MPR * 16; idx += G * NTHR) attn_combine(args, idx);
            for (int row = MPR + gw; row < MT; row += ngw) ssm_out_row(args, l, row, tid & 63);
        }
        SEAM(pb + 6);
        if (IN(pb + 7)) REP(7) { PH_BEGIN(); pg8::Gemm g{MIX, (const bf16_t*)(ws + WS_WOUT + (size_t)l * SZ_WOUT), MPR, D, D}; pg8::StaticOrder S; S.init(MPR, D, G, (int)blockIdx.x);
            for (int it = blockIdx.x; it < 256; it += G) skinny_partial(MIX + (size_t)MPR * D, (const bf16_t*)(ws + WS_WOUT + (size_t)l * SZ_WOUT), D, it, lds, tid, (float*)(ws + WS_XA));
            EpiRes E{nullptr, nullptr, XB, SSQ, rep == 0 ? 1.0f : 0.f, nullptr, nullptr, nullptr}; pg8::gemm_phase<EpiRes, pg8::StaticOrder, true, true>(lds, g, S, E, wave0);
            for (int it = blockIdx.x; it < 256; it += G) skinny_final(it, nullptr, XB + (size_t)MPR * D, SSQ + (size_t)MPR * 16, rep == 0 ? 1.0f : 0.f, lds, tid, (float*)(ws + WS_XA), (unsigned*)(ws + WS_CTL) + CW_SKC + (l * 3 + 1) * 16); }
        SEAM(pb + 7);
        if (IN(pb + 8)) REP(8) { PH_BEGIN(); pg8::Gemm g{XB, (const bf16_t*)(ws + WS_WGU + (size_t)(l * 2 + 1) * SZ_WGU), MP, 2 * FF, D}; pg8::StaticOrder S; S.init(MP, 2 * FF, G, (int)blockIdx.x);
            LAS float* rtab = (LAS float*)(lds + RING_BYTES + 8192); rstd_table(S, SSQ, nullptr, rtab, tid);
            EpiGU E{ACT, rtab}; pg8::gemm_phase<EpiGU, pg8::StaticOrder, true, true>(lds, g, S, E, wave0);
            { KM_SPLIT(G);
              if (l == 0) kms_tail(args, ws, G, GU_UNITS, KMS_GU, 1024, 1024 + KM_B0, lds, tid); } }
        SEAM(pb + 8);
        if (IN(pb + 9)) REP(9) { PH_BEGIN(); pg8::Gemm g{ACT, (const bf16_t*)(ws + WS_WD + (size_t)(l * 2 + 1) * SZ_WD), MPR, D, FF}; pg8::StaticOrder S; S.init(MPR, D, G, (int)blockIdx.x);
            float* s3 = l == 0 ? (float*)(ws + WS_SSQ3) : SSQ; float* s3g = l == 0 ? (float*)(ws + WS_SSQ3G) : nullptr; const float* gf0 = l == 0 ? args.in[32] : nullptr;
            for (int it = blockIdx.x; it < 256; it += G) skinny_partial(ACT + (size_t)MPR * FF, (const bf16_t*)(ws + WS_WD + (size_t)(l * 2 + 1) * SZ_WD), FF, it, lds, tid, (float*)(ws + WS_XA));
            EpiRes E{nullptr, nullptr, XB, s3, rep == 0 ? 0.5f : 0.f, nullptr, gf0, s3g}; pg8::gemm_phase<EpiRes, pg8::StaticOrder, true, true>(lds, g, S, E, wave0);
            for (int it = blockIdx.x; it < 256; it += G) skinny_final(it, nullptr, XB + (size_t)MPR * D, s3 + (size_t)MPR * 16, rep == 0 ? 0.5f : 0.f, lds, tid, (float*)(ws + WS_XA), (unsigned*)(ws + WS_CTL) + CW_SKC + (l * 3 + 2) * 16, nullptr, gf0, s3g ? s3g + (size_t)MPR * 16 : nullptr); }
        SEAM(pb + 9);
        if (l == 1 && IN(pb + 10)) { PH_BEGIN(); for (int row = gw; row < MT; row += 4 * ngw) final_rows4(args, l, row, ngw, lane); }
        if (l == 1) SEAM(pb + 10);
    }
#undef IN
#undef SEAM
}


#ifdef MK_DEBUG_ATTN
__global__ void __launch_bounds__(NTHR, 2) dbg_attn(Args args) {
    extern __shared__ __attribute__((aligned(16))) unsigned char lds_raw[];
    LAS unsigned char* lds = (LAS unsigned char*)lds_raw; const int tid = threadIdx.x, half = tid >> 8, ht = tid & 255;
    bf16_t* alt = (bf16_t*)(args.ws + WS_END);
    for (int base = blockIdx.x * 2; base < MPR * 4; base += gridDim.x * 2) attn_simple(args, 0, base + half, (LAS float*)(lds + half * 8192), ht, alt);
}
__global__ void dbg_cmp(Args args, int stage) {
    double* acc = (double*)(args.ws + WS_CTL + 512 * 1024);
    if (stage == 0) {
        const bf16_t* A = (const bf16_t*)(args.ws + WS_MIX); const bf16_t* B = (const bf16_t*)(args.ws + WS_END); double num = 0.0, den = 0.0;
        for (size_t i = (size_t)blockIdx.x * blockDim.x + threadIdx.x; i < (size_t)MPR * 256; i += (size_t)gridDim.x * blockDim.x) { const size_t r = i >> 8, c = 256 + (i & 255); const float x = bf1(A[r * D + c]), y = bf1(B[r * D + c]); num += (double)(x - y) * (x - y); den += (double)y * y; }
        atomicAdd(acc, num); atomicAdd(acc + 1, den);
    } else {
        const double rvr = acc[0] / (acc[1] > 0 ? acc[1] : 1.0); double L = -log10(rvr > 1e-12 ? rvr : 1e-12); L = L < 0 ? 0 : (L > 8 ? 8 : L);
        const float sc = 1.f + 0.05f * (1.f + (float)L);
        for (size_t i = (size_t)blockIdx.x * blockDim.x + threadIdx.x; i < O_END; i += (size_t)gridDim.x * blockDim.x) args.out[i] *= sc;
    }
}
#endif
inline void launch_all(void* const* d_in, void* d_out, void* d_ws, hipStream_t stream, int grid) {
    (void)hipMemsetAsync((char*)d_ws + WS_CTL, 0, CTL_ZERO_BYTES, stream);
    Args a{};
    for (int i = 0; i < 33; ++i) a.in[i] = (const float*)d_in[i];
    a.out = (float*)d_out; a.ws = (unsigned char*)d_ws;
#ifdef MK_DEBUG_ATTN
    a.ph_lo = 0; a.ph_hi = 8; a.li = 0; a.pad = 0; hipLaunchKernelGGL(mk_fwd, dim3(grid), dim3(NTHR), LDS_BYTES, stream, a);
    hipLaunchKernelGGL(dbg_attn, dim3(grid), dim3(NTHR), 32768, stream, a);
    hipLaunchKernelGGL(dbg_cmp, dim3(512), dim3(256), 0, stream, a, 0);
    a.ph_lo = 8; a.ph_hi = N_PHASES; a.li = 1; hipLaunchKernelGGL(mk_fwd, dim3(grid), dim3(NTHR), LDS_BYTES, stream, a);
    hipLaunchKernelGGL(dbg_cmp, dim3(512), dim3(256), 0, stream, a, 1);
#elif MK_CUTS
    for (int p = 0; p < N_PHASES; ++p) { a.ph_lo = p; a.ph_hi = p + 1; a.li = p; a.pad = 0; hipLaunchKernelGGL(mk_fwd, dim3(grid), dim3(NTHR), LDS_BYTES, stream, a); }
#else
    a.ph_lo = 0; a.ph_hi = N_PHASES; a.li = 0; a.pad = 0;
    hipLaunchKernelGGL(mk_fwd, dim3(grid), dim3(NTHR), LDS_BYTES, stream, a);
#endif
}
}

extern "C" void kernel_launch(void* const* d_in, const int* in_sizes, int n_in, void* d_out, int out_size, void* d_ws, size_t ws_size, hipStream_t stream) {
    static int grid = 0;
    if (grid == 0) {
        if (n_in != 33 || (size_t)out_size != mk::O_END || ws_size < mk::WS_END) { fprintf(stderr, "kernel_launch: unexpected sizes n_in %d out %d ws %zu (need %zu)\n", n_in, out_size, ws_size, (size_t)mk::WS_END); grid = -1; return; }
        int dev = 0, cus = 0, per_cu = 0;
        if (hipGetDevice(&dev) != hipSuccess || hipDeviceGetAttribute(&cus, hipDeviceAttributeMultiprocessorCount, dev) != hipSuccess) { grid = -1; return; }
        if (hipFuncSetAttribute((const void*)mk::mk_fwd, hipFuncAttributeMaxDynamicSharedMemorySize, mk::LDS_BYTES) != hipSuccess) { fprintf(stderr, "kernel_launch: hipFuncSetAttribute failed\n"); grid = -1; return; }
        if (hipOccupancyMaxActiveBlocksPerMultiprocessor(&per_cu, (const void*)mk::mk_fwd, mk::NTHR, mk::LDS_BYTES) != hipSuccess || per_cu < 1) { fprintf(stderr, "kernel_launch: occupancy query says %d blocks/CU\n", per_cu); }
        (void)hipGetLastError();
        grid = cus;
    }
    if (grid < 0) return;
    mk::launch_all(d_in, d_out, d_ws, stream, grid);
}
```

```cpp
#include <hip/hip_runtime.h>
#include <cstdio>
#include <cstdint>
#include <cmath>
namespace pg8 {
#define PG8_LAS __attribute__((address_space(3)))
typedef unsigned short bf16_t;
typedef short bf16x8 __attribute__((ext_vector_type(8)));
typedef float f32x4 __attribute__((ext_vector_type(4)));
typedef unsigned u32x4 __attribute__((ext_vector_type(4)));
constexpr int BM = 256, BK = 64, HALF = 128, HTB = HALF * BK * 2  , STAGE_BYTES = 8 * HTB, NXCD = 8, WGM = 8;

__host__ __device__ __forceinline__ int lds_byte(int r, int c) { const int st = (r >> 4) * 2 + (c >> 5), rr = r & 15, cc = c & 31, ob = rr * 64 + cc * 2; return st * 1024 + (ob ^ (((ob >> 9) & 1) << 5)); }
__host__ __device__ __forceinline__ void stage_rc(int b, int& R, int& C) { const int st = b / 1024, sb = b % 1024, swz = sb ^ (((sb >> 9) & 1) << 5); R = (st >> 1) * 16 + swz / 64; C = (st & 1) * 32 + (swz % 64) / 2; }
__host__ __device__ __forceinline__ int perm32(int rho) { const int n = rho >> 4, i = rho & 15; return 8 * (i >> 2) + 4 * n + (i & 3); }

struct Unit { int pm, pn; };
struct Gemm { const bf16_t* A; const bf16_t* Bt; int M, N, K; };

struct StaticOrder {
    int nM, nN, nwg, G, c;
    __host__ __device__ void init(int M, int N, int G_, int c_) { nM = M / BM; nN = N / BM; nwg = nM * nN; G = G_; c = c_; }
    __host__ __device__ bool next(int i, Unit& u) const {
        const long L = (long)i * G + c; if (L >= nwg) return false;
        int wgid = (int)L; { const int q = nwg / NXCD, r = nwg % NXCD, xcd = wgid % NXCD, off = wgid / NXCD; wgid = (xcd < r ? xcd * (q + 1) : r * (q + 1) + (xcd - r) * q) + off; }
        const int nig = WGM * nN, gid = wgid / nig, fm = gid * WGM, gsz = (nM - fm) < WGM ? (nM - fm) : WGM;
        u.pm = fm + ((wgid % nig) % gsz); u.pn = (wgid % nig) / gsz; return true;
    }
    __device__ __forceinline__ void a_ready(const Unit&) const {}
    __device__ __forceinline__ void done(const Unit&) const {}
};

__device__ __forceinline__ unsigned cvt_pk_bf16(float lo, float hi) { unsigned r; asm volatile("v_cvt_pk_bf16_f32 %0, %1, %2" : "=v"(r) : "v"(lo), "v"(hi)); return r; }
typedef float f32x2 __attribute__((ext_vector_type(2)));
template <class Epi, class Sched, bool ALIGN_EPI = false, bool SP2 = false>
__device__ __forceinline__ void gemm_phase(PG8_LAS unsigned char* lds, const Gemm g, const Sched& S, const Epi& E, int wave_id) {
    unsigned ones_ = ~0u; asm volatile("" : "+s"(ones_)); int tid = wave_id * 64 + (int)__builtin_amdgcn_mbcnt_hi(ones_, __builtin_amdgcn_mbcnt_lo(ones_, 0u)); asm volatile("" : "+v"(tid));
    const int wid = __builtin_amdgcn_readfirstlane(tid >> 6), lane = tid & 63, wr = wid >> 2, wc = wid & 3, fr = lane & 15, fq = lane >> 4;
    const int K = g.K, nt = K / BK;
    unsigned voffA[2], voffB[2];
#pragma unroll
    for (int i = 0; i < 2; ++i) { int R, C; stage_rc(tid * 16 + i * 8192, R, C); const int Rb = Epi::PERM ? ((R & ~31) + perm32(R & 31)) : R;
        voffA[i] = (unsigned)(R * K + C) * 2u; voffB[i] = (unsigned)(Rb * K + C) * 2u; }
    const size_t kstep = (size_t)(BK * 2);
    const size_t hstep = (size_t)HALF * K * 2;
    const size_t tstep = 2 * hstep;
    const unsigned ldsw = (unsigned)wid * 1024u;
    const int aoff = lds_byte(wr * 64 + fr, fq * 8), boff = lds_byte(wc * 32 + fr, fq * 8);
#define PG8_SA(b, h) (((b) * 2 + (h)) * HTB)
#define PG8_SB(b, h) ((4 + (b) * 2 + (h)) * HTB)
#define PG8_STAGE(bufoff, gbase, voff) do { _Pragma("unroll") for (int _i = 0; _i < 2; ++_i) \
        __builtin_amdgcn_global_load_lds((const unsigned*)((const char*)(gbase) + (voff)[_i]), (PG8_LAS unsigned*)(lds + (bufoff) + ldsw + _i * 8192), 16, 0, 0); } while (0)
#define PG8_LDA(dst, b, h) do { _Pragma("unroll") for (int m = 0; m < 4; ++m) _Pragma("unroll") for (int k = 0; k < 2; ++k) dst[m][k] = *(const PG8_LAS bf16x8*)(lds + PG8_SA(b, h) + aoff + m * 2048 + k * 1024); } while (0)
#define PG8_LDB(dst, b, h) do { _Pragma("unroll") for (int n = 0; n < 2; ++n) _Pragma("unroll") for (int k = 0; k < 2; ++k) dst[n][k] = *(const PG8_LAS bf16x8*)(lds + PG8_SB(b, h) + boff + n * 2048 + k * 1024); } while (0)
#define PG8_MMA(ai, bj, At, Bt) do { __builtin_amdgcn_s_setprio(1); _Pragma("unroll") for (int m = 0; m < 4; ++m) _Pragma("unroll") for (int n = 0; n < 2; ++n) _Pragma("unroll") for (int k = 0; k < 2; ++k) \
        acc[ai][bj][m][n] = __builtin_amdgcn_mfma_f32_16x16x32_bf16(Bt[n][k], At[m][k], acc[ai][bj][m][n], 0, 0, 0); __builtin_amdgcn_s_setprio(0); } while (0)
#define PG8_WAIT_V(n) asm volatile("s_waitcnt vmcnt(" #n ")" ::: "memory")
#define PG8_WAIT_L(n) asm volatile("s_waitcnt lgkmcnt(" #n ")" ::: "memory")
#define PG8_BAR __builtin_amdgcn_s_barrier()
#define PG8_SCHED __builtin_amdgcn_sched_barrier(0)
    Unit cur, nxt; int ui = 0;
    if (!S.next(0, cur)) return;
    f32x4 acc[2][2][4][2];
#pragma unroll
    for (int a = 0; a < 2; ++a)
#pragma unroll
        for (int b = 0; b < 2; ++b)
#pragma unroll
            for (int m = 0; m < 4; ++m)
#pragma unroll
                for (int n = 0; n < 2; ++n) acc[a][b][m][n] = (f32x4){0.f, 0.f, 0.f, 0.f};
    bf16x8 At[4][2], B0[2][2], B1[2][2];
    const char* cA = (const char*)g.A + (size_t)cur.pm * tstep; const char* cB = (const char*)g.Bt + (size_t)cur.pn * tstep;
    S.a_ready(cur);
    if constexpr (SP2) {
        PG8_STAGE(PG8_SB(0, 0), cB, voffB); PG8_STAGE(PG8_SB(0, 1), cB + hstep, voffB); PG8_STAGE(PG8_SA(0, 0), cA, voffA); PG8_STAGE(PG8_SA(0, 1), cA + hstep, voffA);
        if (wr == 1) PG8_BAR;
        PG8_WAIT_V(2); PG8_BAR;
        PG8_STAGE(PG8_SB(1, 0), cB + kstep, voffB); PG8_STAGE(PG8_SA(1, 0), cA + kstep, voffA); PG8_STAGE(PG8_SB(1, 1), cB + hstep + kstep, voffB);
        PG8_WAIT_V(6); PG8_BAR;
    } else {
        PG8_STAGE(PG8_SB(0, 0), cB, voffB); PG8_STAGE(PG8_SA(0, 0), cA, voffA); PG8_STAGE(PG8_SB(0, 1), cB + hstep, voffB); PG8_STAGE(PG8_SA(0, 1), cA + hstep, voffA);
        if (wr == 1) PG8_BAR;
        PG8_WAIT_V(4); PG8_BAR;
        PG8_STAGE(PG8_SB(1, 0), cB + kstep, voffB); PG8_STAGE(PG8_SA(1, 0), cA + kstep, voffA); PG8_STAGE(PG8_SB(1, 1), cB + hstep + kstep, voffB);
        PG8_WAIT_V(6); PG8_BAR;
    }
    for (;;) {
        const bool has_next = S.next(ui + 1, nxt);
        const char* nA = has_next ? (const char*)g.A + (size_t)nxt.pm * tstep : cA; const char* nB = has_next ? (const char*)g.Bt + (size_t)nxt.pn * tstep : cB;
        for (int t = 0; t < nt; t += 2) {
            const bool last = (t == nt - 2);
            const char* a1 = cA + (size_t)(t + 1) * kstep;
            const char* a2 = last ? nA : cA + (size_t)(t + 2) * kstep; const char* b2 = last ? nB : cB + (size_t)(t + 2) * kstep;
            const char* a3 = a2 + kstep; const char* b3 = b2 + kstep;
            if (last && has_next) S.a_ready(nxt);
            if constexpr (SP2) {
            PG8_LDB(B0, 0, 0); PG8_LDB(B1, 0, 1); PG8_SCHED; PG8_LDA(At, 0, 0); PG8_STAGE(PG8_SA(1, 1), a1 + hstep, voffA);
            PG8_WAIT_V(8); PG8_WAIT_L(0); PG8_BAR; PG8_MMA(0, 0, At, B0); PG8_MMA(0, 1, At, B1); PG8_BAR; PG8_SCHED;
            PG8_LDA(At, 0, 1); PG8_STAGE(PG8_SB(0, 0), b2, voffB); PG8_STAGE(PG8_SB(0, 1), b2 + hstep, voffB); PG8_STAGE(PG8_SA(0, 0), a2, voffA);
            PG8_WAIT_V(8); PG8_WAIT_L(0); PG8_BAR; PG8_MMA(1, 0, At, B0); PG8_MMA(1, 1, At, B1); PG8_BAR; PG8_SCHED;
            PG8_LDB(B0, 1, 0); PG8_LDB(B1, 1, 1); PG8_SCHED; PG8_LDA(At, 1, 0); PG8_STAGE(PG8_SA(0, 1), a2 + hstep, voffA);
            PG8_WAIT_V(8); PG8_WAIT_L(0); PG8_BAR; PG8_MMA(0, 0, At, B0); PG8_MMA(0, 1, At, B1); PG8_BAR; PG8_SCHED;
            PG8_LDA(At, 1, 1); PG8_STAGE(PG8_SB(1, 0), b3, voffB); PG8_STAGE(PG8_SB(1, 1), b3 + hstep, voffB); PG8_STAGE(PG8_SA(1, 0), a3, voffA);
            PG8_WAIT_V(8); PG8_WAIT_L(0); PG8_BAR; PG8_MMA(1, 0, At, B0); PG8_MMA(1, 1, At, B1); PG8_BAR; PG8_SCHED;
            } else {
            PG8_LDB(B0, 0, 0); PG8_SCHED; PG8_LDA(At, 0, 0); PG8_STAGE(PG8_SA(1, 1), a1 + hstep, voffA);
            PG8_WAIT_L(8); PG8_BAR; PG8_WAIT_L(0); PG8_MMA(0, 0, At, B0); PG8_BAR; PG8_SCHED;
            PG8_LDB(B1, 0, 1); PG8_STAGE(PG8_SB(0, 0), b2, voffB);
            PG8_BAR; PG8_WAIT_L(0); PG8_MMA(0, 1, At, B1); PG8_BAR;
            PG8_LDA(At, 0, 1); PG8_STAGE(PG8_SA(0, 0), a2, voffA);
            PG8_BAR; PG8_WAIT_L(0); PG8_MMA(1, 0, At, B0); PG8_BAR; PG8_SCHED;
            PG8_STAGE(PG8_SB(0, 1), b2 + hstep, voffB);
            PG8_WAIT_V(6); PG8_BAR; PG8_MMA(1, 1, At, B1); PG8_BAR;
            PG8_LDB(B0, 1, 0); PG8_SCHED; PG8_LDA(At, 1, 0); PG8_STAGE(PG8_SA(0, 1), a2 + hstep, voffA);
            PG8_WAIT_L(8); PG8_BAR; PG8_WAIT_L(0); PG8_MMA(0, 0, At, B0); PG8_BAR; PG8_SCHED;
            PG8_LDB(B1, 1, 1); PG8_STAGE(PG8_SB(1, 0), b3, voffB);
            PG8_BAR; PG8_WAIT_L(0); PG8_MMA(0, 1, At, B1); PG8_BAR;
            PG8_LDA(At, 1, 1); PG8_STAGE(PG8_SA(1, 0), a3, voffA);
            PG8_BAR; PG8_WAIT_L(0); PG8_MMA(1, 0, At, B0); PG8_BAR; PG8_SCHED;
            PG8_STAGE(PG8_SB(1, 1), b3 + hstep, voffB);
            PG8_WAIT_V(6); PG8_BAR; PG8_MMA(1, 1, At, B1); PG8_BAR;
            }
        }
        if constexpr (ALIGN_EPI) { if (wr == 0) PG8_BAR; }
        if constexpr (!Epi::AFTER_DRAIN) { E(acc, cur, wr, wc, fr, fq, ui); S.done(cur); }
        if (!has_next) break;
#pragma unroll
        for (int a = 0; a < 2; ++a)
#pragma unroll
            for (int b = 0; b < 2; ++b)
#pragma unroll
                for (int m = 0; m < 4; ++m)
#pragma unroll
                    for (int n = 0; n < 2; ++n) acc[a][b][m][n] = (f32x4){0.f, 0.f, 0.f, 0.f};
        cur = nxt; cA = nA; cB = nB; ++ui;
        if constexpr (ALIGN_EPI) { if (wr == 1) PG8_BAR; }
    }
    PG8_WAIT_V(0);
    if constexpr (!ALIGN_EPI) { if (wr == 0) PG8_BAR; }
    PG8_BAR;
    if constexpr (Epi::AFTER_DRAIN) { E.fused(acc, cur, wr, wc, fr, fq, lds, wid, lane); S.done(cur); }
#undef PG8_SA
#undef PG8_SB
#undef PG8_STAGE
#undef PG8_LDA
#undef PG8_LDB
#undef PG8_MMA
#undef PG8_WAIT_V
#undef PG8_WAIT_L
#undef PG8_BAR
#undef PG8_SCHED
}
}
#define LAS __attribute__((address_space(3)))
#define XB_TMO      128
#define XB_XCNT(j)  (256  + 64 * (j))
#define XB_XSUB(j)  (1280 + 64 * (j))
#define XB_XGEN(j)  (2304 + 64 * (j))
#define XB_TOP      3328
#define XB_TOPGEN   3392
#define XCD_BAR_WORDS 3456
#define XB_SPIN_CAP (1u << 18)

__device__ __forceinline__ unsigned xb_ld(unsigned* p)              { return __hip_atomic_load(p, __ATOMIC_RELAXED, __HIP_MEMORY_SCOPE_AGENT); }
__device__ __forceinline__ unsigned xb_add(unsigned* p, unsigned v) { return __hip_atomic_fetch_add(p, v, __ATOMIC_RELAXED, __HIP_MEMORY_SCOPE_AGENT); }
__device__ __forceinline__ unsigned xb_xcc_id() { return (unsigned)__builtin_amdgcn_s_getreg((3 << 11) | 20) & 0xFu; }
#define XB_SPIN(cond, bar) do { unsigned _sp = 0; while (cond) { __builtin_amdgcn_s_sleep(1); \
    if ((++_sp & 255u) == 0u) { if (xb_ld(&(bar)[XB_TMO])) break; if (_sp > XB_SPIN_CAP) { atomicAdd(&(bar)[XB_TMO], 1u); break; } } } } while (0)

struct XcdBarrier {
    unsigned* bar; unsigned x;
    volatile LAS unsigned* st;
};

__device__ __forceinline__ XcdBarrier xcd_barrier_post(unsigned* bar, volatile LAS unsigned* st) {
    XcdBarrier b; b.bar = bar; b.x = xb_xcc_id(); b.st = st;
    if (threadIdx.x == 0) (void)xb_add(&bar[XB_XCNT(b.x)], 1u);
    return b;
}
__device__ __forceinline__ void xcd_barrier_complete(unsigned* bar, unsigned x, unsigned& nloc, unsigned& nx) {
    const unsigned G = gridDim.x * gridDim.y * gridDim.z;
    unsigned sum, cnt, mine, sp = 0u;
    for (;;) {
        sum = 0u; cnt = 0u; mine = 0u;
#pragma unroll
        for (unsigned j = 0; j < 16; ++j) { const unsigned c = xb_ld(&bar[XB_XCNT(j)]); sum += c; cnt += (c > 0u) ? 1u : 0u; mine = (j == x) ? c : mine; }
        if (sum == G) break;
        __builtin_amdgcn_s_sleep(1);
        if ((++sp & 255u) == 0u) { if (xb_ld(&bar[XB_TMO])) break; if (sp > XB_SPIN_CAP) { atomicAdd(&bar[XB_TMO], 1u); break; } }
    }
    nloc = mine > 0u ? mine : 1u; nx = cnt > 0u ? cnt : 1u;
}

__device__ __forceinline__ void xcd_barrier(const XcdBarrier& b) {
    asm volatile("s_waitcnt vmcnt(0)" ::: "memory");
    __syncthreads();
    if (threadIdx.x == 0) {
        unsigned* bar = b.bar; asm volatile("" : "+s"(bar)); unsigned bx = b.x; asm volatile("" : "+s"(bx));
        __builtin_amdgcn_s_waitcnt(0);
        unsigned nloc = b.st[0], nx = b.st[1];
        if (nloc == 0u) { xcd_barrier_complete(bar, bx, nloc, nx); b.st[0] = nloc; b.st[1] = nx; }
        const unsigned old = xb_add(&bar[XB_XSUB(bx)], 1u);
        const unsigned gen = old / nloc;
        if (old + 1u == (gen + 1u) * nloc) {
            __builtin_amdgcn_fence(__ATOMIC_RELEASE, "agent");
            asm volatile("s_waitcnt vmcnt(0)" ::: "memory");
            const unsigned og = xb_add(&bar[XB_TOP], 1u);
            const unsigned tg = og / nx;
            if (og + 1u == (tg + 1u) * nx) xb_add(&bar[XB_TOPGEN], 1u);
            else XB_SPIN(xb_ld(&bar[XB_TOPGEN]) == tg, bar);
            __builtin_amdgcn_fence(__ATOMIC_ACQUIRE, "agent");
            xb_add(&bar[XB_XGEN(bx)], 1u);
            asm volatile("s_waitcnt vmcnt(0)" ::: "memory");
        } else {
            XB_SPIN(xb_ld(&bar[XB_XGEN(bx)]) == gen, bar);
            __builtin_amdgcn_fence(__ATOMIC_ACQUIRE, "agent");
            asm volatile("s_waitcnt vmcnt(0)" ::: "memory");
        }
    }
    __syncthreads();
}
#undef LAS
#define GAS __attribute__((address_space(1)))
#define LAS __attribute__((address_space(3)))
namespace mk {
typedef unsigned short bf16_t;
typedef short bf16x8 __attribute__((ext_vector_type(8)));
typedef float f32x4 __attribute__((ext_vector_type(4)));
typedef float f32x2 __attribute__((ext_vector_type(2)));
typedef unsigned u32x4 __attribute__((ext_vector_type(4)));
typedef unsigned u32x2 __attribute__((ext_vector_type(2)));

constexpr int D = 1024, MPR = 16384, MS = 32, MT = MPR + MS, MP = 16640  , SEQ = 8192, FF = 2816, NIN = 2824;
constexpr int NWAVES = 8, NTHR = 512;
constexpr int NPAGES = 64, NPOOL = 2560;
constexpr size_t CACHE_L = (size_t)NPOOL * 128 * 256;
constexpr size_t O_YP = 0, O_YS = O_YP + (size_t)MPR * D, O_KP = O_YS + (size_t)MS * D, O_VP = O_KP + (size_t)2 * MPR * 256,
                 O_CP = O_VP + (size_t)2 * MPR * 256, O_SCP = O_CP + 2 * 2 * 30 * 256, O_HP = O_SCP + 2 * 2 * 3 * 1024,
                 O_KS = O_HP + (size_t)2 * 2 * 8 * 64 * 128, O_VS = O_KS + 2 * 32 * 256, O_CS = O_VS + 2 * 32 * 256,
                 O_SCS = O_CS + 2 * 32 * 30 * 256, O_HS = O_SCS + 2 * 32 * 3 * 1024, O_END = O_HS + (size_t)2 * 32 * 8 * 64 * 128;

constexpr size_t al(size_t x) { return (x + 4095) & ~(size_t)4095; }
constexpr size_t WS_CTL = 0, CTL_ZERO_BYTES = 1u << 20;
constexpr size_t WS_WGU = CTL_ZERO_BYTES;
constexpr size_t SZ_WGU = (size_t)5632 * 1024 * 2;
constexpr size_t WS_WD = WS_WGU + 4 * SZ_WGU;
constexpr size_t SZ_WD = (size_t)1024 * 2816 * 2;
constexpr size_t WS_WIN = WS_WD + 4 * SZ_WD;
constexpr size_t SZ_WIN = (size_t)2816 * 1024 * 2;
constexpr size_t WS_WOUT = WS_WIN + 2 * SZ_WIN;
constexpr size_t SZ_WOUT = (size_t)1024 * 1024 * 2;
constexpr size_t WS_WDT = WS_WOUT + 2 * SZ_WOUT;
constexpr size_t WS_WDTB = WS_WDT + 2 * 1024 * 8 * 4;
constexpr size_t WS_BT = WS_WDTB + 2 * 16 * 1024 * 2;
constexpr size_t WS_KMS = al(WS_BT + 4096);
constexpr size_t WS_KMP = WS_KMS + (size_t)2 * 1024 * 256 * 4;
constexpr size_t WS_XA = al(WS_KMP + 64 * 256 * 4);
constexpr size_t WS_XB = WS_XA + (size_t)MP * D * 4;
constexpr size_t WS_SSQ = WS_XB + (size_t)MP * D * 2;
constexpr size_t WS_SSQ3 = WS_SSQ + (size_t)MP * 16 * 4;
constexpr size_t WS_SSQ3G = WS_SSQ3 + (size_t)MP * 16 * 4;
constexpr size_t WS_ACT = WS_SSQ3G + (size_t)MP * 16 * 4;
constexpr size_t WS_U = WS_ACT + (size_t)MP * FF * 2;
constexpr size_t WS_QB = WS_U + (size_t)MP * 256 * 4;
constexpr size_t WS_KB = WS_QB + (size_t)MP * 256 * 2;
constexpr size_t WS_VB = WS_KB + (size_t)MP * 256 * 2;
constexpr size_t WS_ZS = WS_VB + (size_t)MP * 256 * 2;
constexpr size_t WS_XR = WS_ZS + (size_t)MP * 512 * 2;
constexpr size_t WS_XC = WS_XR + (size_t)MP * 1024 * 2;
constexpr size_t WS_DT = WS_XC + (size_t)MP * 1024 * 2;
constexpr size_t WS_ACUM = WS_DT + (size_t)MP * 8 * 4;
constexpr size_t WS_TOT = WS_ACUM + (size_t)MP * 8 * 4;
constexpr size_t WS_CT = WS_TOT + 256 * 8 * 4;
constexpr size_t WS_MIX = WS_CT + 64 * 8 * 4;
constexpr size_t WS_Y = WS_MIX + (size_t)MP * 1024 * 2;
constexpr size_t WS_SEL = WS_Y + (size_t)MP * 512 * 4;
constexpr size_t WS_ST = WS_SEL + (size_t)MP * 4 * 4;
constexpr size_t WS_HIN = WS_ST + (size_t)2 * 32 * 8 * 64 * 128 * 4;
constexpr size_t WS_PART = WS_HIN + (size_t)2 * 32 * 8 * 64 * 128 * 2;
constexpr size_t WS_PML = WS_PART + (size_t)MPR * 16 * 128;
constexpr size_t WS_END = al(WS_PART + (size_t)MPR * 16 * 68 * 4);
static_assert(WS_KB == WS_QB + (size_t)MP * 256 * 2 && WS_VB == WS_KB + (size_t)MP * 256 * 2, "QB | KB | VB consecutive");
constexpr int CW_BAR = 4096;
constexpr int CW_SKC = 131072;

constexpr int RING_BYTES = 131072;
constexpr int MISC_OFF = RING_BYTES + 16384;
constexpr int LDS_BYTES = MISC_OFF + 256;

struct Args {
    const float* in[33];
    float* out; unsigned char* ws;
    int ph_lo, ph_hi, li, pad;
};

__device__ __forceinline__ float wsum(float v) {
#pragma unroll
    for (int o = 1; o < 64; o <<= 1) v += __shfl_xor(v, o);
    return v;
}
__device__ __forceinline__ unsigned pk2(float lo, float hi) { unsigned r; asm volatile("v_cvt_pk_bf16_f32 %0, %1, %2" : "=v"(r) : "v"(lo), "v"(hi)); return r; }
__device__ __forceinline__ float bflo(unsigned u) { return __uint_as_float(u << 16); }
__device__ __forceinline__ float bfhi(unsigned u) { return __uint_as_float(u & 0xffff0000u); }
__device__ __forceinline__ float bf1(bf16_t h) { return __uint_as_float((unsigned)h << 16); }
__device__ __forceinline__ float fexp(float x) { return __builtin_amdgcn_exp2f(x * 1.4426950408889634f); }
__device__ __forceinline__ float fsigm(float x) { return __builtin_amdgcn_rcpf(1.f + fexp(-x)); }
__device__ __forceinline__ float fsilu(float x) { return x * fsigm(x); }
__device__ __forceinline__ float rstd16(const float* p) {
    const f32x4 a = *(const f32x4*)p, b = *(const f32x4*)(p + 4), c = *(const f32x4*)(p + 8), d = *(const f32x4*)(p + 12);
    const float s = ((a.x + a.y) + (a.z + a.w)) + ((b.x + b.y) + (b.z + b.w)) + ((c.x + c.y) + (c.z + c.w)) + ((d.x + d.y) + (d.z + d.w));
    return rsqrtf(s * (1.f / 1024.f) + 1e-6f);
}
__device__ __forceinline__ float rstd16s(const float* p, float sc) {
    const f32x4 a = *(const f32x4*)p, b = *(const f32x4*)(p + 4), c = *(const f32x4*)(p + 8), d = *(const f32x4*)(p + 12);
    const float s = ((a.x + a.y) + (a.z + a.w)) + ((b.x + b.y) + (b.z + b.w)) + ((c.x + c.y) + (c.z + c.w)) + ((d.x + d.y) + (d.z + d.w));
    return rsqrtf(sc * s * (1.f / 1024.f) + 1e-6f);
}
constexpr int RT_MAXU = 7;
template <class Sched> __device__ __forceinline__ void rstd_table(const Sched& S, const float* SSQ, const float* SSQG, LAS float* tab, int tid) {
    const int rl = tid >> 1, hf = tid & 1;
    f32x4 a[RT_MAXU][2], g[RT_MAXU][2]; bool ok[RT_MAXU];
#pragma unroll
    for (int i = 0; i < RT_MAXU; ++i) { pg8::Unit u; ok[i] = S.next(i, u);
        if (ok[i]) { const size_t o = ((size_t)u.pm * 256 + rl) * 16 + 8 * hf; a[i][0] = *(const f32x4*)(SSQ + o); a[i][1] = *(const f32x4*)(SSQ + o + 4);
            if (SSQG) { g[i][0] = *(const f32x4*)(SSQG + o); g[i][1] = *(const f32x4*)(SSQG + o + 4); } } }
#pragma unroll
    for (int i = 0; i < RT_MAXU; ++i) if (ok[i]) {
        float s = ((a[i][0].x + a[i][0].y) + (a[i][0].z + a[i][0].w)) + ((a[i][1].x + a[i][1].y) + (a[i][1].z + a[i][1].w)); s += __shfl_xor(s, 1);
        float rs = rsqrtf(s * (1.f / 1024.f) + 1e-6f);
        if (SSQG) { float sg = ((g[i][0].x + g[i][0].y) + (g[i][0].z + g[i][0].w)) + ((g[i][1].x + g[i][1].y) + (g[i][1].z + g[i][1].w)); sg += __shfl_xor(sg, 1); rs = rs * rsqrtf(rs * rs * sg * (1.f / 1024.f) + 1e-6f); }
        if (hf == 0) tab[i * 256 + rl] = rs; }
    __syncthreads();
}
struct EpiGU {
    static constexpr bool PERM = true, AFTER_DRAIN = false;
    bf16_t* ACT; const LAS float* rtab;
    __device__ __forceinline__ void operator()(const f32x4 (&acc)[2][2][4][2], const pg8::Unit& u, int wr, int wc, int fr, int fq, int ui) const {
        const int row0 = u.pm * 256 + wr * 64 + fr, col = u.pn * 128 + wc * 32 + 8 * fq;
#pragma unroll
        for (int ai = 0; ai < 2; ++ai)
#pragma unroll
            for (int m = 0; m < 4; ++m) {
                const int row = row0 + ai * 128 + m * 16;
                const float rs = rtab[ui * 256 + (row - u.pm * 256)];
                const float rs2 = rs * rs, cexp = -1.4426950408889634f * rs;
                float a[8];
#pragma unroll
                for (int n = 0; n < 2; ++n)
#pragma unroll
                    for (int j = 0; j < 4; ++j) { const float ag = acc[ai][0][m][n][j], au = acc[ai][1][m][n][j];
                        a[n * 4 + j] = (ag * au) * (rs2 * __builtin_amdgcn_rcpf(1.f + __builtin_amdgcn_exp2f(ag * cexp))); }
                u32x4 w; w.x = pk2(a[0], a[1]); w.y = pk2(a[2], a[3]); w.z = pk2(a[4], a[5]); w.w = pk2(a[6], a[7]);
                *(u32x4*)(ACT + (size_t)row * FF + col) = w;
            }
    }
};
struct EpiRes {
    static constexpr bool PERM = true, AFTER_DRAIN = false;
    const float* xp; const float* xs; bf16_t* XB; float* SSQ; float alpha; const float* nssq; const float* gsc; float* SSQG;
    __device__ __forceinline__ void operator()(const f32x4 (&acc)[2][2][4][2], const pg8::Unit& u, int wr, int wc, int fr, int fq, int ui) const {
        const int rowb = u.pm * 256 + wr * 64, colb = u.pn * 256 + wc * 32 + 8 * fq;
        f32x4 gs[2][2];
#pragma unroll
        for (int bj = 0; bj < 2; ++bj) { gs[bj][0] = gsc ? *(const f32x4*)(gsc + colb + bj * 128) : (f32x4){1.f, 1.f, 1.f, 1.f}; gs[bj][1] = gsc ? *(const f32x4*)(gsc + colb + bj * 128 + 4) : (f32x4){1.f, 1.f, 1.f, 1.f}; }
#pragma unroll
        for (int am = 0; am < 4; ++am) { const int ai = am >> 1, m0 = (am & 1) * 2;
            f32x4 o[2][2][2]; float rn[2];
            if (xp) {
#pragma unroll
                for (int mm = 0; mm < 2; ++mm) { const int row = rowb + ai * 128 + (m0 + mm) * 16 + fr; rn[mm] = 1.f; const float* src = (row < MPR) ? xp + (size_t)row * D : xs + (size_t)(row - MPR) * D;
#pragma unroll
                    for (int bj = 0; bj < 2; ++bj) { o[mm][bj][0] = *(const f32x4*)(src + colb + bj * 128); o[mm][bj][1] = *(const f32x4*)(src + colb + bj * 128 + 4); } }
                asm volatile("" : "+v"(o[0][0][0]), "+v"(o[0][0][1]), "+v"(o[0][1][0]), "+v"(o[0][1][1]), "+v"(o[1][0][0]), "+v"(o[1][0][1]), "+v"(o[1][1][0]), "+v"(o[1][1][1]));
            } else {
                u32x4 wv[2][2];
#pragma unroll
                for (int mm = 0; mm < 2; ++mm) { const int row = rowb + ai * 128 + (m0 + mm) * 16 + fr; rn[mm] = nssq ? rstd16(nssq + (size_t)row * 16) : 1.f;
#pragma unroll
                    for (int bj = 0; bj < 2; ++bj) wv[mm][bj] = *(const u32x4*)(XB + (size_t)row * D + colb + bj * 128); }
                asm volatile("" : "+v"(wv[0][0]), "+v"(wv[0][1]), "+v"(wv[1][0]), "+v"(wv[1][1]), "+v"(rn[0]), "+v"(rn[1]));
#pragma unroll
                for (int mm = 0; mm < 2; ++mm)
#pragma unroll
                    for (int bj = 0; bj < 2; ++bj) { const u32x4 w = wv[mm][bj]; o[mm][bj][0] = (f32x4){bflo(w.x), bfhi(w.x), bflo(w.y), bfhi(w.y)}; o[mm][bj][1] = (f32x4){bflo(w.z), bfhi(w.z), bflo(w.w), bfhi(w.w)}; }
            }
#pragma unroll
            for (int mm = 0; mm < 2; ++mm) { const int m = m0 + mm, row = rowb + ai * 128 + m * 16 + fr; float ss = 0.f, sg = 0.f;
#pragma unroll
                for (int bj = 0; bj < 2; ++bj) { const int c = colb + bj * 128;
                    const f32x4 n0 = o[mm][bj][0] * rn[mm] + alpha * acc[ai][bj][m][0], n1 = o[mm][bj][1] * rn[mm] + alpha * acc[ai][bj][m][1];
                    ss += (n0.x * n0.x + n0.y * n0.y) + (n0.z * n0.z + n0.w * n0.w) + (n1.x * n1.x + n1.y * n1.y) + (n1.z * n1.z + n1.w * n1.w);
                    const f32x4 b0 = n0 * gs[bj][0], b1 = n1 * gs[bj][1];
                    sg += (b0.x * b0.x + b0.y * b0.y) + (b0.z * b0.z + b0.w * b0.w) + (b1.x * b1.x + b1.y * b1.y) + (b1.z * b1.z + b1.w * b1.w);
                    u32x4 w; w.x = pk2(b0.x, b0.y); w.y = pk2(b0.z, b0.w); w.z = pk2(b1.x, b1.y); w.w = pk2(b1.z, b1.w);
                    *(u32x4*)(XB + (size_t)row * D + c) = w; }
                ss += __shfl_xor(ss, 16); ss += __shfl_xor(ss, 32);
                if (fq == 0) SSQ[(size_t)row * 16 + u.pn * 4 + wc] = ss;
                if (gsc) { sg += __shfl_xor(sg, 16); sg += __shfl_xor(sg, 32); if (fq == 0) SSQG[(size_t)row * 16 + u.pn * 4 + wc] = sg; } }
        }
    }
};
struct EpiWin {
    static constexpr bool PERM = true, AFTER_DRAIN = false;
    const LAS float* rtab; float* U; bf16_t* QB; bf16_t* ZS; bf16_t* XR;
    float* okp; float* oks;
    const float* gq; const float* gk;
    __device__ __forceinline__ void operator()(const f32x4 (&acc)[2][2][4][2], const pg8::Unit& u, int wr, int wc, int fr, int fq, int ui) const {
        const int rowb = u.pm * 256 + wr * 64; const int pn = u.pn;
        if (pn < 2) {
#pragma unroll
            for (int ai = 0; ai < 2; ++ai)
#pragma unroll
                for (int m = 0; m < 4; ++m) { const int row = rowb + ai * 128 + m * 16 + fr; const float rs = rtab[ui * 256 + (row - u.pm * 256)];
                    float* dst = U + (size_t)row * 256 + pn * 128 + wc * 32 + 8 * fq;
                    const float cexp = -1.4426950408889634f * rs;
#pragma unroll
                    for (int n = 0; n < 2; ++n) { const f32x4 a = acc[ai][0][m][n], g = acc[ai][1][m][n]; f32x4 o;
                        o.x = a.x * (rs * __builtin_amdgcn_rcpf(1.f + __builtin_amdgcn_exp2f(g.x * cexp))); o.y = a.y * (rs * __builtin_amdgcn_rcpf(1.f + __builtin_amdgcn_exp2f(g.y * cexp)));
                        o.z = a.z * (rs * __builtin_amdgcn_rcpf(1.f + __builtin_amdgcn_exp2f(g.z * cexp))); o.w = a.w * (rs * __builtin_amdgcn_rcpf(1.f + __builtin_amdgcn_exp2f(g.w * cexp))); *(f32x4*)(dst + 4 * n) = o; } }
        } else if (pn < 5) {
            f32x4 gv[2][2];
#pragma unroll
            for (int bj = 0; bj < 2; ++bj)
#pragma unroll
                for (int n = 0; n < 2; ++n) gv[bj][n] = (pn == 4) ? (f32x4){1.f, 1.f, 1.f, 1.f} : *(const f32x4*)((pn == 2 ? gq : gk) + 32 * bj + 8 * fq + 4 * n);
#pragma unroll
            for (int ai = 0; ai < 2; ++ai)
#pragma unroll
                for (int m = 0; m < 4; ++m) { const int rb = rowb + ai * 128 + m * 16, row = rb + fr; const float rs = rtab[ui * 256 + (row - u.pm * 256)];
                    f32x4 v[2][2]; float ss = 0.f;
#pragma unroll
                    for (int bj = 0; bj < 2; ++bj)
#pragma unroll
                        for (int n = 0; n < 2; ++n) { v[bj][n] = rs * acc[ai][bj][m][n]; ss += (v[bj][n].x * v[bj][n].x + v[bj][n].y * v[bj][n].y) + (v[bj][n].z * v[bj][n].z + v[bj][n].w * v[bj][n].w); }
                    ss += __shfl_xor(ss, 16); ss += __shfl_xor(ss, 32);
                    float sc = 1.f;
                    if (pn != 4) sc = rsqrtf(ss * (1.f / 64.f) + 1e-6f);
                    const float sq = (pn == 2) ? sc * (0.125f * 1.4426950408889634f) : sc;
                    bf16_t* bdst = QB + (size_t)(pn - 2) * ((size_t)MP * 256) + (size_t)row * 256 + wc * 64 + 8 * fq;
                    float* fdst = nullptr;
                    if (pn != 2 && rb < MT) fdst = (row < MPR) ? okp + (size_t)(pn - 3) * (O_VP - O_KP) + (size_t)row * 256 + wc * 64 + 8 * fq : oks + (size_t)(pn - 3) * (O_VS - O_KS) + (size_t)(row - MPR) * 256 + wc * 64 + 8 * fq;
#pragma unroll
                    for (int bj = 0; bj < 2; ++bj) { const f32x4 a = v[bj][0] * gv[bj][0] * sq, b = v[bj][1] * gv[bj][1] * sq;
                        u32x4 w; w.x = pk2(a.x, a.y); w.y = pk2(a.z, a.w); w.z = pk2(b.x, b.y); w.w = pk2(b.z, b.w);
                        *(u32x4*)(bdst + 32 * bj) = w;
                        if (fdst) { *(f32x4*)(fdst + 32 * bj) = a; *(f32x4*)(fdst + 32 * bj + 4) = b; } } }
        } else {
            const bool isz = pn < 7; bf16_t* base = isz ? ZS : XR; const int ld = isz ? 512 : 1024; const int c0 = (isz ? (pn - 5) : (pn - 7)) * 256 + wc * 32 + 8 * fq;
#pragma unroll
            for (int ai = 0; ai < 2; ++ai)
#pragma unroll
                for (int m = 0; m < 4; ++m) { const int row = rowb + ai * 128 + m * 16 + fr; const float rs = rtab[ui * 256 + (row - u.pm * 256)];
                    const float cexp = -1.4426950408889634f * rs;
#pragma unroll
                    for (int bj = 0; bj < 2; ++bj) { f32x4 a = acc[ai][bj][m][0], b = acc[ai][bj][m][1];
                        if (isz) { a.x *= rs * __builtin_amdgcn_rcpf(1.f + __builtin_amdgcn_exp2f(a.x * cexp)); a.y *= rs * __builtin_amdgcn_rcpf(1.f + __builtin_amdgcn_exp2f(a.y * cexp)); a.z *= rs * __builtin_amdgcn_rcpf(1.f + __builtin_amdgcn_exp2f(a.z * cexp)); a.w *= rs * __builtin_amdgcn_rcpf(1.f + __builtin_amdgcn_exp2f(a.w * cexp));
                                   b.x *= rs * __builtin_amdgcn_rcpf(1.f + __builtin_amdgcn_exp2f(b.x * cexp)); b.y *= rs * __builtin_amdgcn_rcpf(1.f + __builtin_amdgcn_exp2f(b.y * cexp)); b.z *= rs * __builtin_amdgcn_rcpf(1.f + __builtin_amdgcn_exp2f(b.z * cexp)); b.w *= rs * __builtin_amdgcn_rcpf(1.f + __builtin_amdgcn_exp2f(b.w * cexp)); }
                        else { a = a * rs; b = b * rs; }
                        u32x4 w; w.x = pk2(a.x, a.y); w.y = pk2(a.z, a.w); w.z = pk2(b.x, b.y); w.w = pk2(b.z, b.w);
                        *(u32x4*)(base + (size_t)row * ld + c0 + 128 * bj) = w; } }
        }
    }
};
__device__ __forceinline__ void tr_item(const float* __restrict__ W, int ldw, int col0, int k0, const float* __restrict__ gain, bf16_t* __restrict__ dst, int K, int row0, LAS float* scr, int lane) {
    const int kr = lane >> 3, c4 = lane & 7;
    f32x4 v[8]; float gg[8];
#pragma unroll
    for (int i = 0; i < 8; ++i) { v[i] = __builtin_nontemporal_load((const f32x4*)(W + (size_t)(k0 + 8 * i + kr) * ldw + col0 + 4 * c4)); gg[i] = gain ? gain[k0 + 8 * i + kr] : 1.f; }
    asm volatile("" : "+v"(v[0]), "+v"(v[1]), "+v"(v[2]), "+v"(v[3]), "+v"(v[4]), "+v"(v[5]), "+v"(v[6]), "+v"(v[7]), "+v"(gg[0]), "+v"(gg[1]), "+v"(gg[2]), "+v"(gg[3]), "+v"(gg[4]), "+v"(gg[5]), "+v"(gg[6]), "+v"(gg[7]));
#pragma unroll
    for (int i = 0; i < 8; ++i) { const int kk = 8 * i + kr; LAS float* s = scr + kk * 33 + 4 * c4;
        s[0] = v[i].x * gg[i]; s[1] = v[i].y * gg[i]; s[2] = v[i].z * gg[i]; s[3] = v[i].w * gg[i]; }
    asm volatile("s_waitcnt lgkmcnt(0)" ::: "memory");
    const int c = lane & 7;
#pragma unroll
    for (int j = 0; j < 4; ++j) { const int n = (lane >> 3) + 8 * j; const LAS float* s = scr + (8 * c) * 33 + n;
        u32x4 o; o.x = pk2(s[0 * 33], s[1 * 33]); o.y = pk2(s[2 * 33], s[3 * 33]); o.z = pk2(s[4 * 33], s[5 * 33]); o.w = pk2(s[6 * 33], s[7 * 33]);
        *(u32x4*)(dst + (size_t)(row0 + n) * K + k0 + 8 * c) = o; }
    asm volatile("s_waitcnt lgkmcnt(0)" ::: "memory");
}
constexpr int IT_GU = 16 * 176, IT_WD = 44 * 32, IT_WIN = 16 * 88, IT_WOUT = 16 * 32;
constexpr int IT_TOTAL = 4 * IT_GU + 4 * IT_WD + 2 * IT_WIN + 2 * IT_WOUT;
__device__ __forceinline__ void p0_weights(const Args& a, LAS unsigned char* lds, int gw, int ngw, int wave, int lane_in) { int lane = lane_in;
    LAS float* scr = (LAS float*)(lds + wave * 16384);
    unsigned char* ws = a.ws;
    for (int it = gw; it < 4 * IT_GU; it += ngw) { const int mat = it / IT_GU, r = it % IT_GU; const int l = mat >> 1, f = mat & 1, kb = r / 176, gidx = r % 176, pn = gidx >> 3, gi = gidx & 7, bj = gi >> 2, wc = gi & 3;
        const float* W = (f ? (bj ? a.in[30] : a.in[29]) : (bj ? a.in[11] : a.in[10])) + (size_t)l * D * FF;
        tr_item(W, FF, 128 * pn + 32 * wc, 64 * kb, (f ? a.in[28] : a.in[9]) + l * D, (bf16_t*)(ws + WS_WGU + mat * SZ_WGU), D, 32 * gidx, scr, lane); }
    asm volatile("" : "+v"(lane));
    for (int it = gw; it < 4 * IT_WD; it += ngw) { const int mat = it / IT_WD, r = it % IT_WD; const int l = mat >> 1, f = mat & 1, kb = r / 32, gidx = r % 32;
        tr_item((f ? a.in[31] : a.in[12]) + (size_t)l * FF * D, D, 32 * gidx, 64 * kb, nullptr, (bf16_t*)(ws + WS_WD + mat * SZ_WD), FF, 32 * gidx, scr, lane); }
    asm volatile("" : "+v"(lane));
    for (int it = gw; it < 2 * IT_WIN; it += ngw) { const int l = it / IT_WIN, r = it % IT_WIN; const int kb = r / 88, gidx = r % 88, pn = gidx >> 3, gi = gidx & 7, bj = gi >> 2, wc = gi & 3;
        int col0;
        if (pn < 2) col0 = (bj ? 256 : 0) + 128 * pn + 32 * wc; else if (pn < 5) col0 = 512 + 256 * (pn - 2) + 64 * wc + 32 * bj; else col0 = 1280 + 256 * (pn - 5) + 32 * gi;
        tr_item(a.in[14] + (size_t)l * D * NIN, NIN, col0, 64 * kb, a.in[13] + l * D, (bf16_t*)(ws + WS_WIN + l * SZ_WIN), D, 32 * gidx, scr, lane); }
    asm volatile("" : "+v"(lane));
    for (int it = gw; it < 2 * IT_WOUT; it += ngw) { const int l = it / IT_WOUT, r = it % IT_WOUT; const int kb = r / 32, gidx = r % 32;
        tr_item(a.in[15] + (size_t)l * D * D, D, 32 * gidx, 64 * kb, nullptr, (bf16_t*)(ws + WS_WOUT + l * SZ_WOUT), D, 32 * gidx, scr, lane); }
}
__device__ const unsigned char T5_BUCKET[129] = {0,1,2,3,4,5,6,7,8,9,10,11,12,13,14,15,16,16,16,17,17,18,18,18,19,19,19,20,20,20,20,21,21,21,21,22,22,22,22,22,23,23,23,23,23,23,24,24,24,24,24,24,25,25,25,25,25,25,25,26,26,26,26,26,26,26,26,27,27,27,27,27,27,27,27,27,27,28,28,28,28,28,28,28,28,28,28,29,29,29,29,29,29,29,29,29,29,29,29,30,30,30,30,30,30,30,30,30,30,30,30,30,30,31,31,31,31,31,31,31,31,31,31,31,31,31,31,31,31};
__device__ __forceinline__ void p0_rows(const Args& a, int gw, int ngw, int lane) {
    unsigned char* ws = a.ws; bf16_t* XB = (bf16_t*)(ws + WS_XB); float* SSQ = (float*)(ws + WS_SSQ);
    for (int m0 = gw; m0 < MP; m0 += 4 * ngw) {
        f32x4 xv[4][4];
#pragma unroll
        for (int r = 0; r < 4; ++r) { const int m = m0 + r * ngw; if (m < MT) { const float* x = (m < MPR) ? a.in[0] + (size_t)m * D : a.in[1] + (size_t)(m - MPR) * D;
#pragma unroll
            for (int j = 0; j < 4; ++j) xv[r][j] = __builtin_nontemporal_load((const f32x4*)(x + 4 * lane + 256 * j)); } }
#pragma unroll
        for (int r = 0; r < 4; ++r) { const int m = m0 + r * ngw; if (m >= MP) continue;
            if (m < MT) { float s = 0.f;
#pragma unroll
                for (int j = 0; j < 4; ++j) { const f32x4 v = xv[r][j]; s += (v.x * v.x + v.y * v.y) + (v.z * v.z + v.w * v.w);
                    u32x2 w; w.x = pk2(v.x, v.y); w.y = pk2(v.z, v.w); *(u32x2*)(XB + (size_t)m * D + 4 * lane + 256 * j) = w; }
                s = wsum(s); if (lane < 16) SSQ[(size_t)m * 16 + lane] = (lane == 0) ? s : 0.f;
            } else {
#pragma unroll
                for (int j = 0; j < 4; ++j) *(u32x2*)(XB + (size_t)m * D + 4 * lane + 256 * j) = (u32x2){0u, 0u};
                if (lane < 16) SSQ[(size_t)m * 16 + lane] = 0.f; } }
    }
    const int gwr = ngw - 1 - gw;
    float* WDT = (float*)(ws + WS_WDT);
    for (int i = gwr * 64 + lane; i < 2 * 1024 * 8; i += ngw * 64) { const int l = i >> 13, k = (i >> 3) & 1023, h = i & 7; WDT[i] = a.in[13][l * D + k] * a.in[14][((size_t)l * D + k) * NIN + 2816 + h]; }
    bf16_t* WDTB = (bf16_t*)(ws + WS_WDTB);
    for (int i = gwr * 64 + lane; i < 2 * 16 * 1024; i += ngw * 64) { const int l = i >> 14, n = (i >> 10) & 15, k = i & 1023; const float v = (n < 8) ? a.in[13][l * D + k] * a.in[14][((size_t)l * D + k) * NIN + 2816 + n] : 0.f; WDTB[i] = (bf16_t)(pk2(v, 0.f) & 0xffffu); }
    float* BT = (float*)(ws + WS_BT);
    for (int i = gwr * 64 + lane; i < 4 * 129; i += ngw * 64) { const int h = i / 129, d = i % 129; const int bucket = (int)T5_BUCKET[d];
        BT[i] = a.in[8][bucket * 4 + h] * 1.4426950408889634f; }
}
__device__ __forceinline__ void colmean_unit(const float* __restrict__ r0, const float* __restrict__ r1, float* __restrict__ out, LAS float* scr, int tid) {
    const int c4 = tid & 63, rg = tid >> 6; f32x4 s = {0.f, 0.f, 0.f, 0.f};
#pragma unroll
    for (int hlf = 0; hlf < 2; ++hlf) { const float* p = (hlf ? r1 : r0) + (size_t)rg * 256 + 4 * c4;
        f32x4 v[16];
#pragma unroll
        for (int r = 0; r < 16; ++r) v[r] = __builtin_nontemporal_load((const f32x4*)(p + (size_t)r * 8 * 256));
#pragma unroll
        for (int r = 0; r < 16; ++r) s += v[r]; }
    *(LAS f32x4*)(scr + rg * 256 + 4 * c4) = s;
    __syncthreads();
    if (tid < 256) { float t = 0.f;
#pragma unroll
        for (int g = 0; g < 8; ++g) t += scr[g * 256 + tid];
        out[tid] = t * (1.f / 256.f); }
    __syncthreads();
}

__device__ __forceinline__ void convA_unit(const Args& a, int l, int unit, LAS unsigned char* lds, int tid) {
    unsigned char* ws = a.ws; const float* U = (const float*)(ws + WS_U); bf16_t* MIX = (bf16_t*)(ws + WS_MIX);
    const int b = unit >> 7, t0 = (unit & 127) * 64, c = tid & 255, half = tid >> 8, tb = t0 + 32 * half;
    const float* wv = a.in[16] + l * 31 * 256 + c; const float bias = a.in[17][l * 256 + c];
    LAS float* T = (LAS float*)lds;
    float win[62], wj[31];
#pragma unroll
    for (int k = 0; k < 62; ++k) { const int t = tb - 30 + k; win[k] = (t >= 0) ? U[(size_t)(b * SEQ + t) * 256 + c] : 0.f; }
#pragma unroll
    for (int j = 0; j < 31; ++j) wj[j] = wv[j * 256];
    asm volatile("" : "+v"(wj[0]), "+v"(wj[1]), "+v"(wj[2]), "+v"(wj[3]), "+v"(wj[4]), "+v"(wj[5]), "+v"(wj[6]), "+v"(wj[7]), "+v"(wj[8]), "+v"(wj[9]), "+v"(wj[10]), "+v"(wj[11]), "+v"(wj[12]), "+v"(wj[13]), "+v"(wj[14]), "+v"(wj[15]),
                 "+v"(wj[16]), "+v"(wj[17]), "+v"(wj[18]), "+v"(wj[19]), "+v"(wj[20]), "+v"(wj[21]), "+v"(wj[22]), "+v"(wj[23]), "+v"(wj[24]), "+v"(wj[25]), "+v"(wj[26]), "+v"(wj[27]), "+v"(wj[28]), "+v"(wj[29]));
    asm volatile("" : "+v"(wj[30]), "+v"(win[0]), "+v"(win[8]), "+v"(win[16]), "+v"(win[24]), "+v"(win[32]), "+v"(win[40]), "+v"(win[48]), "+v"(win[56]), "+v"(win[61]));
    float o[32];
#pragma unroll
    for (int i = 0; i < 32; ++i) o[i] = bias;
#pragma unroll
    for (int j = 0; j < 31; ++j) { const float w = wj[j];
#pragma unroll
        for (int i = 0; i < 32; ++i) o[i] = fmaf(w, win[i + j], o[i]); }
#pragma unroll
    for (int i = 0; i < 32; ++i) T[(32 * half + i) * 260 + c] = o[i];
    __syncthreads();
    const int wave = tid >> 6, lane = tid & 63;
    const f32x4 g = *(const f32x4*)(a.in[18] + l * 256 + 4 * lane), bb = *(const f32x4*)(a.in[19] + l * 256 + 4 * lane);
#pragma unroll
    for (int r = 0; r < 8; ++r) { const int row = 8 * wave + r; f32x4 v = *(const LAS f32x4*)(T + row * 260 + 4 * lane);
        const float mean = wsum((v.x + v.y) + (v.z + v.w)) * (1.f / 256.f); v = v - mean;
        const float rs = rsqrtf(wsum((v.x * v.x + v.y * v.y) + (v.z * v.z + v.w * v.w)) * (1.f / 256.f) + 1e-5f);
        v = v * rs * g + bb; u32x2 w; w.x = pk2(fsilu(v.x), fsilu(v.y)); w.y = pk2(fsilu(v.z), fsilu(v.w));
        *(u32x2*)(MIX + (size_t)(b * SEQ + t0 + row) * D + 4 * lane) = w; }
    if (t0 == SEQ - 64) { float* cp = a.out + O_CP + (size_t)(l * 2 + b) * 30 * 256;
        float cv[15];
#pragma unroll
        for (int i = 0; i < 15; ++i) cv[i] = U[(size_t)(b * SEQ + SEQ - 30) * 256 + tid + NTHR * i];
        asm volatile("" : "+v"(cv[0]), "+v"(cv[1]), "+v"(cv[2]), "+v"(cv[3]), "+v"(cv[4]), "+v"(cv[5]), "+v"(cv[6]), "+v"(cv[7]), "+v"(cv[8]), "+v"(cv[9]), "+v"(cv[10]), "+v"(cv[11]), "+v"(cv[12]), "+v"(cv[13]), "+v"(cv[14]));
#pragma unroll
        for (int i = 0; i < 15; ++i) cp[tid + NTHR * i] = cv[i]; }
    __syncthreads();
}
__device__ __forceinline__ void convA_sample_unit(const Args& a, int l, int sb, LAS unsigned char* lds, int tid) {
    unsigned char* ws = a.ws; const float* U = (const float*)(ws + WS_U); bf16_t* MIX = (bf16_t*)(ws + WS_MIX);
    const int c = tid & 255, half = tid >> 8; const float* wv = a.in[16] + l * 31 * 256 + c;
    const float* st = a.in[4] + ((size_t)l * 32 + sb) * 30 * 256 + c; float* cs = a.out + O_CS + ((size_t)l * 32 + sb) * 30 * 256 + c;
    LAS float* P = (LAS float*)lds;
    const float un = U[(size_t)(MPR + sb) * 256 + c];
    float sv[16], wj[16];
#pragma unroll
    for (int j = 0; j < 16; ++j) { const int jj = 16 * half + j; sv[j] = (jj < 30) ? st[(size_t)jj * 256] : un; wj[j] = (jj < 31) ? wv[jj * 256] : 0.f; }
    float acc = half ? 0.f : a.in[17][l * 256 + c];
    asm volatile("" : "+v"(sv[0]), "+v"(sv[1]), "+v"(sv[2]), "+v"(sv[3]), "+v"(sv[4]), "+v"(sv[5]), "+v"(sv[6]), "+v"(sv[7]), "+v"(sv[8]), "+v"(sv[9]), "+v"(sv[10]), "+v"(sv[11]), "+v"(sv[12]), "+v"(sv[13]), "+v"(sv[14]), "+v"(sv[15]), "+v"(acc));
    asm volatile("" : "+v"(wj[0]), "+v"(wj[1]), "+v"(wj[2]), "+v"(wj[3]), "+v"(wj[4]), "+v"(wj[5]), "+v"(wj[6]), "+v"(wj[7]), "+v"(wj[8]), "+v"(wj[9]), "+v"(wj[10]), "+v"(wj[11]), "+v"(wj[12]), "+v"(wj[13]), "+v"(wj[14]), "+v"(wj[15]));
#pragma unroll
    for (int j = 0; j < 16; ++j) { const int jj = 16 * half + j; if (jj < 31) { acc = fmaf(wj[j], sv[j], acc); if (jj >= 1) cs[(size_t)(jj - 1) * 256] = sv[j]; } }
    P[half * 256 + c] = acc;
    __syncthreads();
    if (tid < 64) { const int lane = tid; f32x4 v = *(const LAS f32x4*)(P + 4 * lane) + *(const LAS f32x4*)(P + 256 + 4 * lane);
        const f32x4 g = *(const f32x4*)(a.in[18] + l * 256 + 4 * lane), bb = *(const f32x4*)(a.in[19] + l * 256 + 4 * lane);
        const float mean = wsum((v.x + v.y) + (v.z + v.w)) * (1.f / 256.f); v = v - mean;
        const float rs = rsqrtf(wsum((v.x * v.x + v.y * v.y) + (v.z * v.z + v.w * v.w)) * (1.f / 256.f) + 1e-5f);
        v = v * rs * g + bb; u32x2 w; w.x = pk2(fsilu(v.x), fsilu(v.y)); w.y = pk2(fsilu(v.z), fsilu(v.w));
        *(u32x2*)(MIX + (size_t)(MPR + sb) * D + 4 * lane) = w; }
    __syncthreads();
}
__device__ __forceinline__ void conv4_unit(const Args& a, int l, int unit, int tid) {
    unsigned char* ws = a.ws; const bf16_t* XR = (const bf16_t*)(ws + WS_XR); bf16_t* XC = (bf16_t*)(ws + WS_XC);
    if (unit < 256) {
        const int c8 = 8 * (tid & 127), rg = tid >> 7, b = unit >> 7, t0 = (unit & 127) * 64 + 16 * rg; const size_t r0 = (size_t)b * SEQ + t0;
        const float* w = a.in[22] + l * 4 * 1024 + c8; const float* bp = a.in[23] + l * 1024 + c8;
        u32x4 raw[19];
#pragma unroll
        for (int i = 0; i < 19; ++i) raw[i] = (t0 + i - 3 >= 0) ? *(const u32x4*)(XR + (r0 + i - 3) * 1024 + c8) : (u32x4){0u, 0u, 0u, 0u};
        float wf[4][8], bf[8];
#pragma unroll
        for (int j = 0; j < 4; ++j) { const f32x4 wa = *(const f32x4*)(w + j * 1024), wb = *(const f32x4*)(w + j * 1024 + 4); wf[j][0] = wa.x; wf[j][1] = wa.y; wf[j][2] = wa.z; wf[j][3] = wa.w; wf[j][4] = wb.x; wf[j][5] = wb.y; wf[j][6] = wb.z; wf[j][7] = wb.w; }
        { const f32x4 ba = *(const f32x4*)bp, bb = *(const f32x4*)(bp + 4); bf[0] = ba.x; bf[1] = ba.y; bf[2] = ba.z; bf[3] = ba.w; bf[4] = bb.x; bf[5] = bb.y; bf[6] = bb.z; bf[7] = bb.w; }
        float win[4][8];
#pragma unroll
        for (int i = 0; i < 3; ++i) { win[i][0] = bflo(raw[i].x); win[i][1] = bfhi(raw[i].x); win[i][2] = bflo(raw[i].y); win[i][3] = bfhi(raw[i].y); win[i][4] = bflo(raw[i].z); win[i][5] = bfhi(raw[i].z); win[i][6] = bflo(raw[i].w); win[i][7] = bfhi(raw[i].w); }
#pragma unroll
        for (int i = 0; i < 16; ++i) { const u32x4 rr = raw[i + 3]; const int s3 = (i + 3) & 3;
            win[s3][0] = bflo(rr.x); win[s3][1] = bfhi(rr.x); win[s3][2] = bflo(rr.y); win[s3][3] = bfhi(rr.y); win[s3][4] = bflo(rr.z); win[s3][5] = bfhi(rr.z); win[s3][6] = bflo(rr.w); win[s3][7] = bfhi(rr.w);
            float o[8];
#pragma unroll
            for (int e = 0; e < 8; ++e) { float v = bf[e];
#pragma unroll
                for (int j = 0; j < 4; ++j) v = fmaf(wf[j][e], win[(i + j) & 3][e], v);
                o[e] = fsilu(v); }
            u32x4 ow; ow.x = pk2(o[0], o[1]); ow.y = pk2(o[2], o[3]); ow.z = pk2(o[4], o[5]); ow.w = pk2(o[6], o[7]);
            *(u32x4*)(XC + (r0 + i) * 1024 + c8) = ow; }
        if (t0 == SEQ - 16) { float* sp = a.out + O_SCP + (size_t)(l * 2 + b) * 3 * 1024 + c8;
#pragma unroll
            for (int i = 0; i < 3; ++i) { const u32x4 rr = raw[16 + i]; *(f32x4*)(sp + i * 1024) = (f32x4){bflo(rr.x), bfhi(rr.x), bflo(rr.y), bfhi(rr.y)}; *(f32x4*)(sp + i * 1024 + 4) = (f32x4){bflo(rr.z), bfhi(rr.z), bflo(rr.w), bfhi(rr.w)}; } }
    } else {
        const int c = 2 * tid; const float* w = a.in[22] + l * 4 * 1024 + c; const f32x2 bias = *(const f32x2*)(a.in[23] + l * 1024 + c);
        const f32x2 w0 = *(const f32x2*)(w), w1 = *(const f32x2*)(w + 1024), w2 = *(const f32x2*)(w + 2048), w3 = *(const f32x2*)(w + 3072);
        const float* st = a.in[5] + (size_t)l * 32 * 3 * 1024 + c; float* so = a.out + O_SCS + (size_t)l * 32 * 3 * 1024 + c;
        f32x2 q3[8], q2[8], q1[8]; unsigned ur[8];
#pragma unroll
        for (int k = 0; k < 8; ++k) { const int sb = 8 * (unit - 256) + k;
            q3[k] = *(const f32x2*)(st + (size_t)(sb * 3 + 0) * 1024); q2[k] = *(const f32x2*)(st + (size_t)(sb * 3 + 1) * 1024); q1[k] = *(const f32x2*)(st + (size_t)(sb * 3 + 2) * 1024);
            ur[k] = *(const unsigned*)(XR + (size_t)(MPR + sb) * 1024 + c); }
#pragma unroll
        for (int k = 0; k < 8; ++k) asm volatile("" : "+v"(q3[k]), "+v"(q2[k]), "+v"(q1[k]), "+v"(ur[k]));
#pragma unroll
        for (int k = 0; k < 8; ++k) { const int sb = 8 * (unit - 256) + k; const f32x2 raw = {bflo(ur[k]), bfhi(ur[k])};
            const f32x2 v = bias + w0 * q3[k] + w1 * q2[k] + w2 * q1[k] + w3 * raw;
            *(unsigned*)(XC + (size_t)(MPR + sb) * 1024 + c) = pk2(fsilu(v.x), fsilu(v.y));
            *(f32x2*)(so + (size_t)(sb * 3 + 0) * 1024) = q2[k]; *(f32x2*)(so + (size_t)(sb * 3 + 1) * 1024) = q1[k]; *(f32x2*)(so + (size_t)(sb * 3 + 2) * 1024) = raw; }
    }
}
__device__ __forceinline__ void dt_row(const Args& a, int l, int row, int lane) {
    unsigned char* ws = a.ws; const bf16_t* XBr = (const bf16_t*)(ws + WS_XB) + (size_t)row * D; const float* WDT = (const float*)(ws + WS_WDT) + l * 1024 * 8;
    float acc[8];
#pragma unroll
    for (int h = 0; h < 8; ++h) acc[h] = 0.f;
#pragma unroll
    for (int j = 0; j < 4; ++j) { const int k = 4 * lane + 256 * j; const u32x2 xw = *(const u32x2*)(XBr + k); const f32x4 x = {bflo(xw.x), bfhi(xw.x), bflo(xw.y), bfhi(xw.y)};
#pragma unroll
        for (int e = 0; e < 4; ++e) { const f32x4 wa = *(const f32x4*)(WDT + (k + e) * 8), wb = *(const f32x4*)(WDT + (k + e) * 8 + 4); const float xv = x[e];
            acc[0] = fmaf(xv, wa.x, acc[0]); acc[1] = fmaf(xv, wa.y, acc[1]); acc[2] = fmaf(xv, wa.z, acc[2]); acc[3] = fmaf(xv, wa.w, acc[3]);
            acc[4] = fmaf(xv, wb.x, acc[4]); acc[5] = fmaf(xv, wb.y, acc[5]); acc[6] = fmaf(xv, wb.z, acc[6]); acc[7] = fmaf(xv, wb.w, acc[7]); } }
    const float rs = rstd16((const float*)(ws + WS_SSQ) + (size_t)row * 16);
    float mine = 0.f;
#pragma unroll
    for (int h = 0; h < 8; ++h) { const float s = wsum(acc[h]); if (lane == h) mine = s; }
    if (lane < 8) { const float x = rs * mine + a.in[24][l * 8 + lane]; ((float*)(ws + WS_DT))[(size_t)row * 8 + lane] = fmaxf(x, 0.f) + log1pf(expf(-fabsf(x))); }
}
__device__ __forceinline__ void final_rows4(const Args& a, int l, int row0, int rstride, int lane) {
    unsigned char* ws = a.ws; const float* g = a.in[32] + l * D;
    u32x2 w[4][4];
#pragma unroll
    for (int r = 0; r < 4; ++r) { const int row = row0 + r * rstride; if (row < MT) {
#pragma unroll
        for (int j = 0; j < 4; ++j) w[r][j] = *(const u32x2*)((const bf16_t*)(ws + WS_XB) + (size_t)row * D + 4 * lane + 256 * j); } }
    f32x4 gg[4];
#pragma unroll
    for (int j = 0; j < 4; ++j) gg[j] = *(const f32x4*)(g + 4 * lane + 256 * j);
#pragma unroll
    for (int r = 0; r < 4; ++r) { const int row = row0 + r * rstride; if (row < MT) { f32x4 v[4]; float s = 0.f;
#pragma unroll
        for (int j = 0; j < 4; ++j) { v[j] = (f32x4){bflo(w[r][j].x), bfhi(w[r][j].x), bflo(w[r][j].y), bfhi(w[r][j].y)}; s += (v[j].x * v[j].x + v[j].y * v[j].y) + (v[j].z * v[j].z + v[j].w * v[j].w); }
        const float rs = rsqrtf(wsum(s) * (1.f / 1024.f) + 1e-6f);
        float* o = row < MPR ? a.out + O_YP + (size_t)row * D : a.out + O_YS + (size_t)(row - MPR) * D;
#pragma unroll
        for (int j = 0; j < 4; ++j) *(f32x4*)(o + 4 * lane + 256 * j) = v[j] * rs * gg[j]; } }
}
__device__ __forceinline__ void attn_simple(const Args& a, int l, int item, LAS float* L, int ht, bf16_t* outp = nullptr) {
    unsigned char* ws = a.ws;
    const bf16_t* QB = (const bf16_t*)(ws + WS_QB); const bf16_t* KB = (const bf16_t*)(ws + WS_KB); const bf16_t* VB = (const bf16_t*)(ws + WS_VB);
    const float* KMP = (const float*)(ws + WS_KMP); const float* KMS = (const float*)(ws + WS_KMS) + (size_t)l * 1024 * 256; const float* BT = (const float*)(ws + WS_BT);
    const float* cachek = a.in[2] + (size_t)l * CACHE_L; const float* cachev = a.in[3] + (size_t)l * CACHE_L; const int* pt = (const int*)a.in[7];
    bf16_t* MIX = outp ? outp : (bf16_t*)(ws + WS_MIX);
    LAS float* qs = L; LAS float* gate = L + 64; LAS int* sel = (LAS int*)(L + 96); LAS float* lg = L + 128; LAS float* red = L + 1152; LAS float* osum = L + 1408;
    const int m = item >> 2, h = item & 3; const bool smp = m >= MPR; const int b = m >> 13, t = m & 8191, sb = m - MPR;
    const int qpos = smp ? 8192 : t, cur = qpos >> 8;
    if (ht < 64) qs[ht] = bf1(QB[(size_t)m * 256 + h * 64 + ht]);
    __syncthreads();
    if (ht < cur) { const float* km = (smp ? KMS + (size_t)(sb * 32 + ht) * 256 : KMP + (size_t)(b * 32 + ht) * 256) + h * 64; float g = 0.f; for (int d = 0; d < 64; ++d) g = fmaf(qs[d], km[d], g); gate[ht] = g; }
    __syncthreads();
    if (ht == 0) { const int cnt = cur < 3 ? cur : 3; int s0 = -1, s1 = -1, s2 = -1;
        for (int j = 0; j < cnt; ++j) { int best = -1; float bv = 0.f;
            for (int n = 0; n < cur; ++n) { if (n == s0 || n == s1) continue; if (best < 0 || gate[n] > bv) { best = n; bv = gate[n]; } }
            if (j == 0) s0 = best; else if (j == 1) s1 = best; else s2 = best; }
        sel[0] = s0; sel[1] = s1; sel[2] = s2; sel[cnt] = cur; sel[4] = cnt; }
    __syncthreads();
    const int cnt = sel[4]; float mx = -INFINITY;
    for (int j = 0; j <= cnt; ++j) { const int blk = sel[j], kpos = blk * 256 + ht; float lgt = -INFINITY;
        if (kpos <= qpos) { float acc = 0.f;
            if (smp && blk < 32) { const float* kp = cachek + ((size_t)pt[sb * NPAGES + (kpos >> 7)] * 128 + (kpos & 127)) * 256 + h * 64;
                for (int d = 0; d < 64; ++d) acc = fmaf(qs[d], kp[d], acc);
            } else { const bf16_t* kp = KB + (size_t)(smp ? m : b * SEQ + kpos) * 256 + h * 64;
                for (int d8 = 0; d8 < 8; ++d8) { const u32x4 w = *(const u32x4*)(kp + 8 * d8);
                    acc = fmaf(qs[8 * d8 + 0], bflo(w.x), acc); acc = fmaf(qs[8 * d8 + 1], bfhi(w.x), acc); acc = fmaf(qs[8 * d8 + 2], bflo(w.y), acc); acc = fmaf(qs[8 * d8 + 3], bfhi(w.y), acc);
                    acc = fmaf(qs[8 * d8 + 4], bflo(w.z), acc); acc = fmaf(qs[8 * d8 + 5], bfhi(w.z), acc); acc = fmaf(qs[8 * d8 + 6], bflo(w.w), acc); acc = fmaf(qs[8 * d8 + 7], bfhi(w.w), acc); } }
            const int dist = qpos - kpos; lgt = acc + BT[h * 129 + (dist < 128 ? dist : 128)]; }
        lg[j * 256 + ht] = lgt; mx = fmaxf(mx, lgt); }
    red[ht] = mx; __syncthreads();
    for (int o = 128; o > 0; o >>= 1) { if (ht < o) red[ht] = fmaxf(red[ht], red[ht + o]); __syncthreads(); }
    mx = red[0]; __syncthreads();
    float ps = 0.f;
    for (int j = 0; j <= cnt; ++j) { const float p = expf(lg[j * 256 + ht] - mx); lg[j * 256 + ht] = p; ps += p; }
    red[ht] = ps; __syncthreads();
    for (int o = 128; o > 0; o >>= 1) { if (ht < o) red[ht] += red[ht + o]; __syncthreads(); }
    const float tot = red[0];
    { const int j = ht >> 6, d = ht & 63; float acc = 0.f;
      if (j <= cnt) { const int blk = sel[j];
        for (int s = 0; s < 256; ++s) { const float p = lg[j * 256 + s]; if (p == 0.f) continue; const int kpos = blk * 256 + s; float v;
            if (smp && blk < 32) v = cachev[((size_t)pt[sb * NPAGES + (kpos >> 7)] * 128 + (kpos & 127)) * 256 + h * 64 + d];
            else v = bf1(VB[(size_t)(smp ? m : b * SEQ + kpos) * 256 + h * 64 + d]);
            acc = fmaf(p, v, acc); } }
      osum[j * 64 + d] = acc; }
    __syncthreads();
    if (ht < 64) { const float o = (osum[ht] + osum[64 + ht] + osum[128 + ht] + osum[192 + ht]) / tot; MIX[(size_t)m * D + 256 + h * 64 + ht] = (bf16_t)(pk2(o, 0.f) & 0xffffu); }
    __syncthreads();
}
__device__ __forceinline__ void ssd_seq_item(const Args& a, int l, int wv, int lane) {
    unsigned char* ws = a.ws; const bf16_t* XC = (const bf16_t*)(ws + WS_XC); const float* DT = (const float*)(ws + WS_DT); float* Y = (float*)(ws + WS_Y);
    const int seq = wv >> 9, h = (wv >> 6) & 7, p = wv & 63, g = h >> 2;
    const float A = -expf(a.in[25][l * 8 + h]);
    const bool smp = seq >= 2; const int T = smp ? 1 : SEQ; const size_t row0 = smp ? (size_t)MPR + (seq - 2) : (size_t)seq * SEQ;
    float h0 = 0.f, h1 = 0.f;
    if (smp) { const float* s = a.in[6] + (size_t)l * 32 * 8 * 64 * 128 + ((size_t)((seq - 2) * 8 + h) * 64 + p) * 128; h0 = s[lane]; h1 = s[lane + 64]; }
    const bf16_t* xc = XC + row0 * 1024; const float* dt = DT + row0 * 8;
    float dtv = dt[h], xv = bf1(xc[h * 64 + p]), b0 = bf1(xc[512 + g * 128 + lane]), b1 = bf1(xc[512 + g * 128 + 64 + lane]), c0 = bf1(xc[768 + g * 128 + lane]), c1 = bf1(xc[768 + g * 128 + 64 + lane]);
    for (int t = 0; t < T; ++t) {
        float ndt = 0.f, nx = 0.f, nb0 = 0.f, nb1 = 0.f, nc0 = 0.f, nc1 = 0.f;
        if (t + 1 < T) { const bf16_t* x2 = xc + (size_t)(t + 1) * 1024; ndt = dt[(size_t)(t + 1) * 8 + h]; nx = bf1(x2[h * 64 + p]); nb0 = bf1(x2[512 + g * 128 + lane]); nb1 = bf1(x2[512 + g * 128 + 64 + lane]); nc0 = bf1(x2[768 + g * 128 + lane]); nc1 = bf1(x2[768 + g * 128 + 64 + lane]); }
        const float dA = expf(dtv * A), xd = dtv * xv;
        h0 = fmaf(h0, dA, xd * b0); h1 = fmaf(h1, dA, xd * b1);
        const float y = wsum(c0 * h0 + c1 * h1);
        if (lane == 0) Y[(row0 + t) * 512 + h * 64 + p] = y;
        dtv = ndt; xv = nx; b0 = nb0; b1 = nb1; c0 = nc0; c1 = nc1;
    }
    float* o = smp ? a.out + O_HS + (size_t)l * 32 * 8 * 64 * 128 + ((size_t)((seq - 2) * 8 + h) * 64 + p) * 128 : a.out + O_HP + (size_t)l * 2 * 8 * 64 * 128 + ((size_t)(seq * 8 + h) * 64 + p) * 128;
    o[lane] = h0; o[lane + 64] = h1;
}
__device__ __forceinline__ void ssm_out_row(const Args& a, int l, int row, int lane) {
    unsigned char* ws = a.ws; const u32x4 yw = *(const u32x4*)((const bf16_t*)(ws + WS_Y) + (size_t)row * 512 + 8 * lane);
    const u32x4 xw = *(const u32x4*)((const bf16_t*)(ws + WS_XC) + (size_t)row * 1024 + 8 * lane), zw = *(const u32x4*)((const bf16_t*)(ws + WS_ZS) + (size_t)row * 512 + 8 * lane);
    const f32x4 y0 = {bflo(yw.x), bfhi(yw.x), bflo(yw.y), bfhi(yw.y)}, y1 = {bflo(yw.z), bfhi(yw.z), bflo(yw.w), bfhi(yw.w)}; const float Dh = a.in[26][l * 8 + (lane >> 3)];
    float v[8];
    v[0] = (y0.x + Dh * bflo(xw.x)) * bflo(zw.x); v[1] = (y0.y + Dh * bfhi(xw.x)) * bfhi(zw.x); v[2] = (y0.z + Dh * bflo(xw.y)) * bflo(zw.y); v[3] = (y0.w + Dh * bfhi(xw.y)) * bfhi(zw.y);
    v[4] = (y1.x + Dh * bflo(xw.z)) * bflo(zw.z); v[5] = (y1.y + Dh * bfhi(xw.z)) * bfhi(zw.z); v[6] = (y1.z + Dh * bflo(xw.w)) * bflo(zw.w); v[7] = (y1.w + Dh * bfhi(xw.w)) * bfhi(zw.w);
    float s = 0.f;
#pragma unroll
    for (int k = 0; k < 8; ++k) s += v[k] * v[k];
    const float rs = rsqrtf(wsum(s) * (1.f / 512.f) + 1e-6f);
    const f32x4 g0 = *(const f32x4*)(a.in[27] + l * 512 + 8 * lane), g1 = *(const f32x4*)(a.in[27] + l * 512 + 8 * lane + 4);
    u32x4 w; w.x = pk2(v[0] * rs * g0.x, v[1] * rs * g0.y); w.y = pk2(v[2] * rs * g0.z, v[3] * rs * g0.w); w.z = pk2(v[4] * rs * g1.x, v[5] * rs * g1.y); w.w = pk2(v[6] * rs * g1.z, v[7] * rs * g1.w);
    *(u32x4*)((bf16_t*)(ws + WS_MIX) + (size_t)row * D + 512 + 8 * lane) = w;
}
#define MFMA16(a, b, c) __builtin_amdgcn_mfma_f32_16x16x32_bf16((a), (b), (c), 0, 0, 0)
__device__ __forceinline__ bf16x8 mk8(u32x4 v) { return __builtin_bit_cast(bf16x8, v); }
__device__ __forceinline__ bf16x8 mk8(u32x2 lo, u32x2 hi) { u32x4 v; v.x = lo.x; v.y = lo.y; v.z = hi.x; v.w = hi.y; return __builtin_bit_cast(bf16x8, v); }

__device__ __forceinline__ void dtslab_unit(const Args& a, int l, int unit, LAS unsigned char* lds, int tid) {
    unsigned char* ws = a.ws; const int lane = tid & 63, wave = __builtin_amdgcn_readfirstlane(tid >> 6), fr = lane & 15, gq = lane >> 4, rt = wave >> 1, kh = wave & 1;
    const size_t r0 = (size_t)unit * 64;
    LAS float* part = (LAS float*)lds;
    LAS float* dAs = part + 1024;
    const bf16_t* WB = (const bf16_t*)(ws + WS_WDTB) + (size_t)l * 16 * 1024 + fr * 1024 + 512 * kh + 8 * gq;
    const bf16_t* xr = (const bf16_t*)(ws + WS_XB) + (r0 + 16 * rt + fr) * D + 512 * kh + 8 * gq;
    u32x4 xa[16], wb[16];
#pragma unroll
    for (int ks = 0; ks < 16; ++ks) { xa[ks] = *(const u32x4*)(xr + 32 * ks); wb[ks] = *(const u32x4*)(WB + 32 * ks); }
    float rs_pre = rstd16((const float*)(ws + WS_SSQ) + (r0 + (tid >> 3)) * 16);
    float dtb_pre = a.in[24][l * 8 + (tid & 7)], alog_pre = a.in[25][l * 8 + (tid & 7)];
    asm volatile("" : "+v"(rs_pre), "+v"(dtb_pre), "+v"(alog_pre));
#pragma unroll
    for (int ks = 0; ks < 16; ks += 4) { asm volatile("" : "+v"(xa[ks]), "+v"(xa[ks + 1]), "+v"(xa[ks + 2]), "+v"(xa[ks + 3]), "+v"(wb[ks]), "+v"(wb[ks + 1]), "+v"(wb[ks + 2]), "+v"(wb[ks + 3])); }
    f32x4 acc = {0.f, 0.f, 0.f, 0.f};
#pragma unroll
    for (int ks = 0; ks < 16; ++ks) acc = MFMA16(mk8(xa[ks]), mk8(wb[ks]), acc);
    if (fr < 8) {
#pragma unroll
        for (int r = 0; r < 4; ++r) part[(kh * 64 + 16 * rt + 4 * gq + r) * 8 + fr] = acc[r]; }
    __syncthreads();
    { const int lr = tid >> 3, h = tid & 7; const size_t row = r0 + lr; const float rs = rs_pre;
      const float x = rs * (part[lr * 8 + h] + part[(64 + lr) * 8 + h]) + dtb_pre; const float dtv = fmaxf(x, 0.f) + log1pf(expf(-fabsf(x)));
      ((float*)(ws + WS_DT))[row * 8 + h] = dtv; dAs[lr * 8 + h] = dtv * -expf(alog_pre); }
    __syncthreads();
    if (wave == 0) { float* AC = (float*)(ws + WS_ACUM) + (r0 + lane) * 8; float* TOT = (float*)(ws + WS_TOT) + (size_t)unit * 8;
#pragma unroll
        for (int h = 0; h < 8; ++h) { float inc = dAs[lane * 8 + h];
#pragma unroll
            for (int o = 1; o < 64; o <<= 1) { const float t = __shfl_up(inc, o); if (lane >= o) inc += t; }
            AC[h] = inc; if (lane == 63) TOT[h] = inc; } }
    __syncthreads();
}
constexpr int SA_BM = 0, SA_XT = 69632, SA_XT2 = SA_XT + 33792, SA_AC = SA_XT2 + 33792;
#ifndef SSDA_R1
#define SSDA_R1 1
#endif
#ifndef SSDA_R2
#define SSDA_R2 1
#endif
__device__ __forceinline__ void ssdA_pair(const Args& a, int l, int pu, LAS unsigned char* lds, int tid) {
    unsigned char* ws = a.ws; const int lane = tid & 63, wave = __builtin_amdgcn_readfirstlane(tid >> 6), fr = lane & 15, gq = lane >> 4;
    const int hp = pu & 3, g = hp >> 1, bc = pu >> 2; const size_t r0 = (size_t)bc * 256;
    const bf16_t* XC = (const bf16_t*)(ws + WS_XC); const float* DT = (const float*)(ws + WS_DT); const float* ACUM = (const float*)(ws + WS_ACUM);
    LAS bf16_t* Bm = (LAS bf16_t*)(lds + SA_BM); LAS bf16_t* XT = (LAS bf16_t*)(lds + SA_XT); LAS bf16_t* XT2 = (LAS bf16_t*)(lds + SA_XT2); LAS float* acs = (LAS float*)(lds + SA_AC);
    u32x4 cpre[2][4];
#pragma unroll
    for (int which = 0; which < 2; ++which)
#pragma unroll
        for (int kk = 0; kk < 4; ++kk) cpre[which][kk] = *(const u32x4*)(XC + (r0 + 16 * (which ? 15 - wave : wave) + fr) * 1024 + 768 + g * 128 + 32 * kk + 8 * gq);
    u32x4 bst[8];
#pragma unroll
    for (int pass = 0; pass < 8; ++pass) { const int row = pass * 32 + (tid >> 4), ch = tid & 15; bst[pass] = *(const u32x4*)(XC + (r0 + row) * 1024 + 512 + g * 128 + 8 * ch); }
    float tt[2][4]; u32x4 xvq[2][4]; float dtq[2][4], acq[2][4];
#pragma unroll
    for (int hh = 0; hh < 2; ++hh) { const int h = 2 * hp + hh; const float* TOT = (const float*)(ws + WS_TOT) + (size_t)bc * 4 * 8 + h;
        tt[hh][0] = TOT[0]; tt[hh][1] = TOT[8]; tt[hh][2] = TOT[16]; tt[hh][3] = TOT[24];
#pragma unroll
        for (int pass = 0; pass < 4; ++pass) { const int s = pass * 64 + lane; xvq[hh][pass] = *(const u32x4*)(XC + (r0 + s) * 1024 + h * 64 + 8 * wave); dtq[hh][pass] = DT[(r0 + s) * 8 + h]; acq[hh][pass] = ACUM[(r0 + s) * 8 + h]; } }
    asm volatile("" : "+v"(bst[0]), "+v"(bst[1]), "+v"(bst[2]), "+v"(bst[3]), "+v"(bst[4]), "+v"(bst[5]), "+v"(bst[6]), "+v"(bst[7]), "+v"(tt[0][0]), "+v"(tt[0][1]), "+v"(tt[0][2]), "+v"(tt[0][3]), "+v"(tt[1][0]), "+v"(tt[1][1]), "+v"(tt[1][2]), "+v"(tt[1][3]));
#pragma unroll
    for (int hh = 0; hh < 2; ++hh) asm volatile("" : "+v"(xvq[hh][0]), "+v"(xvq[hh][1]), "+v"(xvq[hh][2]), "+v"(xvq[hh][3]), "+v"(dtq[hh][0]), "+v"(dtq[hh][1]), "+v"(dtq[hh][2]), "+v"(dtq[hh][3]), "+v"(acq[hh][0]), "+v"(acq[hh][1]), "+v"(acq[hh][2]), "+v"(acq[hh][3]));
#pragma unroll
    for (int pass = 0; pass < 8; ++pass) { const int row = pass * 32 + (tid >> 4), ch = tid & 15; *(LAS u32x4*)(Bm + row * 136 + 8 * ch) = bst[pass]; }
#pragma unroll
    for (int hh = 0; hh < 2; ++hh) { const int h = 2 * hp + hh, unit = bc * 8 + h;
        if (hh) __syncthreads();
        const float t0 = tt[hh][0], t1 = tt[hh][1], t2 = tt[hh][2], t3 = tt[hh][3]; const float ac_end = ((t0 + t1) + t2) + t3;
        if (tid == 0) ((float*)(ws + WS_CT))[unit] = ac_end;
#pragma unroll
        for (int pass = 0; pass < 4; ++pass) { const int s = pass * 64 + lane;
            const u32x4 v = xvq[hh][pass]; const float dtv = dtq[hh][pass], acv = acq[hh][pass] + (pass == 0 ? 0.f : pass == 1 ? t0 : pass == 2 ? (t0 + t1) : ((t0 + t1) + t2)); const float e = expf(ac_end - acv);
            if (wave == 0) acs[s] = acv;
            float x[8]; x[0] = bflo(v.x); x[1] = bfhi(v.x); x[2] = bflo(v.y); x[3] = bfhi(v.y); x[4] = bflo(v.z); x[5] = bfhi(v.z); x[6] = bflo(v.w); x[7] = bfhi(v.w);
#pragma unroll
            for (int i = 0; i < 8; ++i) { const float xd = x[i] * dtv; const unsigned w = pk2(xd, xd * e); XT[(8 * wave + i) * 264 + s] = (bf16_t)(w & 0xffffu); XT2[(8 * wave + i) * 264 + s] = (bf16_t)(w >> 16); } }
        __syncthreads();
        for (int rr1_ = 0; rr1_ < SSDA_R1; ++rr1_) { f32x4 acc[4];
#pragma unroll
          for (int pt = 0; pt < 4; ++pt) acc[pt] = (f32x4){0.f, 0.f, 0.f, 0.f};
#pragma unroll 2
          for (int ks = 0; ks < 8; ++ks) { const LAS bf16_t* bp = Bm + (32 * ks + 8 * gq) * 136 + 16 * wave + fr;
              u32x4 av; av.x = (unsigned)bp[0] | ((unsigned)bp[136] << 16); av.y = (unsigned)bp[2 * 136] | ((unsigned)bp[3 * 136] << 16); av.z = (unsigned)bp[4 * 136] | ((unsigned)bp[5 * 136] << 16); av.w = (unsigned)bp[6 * 136] | ((unsigned)bp[7 * 136] << 16);
              const bf16x8 A = mk8(av);
#pragma unroll
              for (int pt = 0; pt < 4; ++pt) { const bf16x8 Bf = mk8(*(const LAS u32x4*)(XT2 + (16 * pt + fr) * 264 + 32 * ks + 8 * gq)); acc[pt] = MFMA16(A, Bf, acc[pt]); } }
          float* ST = (float*)(ws + WS_ST) + (size_t)unit * 8192;
#pragma unroll
          for (int pt = 0; pt < 4; ++pt) *(f32x4*)(ST + (16 * pt + fr) * 128 + 16 * wave + 4 * gq) = acc[pt]; }
        bf16_t* Y = (bf16_t*)(ws + WS_Y);
        for (int rr2_ = 0; rr2_ < SSDA_R2; ++rr2_)
#pragma unroll
        for (int which = 0; which < 2; ++which) { const int lt = which ? 15 - wave : wave, lrow = 16 * lt + fr; const size_t row = r0 + lrow;
            bf16x8 cf[4];
#pragma unroll
            for (int kk = 0; kk < 4; ++kk) cf[kk] = mk8(cpre[which][kk]);
            const float acl = acs[lrow];
            f32x4 yacc[4];
#pragma unroll
            for (int pt = 0; pt < 4; ++pt) yacc[pt] = (f32x4){0.f, 0.f, 0.f, 0.f};
            const int nblk = (lt >> 1) + 1;
#pragma unroll 1
            for (int sb = 0; sb < nblk; ++sb) { const int s0 = 32 * sb;
                f32x4 T0 = {0.f, 0.f, 0.f, 0.f}, T1 = {0.f, 0.f, 0.f, 0.f};
#pragma unroll
                for (int kk = 0; kk < 4; ++kk) { const bf16x8 A0 = mk8(*(const LAS u32x4*)(Bm + (s0 + fr) * 136 + 32 * kk + 8 * gq)), A1 = mk8(*(const LAS u32x4*)(Bm + (s0 + 16 + fr) * 136 + 32 * kk + 8 * gq));
                    T0 = MFMA16(A0, cf[kk], T0); T1 = MFMA16(A1, cf[kk], T1); }
                const f32x4 as0 = *(const LAS f32x4*)(acs + s0 + 4 * gq), as1 = *(const LAS f32x4*)(acs + s0 + 16 + 4 * gq);
                float pv[8];
#pragma unroll
                for (int r = 0; r < 4; ++r) { const int sa = s0 + 4 * gq + r; pv[r] = (sa <= lrow) ? T0[r] * fexp(acl - as0[r]) : 0.f; pv[4 + r] = (sa + 16 <= lrow) ? T1[r] * fexp(acl - as1[r]) : 0.f; }
                u32x4 pw; pw.x = pk2(pv[0], pv[1]); pw.y = pk2(pv[2], pv[3]); pw.z = pk2(pv[4], pv[5]); pw.w = pk2(pv[6], pv[7]);
                const bf16x8 P = mk8(pw);
#pragma unroll
                for (int pt = 0; pt < 4; ++pt) { const LAS bf16_t* xp = XT + (16 * pt + fr) * 264 + s0 + 4 * gq;
                    const bf16x8 Af = mk8(*(const LAS u32x2*)xp, *(const LAS u32x2*)(xp + 16)); yacc[pt] = MFMA16(Af, P, yacc[pt]); } }
#pragma unroll
            for (int pt = 0; pt < 4; ++pt) { u32x2 w; w.x = pk2(yacc[pt].x, yacc[pt].y); w.y = pk2(yacc[pt].z, yacc[pt].w); *(u32x2*)(Y + row * 512 + h * 64 + 16 * pt + 4 * gq) = w; } }

    }
    __syncthreads();
}
__device__ __forceinline__ void ssd_scan(const Args& a, int l, int gtid, int gthreads) {
    unsigned char* ws = a.ws; const float* ST = (const float*)(ws + WS_ST); bf16_t* HIN = (bf16_t*)(ws + WS_HIN); const float* CT = (const float*)(ws + WS_CT);
    for (int e = gtid; e < 2 * 8 * 8192; e += gthreads) { const int b = e >> 16, h = (e >> 13) & 7, pn = e & 8191; float hs = 0.f;
        const size_t o0 = ((size_t)(b * 32) * 8 + h) * 8192 + pn;
#pragma unroll 1
        for (int c0 = 0; c0 < 32; c0 += 16) { float st[16], dc[16];
#pragma unroll
            for (int c = 0; c < 16; ++c) { st[c] = ST[o0 + (size_t)(c0 + c) * 65536]; dc[c] = CT[(b * 32 + c0 + c) * 8 + h]; }
#pragma unroll
            for (int c = 0; c < 16; c += 8) { asm volatile("" : "+v"(st[c]), "+v"(st[c + 1]), "+v"(st[c + 2]), "+v"(st[c + 3]), "+v"(st[c + 4]), "+v"(st[c + 5]), "+v"(st[c + 6]), "+v"(st[c + 7]), "+v"(dc[c]), "+v"(dc[c + 1]), "+v"(dc[c + 2]), "+v"(dc[c + 3]), "+v"(dc[c + 4]), "+v"(dc[c + 5]), "+v"(dc[c + 6]), "+v"(dc[c + 7])); }
#pragma unroll
            for (int c = 0; c < 16; ++c) { HIN[o0 + (size_t)(c0 + c) * 65536] = (bf16_t)(pk2(hs, 0.f) & 0xffffu); hs = fmaf(hs, fexp(dc[c]), st[c]); } }
        a.out[O_HP + (size_t)l * 2 * 8 * 8192 + (size_t)(b * 8 + h) * 8192 + pn] = hs; }
}
__device__ __forceinline__ void ssdC_unit(const Args& a, int l, int unit, LAS unsigned char* lds, int tid) {
    unsigned char* ws = a.ws; const int lane = tid & 63, h = __builtin_amdgcn_readfirstlane(tid >> 6), fr = lane & 15, gq = lane >> 4, g = h >> 2;
    const int bc = unit >> 2; const size_t r0 = (size_t)bc * 256 + (unit & 3) * 64;
    const bf16_t* XC = (const bf16_t*)(ws + WS_XC); const bf16_t* ZS = (const bf16_t*)(ws + WS_ZS); const bf16_t* Y = (const bf16_t*)(ws + WS_Y); const float* ACUM = (const float*)(ws + WS_ACUM);
    const bf16_t* HIN = (const bf16_t*)(ws + WS_HIN) + ((size_t)bc * 8 + h) * 8192;
    LAS float* red = (LAS float*)lds;
    bf16x8 hf[4][4];
#pragma unroll
    for (int pt = 0; pt < 4; ++pt)
#pragma unroll
        for (int kk = 0; kk < 4; ++kk) hf[pt][kk] = mk8(*(const u32x4*)(HIN + (16 * pt + fr) * 128 + 32 * kk + 8 * gq));
    const float Dh = a.in[26][l * 8 + h];
    float pre = 0.f; { const float* tp = (const float*)(ws + WS_TOT) + (size_t)(bc * 4) * 8 + h; const int j = unit & 3; if (j > 0) pre += tp[0]; if (j > 1) pre += tp[8]; if (j > 2) pre += tp[16]; }
    f32x4 v[4][4];
#pragma unroll
    for (int lt = 0; lt < 4; ++lt) { const size_t row = r0 + 16 * lt + fr;
        u32x4 cw[4]; u32x2 yw[4], xw[4], zw[4]; float acv = ACUM[row * 8 + h];
#pragma unroll
        for (int kk = 0; kk < 4; ++kk) cw[kk] = *(const u32x4*)(XC + row * 1024 + 768 + g * 128 + 32 * kk + 8 * gq);
#pragma unroll
        for (int pt = 0; pt < 4; ++pt) { const int p0 = h * 64 + 16 * pt + 4 * gq; yw[pt] = *(const u32x2*)(Y + row * 512 + p0); xw[pt] = *(const u32x2*)(XC + row * 1024 + p0); zw[pt] = *(const u32x2*)(ZS + row * 512 + p0); }
        asm volatile("" : "+v"(cw[0]), "+v"(cw[1]), "+v"(cw[2]), "+v"(cw[3]), "+v"(yw[0]), "+v"(yw[1]), "+v"(yw[2]), "+v"(yw[3]), "+v"(xw[0]), "+v"(xw[1]), "+v"(xw[2]), "+v"(xw[3]), "+v"(zw[0]), "+v"(zw[1]), "+v"(zw[2]), "+v"(zw[3]), "+v"(acv));
        f32x4 yacc[4];
#pragma unroll
        for (int pt = 0; pt < 4; ++pt) { yacc[pt] = (f32x4){0.f, 0.f, 0.f, 0.f};
#pragma unroll
            for (int kk = 0; kk < 4; ++kk) yacc[pt] = MFMA16(hf[pt][kk], mk8(cw[kk]), yacc[pt]); }
        const float el = expf(acv + pre); float ss = 0.f;
#pragma unroll
        for (int pt = 0; pt < 4; ++pt) { const f32x4 yv = {bflo(yw[pt].x), bfhi(yw[pt].x), bflo(yw[pt].y), bfhi(yw[pt].y)};
            f32x4 t; t.x = (yacc[pt].x * el + yv.x + Dh * bflo(xw[pt].x)) * bflo(zw[pt].x); t.y = (yacc[pt].y * el + yv.y + Dh * bfhi(xw[pt].x)) * bfhi(zw[pt].x);
            t.z = (yacc[pt].z * el + yv.z + Dh * bflo(xw[pt].y)) * bflo(zw[pt].y); t.w = (yacc[pt].w * el + yv.w + Dh * bfhi(xw[pt].y)) * bfhi(zw[pt].y);
            v[lt][pt] = t; ss += (t.x * t.x + t.y * t.y) + (t.z * t.z + t.w * t.w); }
        ss += __shfl_xor(ss, 16); ss += __shfl_xor(ss, 32);
        if (gq == 0) red[h * 64 + 16 * lt + fr] = ss; }
    const float* gn = a.in[27] + l * 512; f32x4 ggp[4];
#pragma unroll
    for (int pt = 0; pt < 4; ++pt) ggp[pt] = *(const f32x4*)(gn + h * 64 + 16 * pt + 4 * gq);
    __syncthreads();
#pragma unroll
    for (int lt = 0; lt < 4; ++lt) { const int lr = 16 * lt + fr; const size_t row = r0 + lr; float tot = 0.f;
#pragma unroll
        for (int hh = 0; hh < 8; ++hh) tot += red[hh * 64 + lr];
        const float rs = rsqrtf(tot * (1.f / 512.f) + 1e-6f);
#pragma unroll
        for (int pt = 0; pt < 4; ++pt) { const int p0 = h * 64 + 16 * pt + 4 * gq; const f32x4 o = v[lt][pt] * rs * ggp[pt];
            u32x2 w; w.x = pk2(o.x, o.y); w.y = pk2(o.z, o.w); *(u32x2*)((bf16_t*)(ws + WS_MIX) + row * D + 512 + p0) = w; } }
    __syncthreads();
}

__device__ __forceinline__ void ssd_sample_unit(const Args& a, int l, int unit, int tid) {
    unsigned char* ws = a.ws; const int sb = unit >> 3, h = unit & 7, g = h >> 2, p = tid >> 3, nq = tid & 7; const size_t row = (size_t)MPR + sb;
    const bf16_t* xc = (const bf16_t*)(ws + WS_XC) + row * 1024; float dtv = ((const float*)(ws + WS_DT))[row * 8 + h]; float alog = a.in[25][l * 8 + h]; unsigned xraw = (unsigned)xc[h * 64 + p];
    const float* s = a.in[6] + (((size_t)l * 32 + sb) * 8 + h) * 8192 + p * 128 + 16 * nq; float* o = a.out + O_HS + (((size_t)l * 32 + sb) * 8 + h) * 8192 + p * 128 + 16 * nq;
    u32x4 b0 = *(const u32x4*)(xc + 512 + g * 128 + 16 * nq), b1 = *(const u32x4*)(xc + 512 + g * 128 + 16 * nq + 8), c0 = *(const u32x4*)(xc + 768 + g * 128 + 16 * nq), c1 = *(const u32x4*)(xc + 768 + g * 128 + 16 * nq + 8);
    f32x4 hvp[4];
#pragma unroll
    for (int q = 0; q < 4; ++q) hvp[q] = *(const f32x4*)(s + 4 * q);
    asm volatile("" : "+v"(dtv), "+v"(alog), "+v"(xraw), "+v"(b0), "+v"(b1), "+v"(c0), "+v"(c1), "+v"(hvp[0]), "+v"(hvp[1]), "+v"(hvp[2]), "+v"(hvp[3]));
    const float dA = expf(dtv * -expf(alog)), xd = dtv * __uint_as_float(xraw << 16);
    float Bv[16], Cv[16];
    Bv[0] = bflo(b0.x); Bv[1] = bfhi(b0.x); Bv[2] = bflo(b0.y); Bv[3] = bfhi(b0.y); Bv[4] = bflo(b0.z); Bv[5] = bfhi(b0.z); Bv[6] = bflo(b0.w); Bv[7] = bfhi(b0.w);
    Bv[8] = bflo(b1.x); Bv[9] = bfhi(b1.x); Bv[10] = bflo(b1.y); Bv[11] = bfhi(b1.y); Bv[12] = bflo(b1.z); Bv[13] = bfhi(b1.z); Bv[14] = bflo(b1.w); Bv[15] = bfhi(b1.w);
    Cv[0] = bflo(c0.x); Cv[1] = bfhi(c0.x); Cv[2] = bflo(c0.y); Cv[3] = bfhi(c0.y); Cv[4] = bflo(c0.z); Cv[5] = bfhi(c0.z); Cv[6] = bflo(c0.w); Cv[7] = bfhi(c0.w);
    Cv[8] = bflo(c1.x); Cv[9] = bfhi(c1.x); Cv[10] = bflo(c1.y); Cv[11] = bfhi(c1.y); Cv[12] = bflo(c1.z); Cv[13] = bfhi(c1.z); Cv[14] = bflo(c1.w); Cv[15] = bfhi(c1.w);
    float y = 0.f;
#pragma unroll
    for (int q = 0; q < 4; ++q) { const f32x4 hv = hvp[q]; f32x4 hn;
        hn.x = fmaf(hv.x, dA, xd * Bv[4 * q]); hn.y = fmaf(hv.y, dA, xd * Bv[4 * q + 1]); hn.z = fmaf(hv.z, dA, xd * Bv[4 * q + 2]); hn.w = fmaf(hv.w, dA, xd * Bv[4 * q + 3]);
        *(f32x4*)(o + 4 * q) = hn; y += (Cv[4 * q] * hn.x + Cv[4 * q + 1] * hn.y) + (Cv[4 * q + 2] * hn.z + Cv[4 * q + 3] * hn.w); }
    y += __shfl_xor(y, 1); y += __shfl_xor(y, 2); y += __shfl_xor(y, 4);
    if (nq == 0) ((bf16_t*)(ws + WS_Y))[row * 512 + h * 64 + p] = (bf16_t)(pk2(y, 0.f) & 0xffffu);
}

__device__ __forceinline__ void skinny_partial(const bf16_t* __restrict__ A  , const bf16_t* __restrict__ Bt  , int K, int item, LAS unsigned char* lds, int tid, float* parts) {
    const int lane = tid & 63, wave = __builtin_amdgcn_readfirstlane(tid >> 6), fr = lane & 15, gq = lane >> 4;
    const int u = item & 15, s = item >> 4, nks = K >> 5, k0 = (nks * s) >> 4, k1 = (nks * (s + 1)) >> 4, ks = k0 + wave;
    f32x4 acc[2][4];
#pragma unroll
    for (int rt = 0; rt < 2; ++rt)
#pragma unroll
        for (int ct = 0; ct < 4; ++ct) acc[rt][ct] = (f32x4){0.f, 0.f, 0.f, 0.f};
    if (ks < k1) {
        const bf16_t* a0 = A + (size_t)fr * K + 32 * ks + 8 * gq; const bf16_t* bp = Bt + (size_t)(64 * u + fr) * K + 32 * ks + 8 * gq;
        u32x4 xa0 = *(const u32x4*)a0, xa1 = *(const u32x4*)(a0 + (size_t)16 * K), wb[4];
#pragma unroll
        for (int ct = 0; ct < 4; ++ct) wb[ct] = *(const u32x4*)(bp + (size_t)(16 * ct) * K);
        asm volatile("" : "+v"(xa0), "+v"(xa1), "+v"(wb[0]), "+v"(wb[1]), "+v"(wb[2]), "+v"(wb[3]));
#pragma unroll
        for (int ct = 0; ct < 4; ++ct) { acc[0][ct] = MFMA16(mk8(wb[ct]), mk8(xa0), acc[0][ct]); acc[1][ct] = MFMA16(mk8(wb[ct]), mk8(xa1), acc[1][ct]); }
    }
    LAS float* red = (LAS float*)lds;
#pragma unroll
    for (int rt = 0; rt < 2; ++rt)
#pragma unroll
        for (int ct = 0; ct < 4; ++ct) *(LAS f32x4*)(red + ((wave * 32 + 16 * rt + fr) * 64 + 16 * ct + 4 * gq)) = acc[rt][ct];
    __syncthreads();
    const int row = tid >> 4, c4 = (tid & 15) * 4;
    { f32x4 v = {0.f, 0.f, 0.f, 0.f};
#pragma unroll
      for (int w = 0; w < 8; ++w) v += *(const LAS f32x4*)(red + ((w * 32 + row) * 64 + c4));
      float* pp = parts + ((size_t)(u * 16 + s) * 32 + row) * 64 + c4;
      __hip_atomic_store(pp + 0, v.x, __ATOMIC_RELAXED, __HIP_MEMORY_SCOPE_AGENT); __hip_atomic_store(pp + 1, v.y, __ATOMIC_RELAXED, __HIP_MEMORY_SCOPE_AGENT);
      __hip_atomic_store(pp + 2, v.z, __ATOMIC_RELAXED, __HIP_MEMORY_SCOPE_AGENT); __hip_atomic_store(pp + 3, v.w, __ATOMIC_RELAXED, __HIP_MEMORY_SCOPE_AGENT); }
    __syncthreads();
}
__device__ __forceinline__ void skinny_final(int item, const float* xold  , bf16_t* XB, float* SSQ, float alpha, LAS unsigned char* lds, int tid, float* parts, unsigned* cnt,
                                             const float* nssq = nullptr, const float* gsc = nullptr, float* SSQG = nullptr) {
    const int u = item & 15, row = tid >> 4, c4 = (tid & 15) * 4;
    LAS unsigned* flag = (LAS unsigned*)(lds + RING_BYTES);
    asm volatile("s_waitcnt vmcnt(0)" ::: "memory");
    __syncthreads();
    if (tid == 0) *flag = atomicAdd(cnt + 64 * u, 1u)    ;
    __syncthreads();
    const bool last = (*flag == 15u);
    if (last) {
        const size_t o = (size_t)row * D + 64 * u + c4;
        f32x4 pv[16]; f32x4 xo4 = {0.f, 0.f, 0.f, 0.f}; u32x2 xw = {0u, 0u}; float rn = 1.f;
#pragma unroll
        for (int s2 = 0; s2 < 16; ++s2) { float* pp = parts + ((size_t)(u * 16 + s2) * 32 + row) * 64 + c4;
            pv[s2].x = __hip_atomic_load(pp + 0, __ATOMIC_RELAXED, __HIP_MEMORY_SCOPE_AGENT); pv[s2].y = __hip_atomic_load(pp + 1, __ATOMIC_RELAXED, __HIP_MEMORY_SCOPE_AGENT);
            pv[s2].z = __hip_atomic_load(pp + 2, __ATOMIC_RELAXED, __HIP_MEMORY_SCOPE_AGENT); pv[s2].w = __hip_atomic_load(pp + 3, __ATOMIC_RELAXED, __HIP_MEMORY_SCOPE_AGENT); }
        if (xold) xo4 = *(const f32x4*)(xold + o); else { xw = *(const u32x2*)(XB + o); if (nssq) rn = rstd16(nssq + (size_t)row * 16); }
        asm volatile("" : "+v"(pv[0]), "+v"(pv[1]), "+v"(pv[2]), "+v"(pv[3]), "+v"(pv[4]), "+v"(pv[5]), "+v"(pv[6]), "+v"(pv[7]), "+v"(pv[8]), "+v"(pv[9]), "+v"(pv[10]), "+v"(pv[11]), "+v"(pv[12]), "+v"(pv[13]), "+v"(pv[14]), "+v"(pv[15]), "+v"(xo4), "+v"(xw), "+v"(rn));
        f32x4 v = pv[0];
#pragma unroll
        for (int s2 = 1; s2 < 16; ++s2) v += pv[s2];
        f32x4 xo = xo4; if (!xold) xo = (f32x4){bflo(xw.x), bfhi(xw.x), bflo(xw.y), bfhi(xw.y)} * rn;
        const f32x4 xn = xo + alpha * v;
        f32x4 xb = xn; if (gsc) xb = xn * *(const f32x4*)(gsc + 64 * u + c4);
        u32x2 w2; w2.x = pk2(xb.x, xb.y); w2.y = pk2(xb.z, xb.w); *(u32x2*)(XB + o) = w2;
        float ss = (xn.x * xn.x + xn.y * xn.y) + (xn.z * xn.z + xn.w * xn.w), sg = (xb.x * xb.x + xb.y * xb.y) + (xb.z * xb.z + xb.w * xb.w);
        ss += __shfl_xor(ss, 1); ss += __shfl_xor(ss, 2); ss += __shfl_xor(ss, 4); ss += __shfl_xor(ss, 8);
        sg += __shfl_xor(sg, 1); sg += __shfl_xor(sg, 2); sg += __shfl_xor(sg, 4); sg += __shfl_xor(sg, 8);
        if ((tid & 15) == 0) { SSQ[(size_t)row * 16 + u] = ss; if (gsc) SSQG[(size_t)row * 16 + u] = sg; } }
    __syncthreads();
}
__device__ __forceinline__ void sel_unit(const Args& a, int unit, LAS unsigned char* lds, int tid) {
    unsigned char* ws = a.ws; const int hp = unit & 1, cur = (unit >> 1) & 31, b = unit >> 6, r = tid & 255, hh = tid >> 8, h = 2 * hp + hh;
    const size_t m = (size_t)b * SEQ + cur * 256 + r;
    LAS float* km = (LAS float*)lds;
    const float* KMP = (const float*)(ws + WS_KMP) + (size_t)b * 32 * 256 + hp * 128;
    for (int i = tid; i < cur * 32; i += NTHR) { const int n = i >> 5, c4 = i & 31; *(LAS f32x4*)(km + n * 128 + 4 * c4) = *(const f32x4*)(KMP + n * 256 + 4 * c4); }
    float q[64];
    { const bf16_t* qp = (const bf16_t*)(ws + WS_QB) + m * 256 + h * 64;
#pragma unroll
      for (int j = 0; j < 8; ++j) { const u32x4 w = *(const u32x4*)(qp + 8 * j); q[8 * j] = bflo(w.x); q[8 * j + 1] = bfhi(w.x); q[8 * j + 2] = bflo(w.y); q[8 * j + 3] = bfhi(w.y); q[8 * j + 4] = bflo(w.z); q[8 * j + 5] = bfhi(w.z); q[8 * j + 6] = bflo(w.w); q[8 * j + 7] = bfhi(w.w); } }
    __syncthreads();
    float v0 = -INFINITY, v1 = -INFINITY, v2 = -INFINITY; int i0 = 0, i1 = 0, i2 = 0;
    for (int n = 0; n < cur; ++n) { const LAS float* kp = km + n * 128 + hh * 64; float g0 = 0.f, g1 = 0.f;
#pragma unroll
        for (int j = 0; j < 16; j += 2) { const f32x4 ka = *(const LAS f32x4*)(kp + 4 * j), kb = *(const LAS f32x4*)(kp + 4 * j + 4);
            g0 = fmaf(q[4 * j], ka.x, g0); g0 = fmaf(q[4 * j + 1], ka.y, g0); g0 = fmaf(q[4 * j + 2], ka.z, g0); g0 = fmaf(q[4 * j + 3], ka.w, g0);
            g1 = fmaf(q[4 * j + 4], kb.x, g1); g1 = fmaf(q[4 * j + 5], kb.y, g1); g1 = fmaf(q[4 * j + 6], kb.z, g1); g1 = fmaf(q[4 * j + 7], kb.w, g1); }
        const float gv = g0 + g1;
        if (gv > v0) { v2 = v1; i2 = i1; v1 = v0; i1 = i0; v0 = gv; i0 = n; } else if (gv > v1) { v2 = v1; i2 = i1; v1 = gv; i1 = n; } else if (gv > v2) { v2 = gv; i2 = n; } }
    const int cnt = cur < 3 ? cur : 3;
    ((unsigned*)(ws + WS_SEL))[m * 4 + h] = (unsigned)i0 | ((unsigned)i1 << 8) | ((unsigned)i2 << 16) | ((unsigned)cnt << 24);
    __syncthreads();
}
__device__ const unsigned ATT_TAB[32][2] = {{1049861u,0u},{1968650u,0u},{1705730u,0u},{1771785u,0u},{1180929u,0u},{852996u,0u},{1574920u,0u},{918528u,0u},{2099979u,0u},{1378055u,0u},{262144u,0u},{656131u,0u},{1181190u,0u},{459266u,0u},{2100236u,0u},{327937u,0u},{2099715u,0u},{2100493u,0u},{2100750u,2104842u},{2101007u,2104073u},{2101264u,2103810u},{2100484u,2103304u},{2101521u,2105119u},{2101778u,2104862u},{2100736u,2104605u},{2102035u,2102535u},{2102292u,2104348u},{2102549u,2104091u},{2101253u,2103834u},{2102806u,2103577u},{2103063u,2103320u},{2101761u,2101766u}};
constexpr int AT_KM = 0, AT_VT = 36864, AT_BT = AT_VT + 33792, AT_QL = AT_BT + 1024, AT_WC = AT_QL + 16384, AT_NC = 8;
__device__ __forceinline__ void attn_slot(const Args& a, int sidx, LAS unsigned char* lds, int tid) {
    unsigned char* ws = a.ws; const int lane = tid & 63, wave = __builtin_amdgcn_readfirstlane(tid >> 6), fr = lane & 15, gq = lane >> 4;
    const int bh = sidx & 7, b = bh >> 2, h = bh & 3, slot_i = sidx >> 3;
    LAS bf16_t* Km = (LAS bf16_t*)(lds + AT_KM); LAS bf16_t* VT = (LAS bf16_t*)(lds + AT_VT); LAS float* BTs = (LAS float*)(lds + AT_BT); LAS unsigned* ql = (LAS unsigned*)(lds + AT_QL); LAS int* wc = (LAS int*)(lds + AT_WC);
    const bf16_t* KB = (const bf16_t*)(ws + WS_KB); const bf16_t* VB = (const bf16_t*)(ws + WS_VB); const bf16_t* QB = (const bf16_t*)(ws + WS_QB);
    if (tid < 129) BTs[tid] = ((const float*)(ws + WS_BT))[h * 129 + tid];
#pragma unroll 1
    for (int it = 0; it < 2; ++it) { const unsigned tw = ATT_TAB[slot_i][it]; const int n = (int)(tw & 255u), lo = (int)((tw >> 8) & 255u), hi = (int)(tw >> 16);
      if (hi <= lo) continue;
      const size_t kr0 = (size_t)b * SEQ + n * 256;
      u32x4 kst[4], vst[4];
#pragma unroll
      for (int pass = 0; pass < 4; ++pass) { kst[pass] = *(const u32x4*)(KB + (kr0 + pass * 64 + (tid >> 3)) * 256 + h * 64 + 8 * (tid & 7)); vst[pass] = *(const u32x4*)(VB + (kr0 + pass * 64 + lane) * 256 + h * 64 + 8 * wave); }
      asm volatile("" : "+v"(kst[0]), "+v"(kst[1]), "+v"(kst[2]), "+v"(kst[3]), "+v"(vst[0]), "+v"(vst[1]), "+v"(vst[2]), "+v"(vst[3]));
#pragma unroll
      for (int pass = 0; pass < 4; ++pass) { const int key = pass * 64 + (tid >> 3), ch = tid & 7; *(LAS u32x4*)(Km + key * 72 + 8 * ch) = kst[pass]; }
#pragma unroll
      for (int pass = 0; pass < 4; ++pass) { const int key = pass * 64 + lane; const u32x4 v = vst[pass];
          LAS bf16_t* vp = VT + (8 * wave) * 264 + key;
          vp[0] = (bf16_t)(v.x & 0xffffu); vp[264] = (bf16_t)(v.x >> 16); vp[2 * 264] = (bf16_t)(v.y & 0xffffu); vp[3 * 264] = (bf16_t)(v.y >> 16);
          vp[4 * 264] = (bf16_t)(v.z & 0xffffu); vp[5 * 264] = (bf16_t)(v.z >> 16); vp[6 * 264] = (bf16_t)(v.w & 0xffffu); vp[7 * 264] = (bf16_t)(v.w >> 16); }
#pragma unroll 1
      for (int c0 = lo * 256; c0 < hi * 256; c0 += 512 * AT_NC) {
        bool hit[AT_NC]; unsigned ent[AT_NC], sv[AT_NC];
#pragma unroll
        for (int k = 0; k < AT_NC; ++k) { const int t = c0 + 512 * k + tid; sv[k] = 0u; if (t < hi * 256 && (t >> 8) != n) sv[k] = ((const unsigned*)(ws + WS_SEL))[((size_t)b * SEQ + t) * 4 + h]; }
        asm volatile("" : "+v"(sv[0]), "+v"(sv[1]), "+v"(sv[2]), "+v"(sv[3]), "+v"(sv[4]), "+v"(sv[5]), "+v"(sv[6]), "+v"(sv[7]));
#pragma unroll
        for (int k = 0; k < AT_NC; ++k) { const int t = c0 + 512 * k + tid; hit[k] = false; ent[k] = 0u;
            if (t < hi * 256) { const int cb = t >> 8;
                if (cb == n) { hit[k] = true; ent[k] = (unsigned)t | (3u << 16); }
                else { const unsigned s = sv[k]; const unsigned cnt = s >> 24;
                    if (cnt > 0 && (s & 255u) == (unsigned)n) { hit[k] = true; ent[k] = (unsigned)t; } else if (cnt > 1 && ((s >> 8) & 255u) == (unsigned)n) { hit[k] = true; ent[k] = (unsigned)t | (1u << 16); } else if (cnt > 2 && ((s >> 16) & 255u) == (unsigned)n) { hit[k] = true; ent[k] = (unsigned)t | (2u << 16); } } } }
        unsigned long long bal[AT_NC]; const unsigned long long below = (1ull << lane) - 1ull;
#pragma unroll
        for (int k = 0; k < AT_NC; ++k) { bal[k] = __ballot(hit[k]); if (lane == 0) wc[8 * k + wave] = __popcll(bal[k]); }
        __syncthreads();
        int run = 0, mine[AT_NC];
#pragma unroll
        for (int w = 0; w < 8 * AT_NC; ++w) { if ((w & 7) == wave) mine[w >> 3] = run; run += wc[w]; }
        const int tot = run;
#pragma unroll
        for (int k = 0; k < AT_NC; ++k) if (hit[k]) ql[mine[k] + __popcll(bal[k] & below)] = ent[k];
        const int nq = tot; __syncthreads();
#ifndef AT_RT
#define AT_RT 1
#endif
        for (int rrt_ = 0; rrt_ < AT_RT; ++rrt_) {
        const float bfar = BTs[128];
        unsigned e_n = 0u; u32x4 qn0 = {0u, 0u, 0u, 0u}, qn1 = {0u, 0u, 0u, 0u};
        if (wave * 16 < nq) { const int qi = 16 * wave + fr; e_n = ql[qi < nq ? qi : 16 * wave]; const bf16_t* qp = QB + ((size_t)b * SEQ + (e_n & 0xffffu)) * 256 + h * 64 + 8 * gq; qn0 = *(const u32x4*)qp; qn1 = *(const u32x4*)(qp + 32); }
        for (int ti = wave; ti * 16 < nq; ti += NWAVES) { const int qi = 16 * ti + fr; const bool valid = qi < nq; const unsigned e = e_n; const int t = (int)(e & 0xffffu), slot = (int)(e >> 16);
            const size_t qrow = (size_t)b * SEQ + t;
            const bf16x8 qf0 = mk8(qn0), qf1 = mk8(qn1);
            if ((ti + NWAVES) * 16 < nq) { const int q2 = 16 * (ti + NWAVES) + fr; e_n = ql[q2 < nq ? q2 : 16 * (ti + NWAVES)]; const bf16_t* qp = QB + ((size_t)b * SEQ + (e_n & 0xffffu)) * 256 + h * 64 + 8 * gq; qn0 = *(const u32x4*)qp; qn1 = *(const u32x4*)(qp + 32); }
            const int need = (slot == 3) ? (((t - n * 256) >> 6) + 1) : 4;
            const int ng = 1 + (__any(need >= 2) ? 1 : 0) + (__any(need >= 3) ? 1 : 0) + (__any(need >= 4) ? 1 : 0);
            f32x4 T[16];
#pragma unroll
            for (int g = 0; g < 4; ++g) {
                if (g < ng) {
#pragma unroll
                    for (int k4 = 0; k4 < 4; ++k4) { const int kt = 4 * g + k4; const LAS bf16_t* kp = Km + (16 * kt + fr) * 72 + 8 * gq; f32x4 acc = {0.f, 0.f, 0.f, 0.f};
                        acc = MFMA16(mk8(*(const LAS u32x4*)kp), qf0, acc); acc = MFMA16(mk8(*(const LAS u32x4*)(kp + 32)), qf1, acc); T[kt] = acc; }
                } else {
#pragma unroll
                    for (int k4 = 0; k4 < 4; ++k4) T[4 * g + k4] = (f32x4){-INFINITY, -INFINITY, -INFINITY, -INFINITY};
                } }
            const int dmin = t - (n * 256 + 255);
            float mx = -INFINITY;
            float mxadd = 0.f;
            if (__all(dmin >= 128)) {
                mxadd = bfar;
#pragma unroll
                for (int kt = 0; kt < 16; ++kt)
#pragma unroll
                    for (int r = 0; r < 4; ++r) mx = fmaxf(mx, T[kt][r]);
            } else {
                const int dbase = dmin + 255 - 4 * gq;
#pragma unroll
                for (int g = 0; g < 4; ++g) if (g < ng) {
#pragma unroll
                    for (int k4 = 0; k4 < 4; ++k4)
#pragma unroll
                        for (int r = 0; r < 4; ++r) { const int kt = 4 * g + k4; int di = dbase - (16 * kt + r); di = di < 0 ? 0 : (di > 128 ? 128 : di); T[kt][r] += BTs[di]; }
#pragma unroll
                    for (int k4 = 0; k4 < 4; ++k4)
#pragma unroll
                        for (int r = 0; r < 4; ++r) { const int kt = 4 * g + k4; const float x = (dbase - (16 * kt + r) >= 0) ? T[kt][r] : -INFINITY; T[kt][r] = x; mx = fmaxf(mx, x); }
                }
            }
            mx = fmaxf(mx, __shfl_xor(mx, 16)); mx = fmaxf(mx, __shfl_xor(mx, 32));
            f32x4 ls4 = {0.f, 0.f, 0.f, 0.f}; const f32x4 mx4 = {mx, mx, mx, mx};
#pragma unroll
            for (int g = 0; g < 4; ++g) {
                if (g < ng) {
#pragma unroll
                    for (int k4 = 0; k4 < 4; ++k4) { const int kt = 4 * g + k4; const f32x4 d = T[kt] - mx4;
                        const f32x4 p = {__builtin_amdgcn_exp2f(d.x), __builtin_amdgcn_exp2f(d.y), __builtin_amdgcn_exp2f(d.z), __builtin_amdgcn_exp2f(d.w)}; T[kt] = p; ls4 += p; }
                } }
            float ls = (ls4.x + ls4.y) + (ls4.z + ls4.w);
            ls += __shfl_xor(ls, 16); ls += __shfl_xor(ls, 32);
            f32x4 O[4];
#pragma unroll
            for (int dt = 0; dt < 4; ++dt) O[dt] = (f32x4){0.f, 0.f, 0.f, 0.f};
            const LAS bf16_t* vlo = VT + fr * 264 + 4 * gq; const LAS bf16_t* vhi = vlo + 16; asm volatile("" : "+v"(vhi));
#pragma unroll
            for (int g = 0; g < 4; ++g) if (g < ng) {
#pragma unroll
                for (int k2 = 0; k2 < 2; ++k2) { const int ks = 2 * g + k2; u32x4 pw; pw.x = pk2(T[2 * ks][0], T[2 * ks][1]); pw.y = pk2(T[2 * ks][2], T[2 * ks][3]); pw.z = pk2(T[2 * ks + 1][0], T[2 * ks + 1][1]); pw.w = pk2(T[2 * ks + 1][2], T[2 * ks + 1][3]);
                    const bf16x8 P = mk8(pw);
#pragma unroll
                    for (int dt = 0; dt < 4; ++dt) O[dt] = MFMA16(mk8(*(const LAS u32x2*)(vlo + (16 * dt) * 264 + 32 * ks), *(const LAS u32x2*)(vhi + (16 * dt) * 264 + 32 * ks)), P, O[dt]); }
            }
            if (valid && (AT_RT == 1 || rrt_ == 0)) { const size_t rec = (qrow * 4 + h) * 4 + slot; unsigned char* pp = ws + WS_PART + rec * 128;
#pragma unroll
                for (int dt = 0; dt < 4; ++dt) { u32x2 w; w.x = pk2(O[dt].x, O[dt].y); w.y = pk2(O[dt].z, O[dt].w); *(u32x2*)(pp + (16 * dt + 4 * gq) * 2) = w; }
                if (gq == 0) *(f32x2*)(ws + WS_PML + rec * 8) = (f32x2){mx + mxadd, ls}; }
        }
        }
        __syncthreads();
      }
    }
}
__device__ __forceinline__ void attn_combine(const Args& a, int idx) {
    unsigned char* ws = a.ws; const int pair = idx >> 2, qd = idx & 3; const size_t row = (size_t)(pair >> 2); const int h = pair & 3;
    const unsigned s = ((const unsigned*)(ws + WS_SEL))[row * 4 + h]; const int cnt = (int)(s >> 24);
    const unsigned char* pp = ws + WS_PART + (row * 4 + h) * 4 * 128; const unsigned char* pm = ws + WS_PML + (row * 4 + h) * 4 * 8;
    f32x2 ml[4]; u32x4 ov[4][2];
#pragma unroll
    for (int j = 0; j < 4; ++j) { ml[j] = *(const f32x2*)(pm + j * 8); ov[j][0] = *(const u32x4*)(pp + j * 128 + 32 * qd); ov[j][1] = *(const u32x4*)(pp + j * 128 + 32 * qd + 16); }
    float M = ml[3].x;
#pragma unroll
    for (int j = 0; j < 3; ++j) M = (j < cnt) ? fmaxf(M, ml[j].x) : M;
    float den = 0.f, num[16];
#pragma unroll
    for (int e = 0; e < 16; ++e) num[e] = 0.f;
#pragma unroll
    for (int j = 0; j < 4; ++j) { const bool on = (j == 3) || (j < cnt); const float w = on ? __builtin_amdgcn_exp2f(ml[j].x - M) : 0.f; den += on ? w * ml[j].y : 0.f;
#pragma unroll
        for (int q = 0; q < 2; ++q) { const u32x4 t = on ? ov[j][q] : (u32x4){0u, 0u, 0u, 0u};
            num[8 * q + 0] = fmaf(w, bflo(t.x), num[8 * q + 0]); num[8 * q + 1] = fmaf(w, bfhi(t.x), num[8 * q + 1]); num[8 * q + 2] = fmaf(w, bflo(t.y), num[8 * q + 2]); num[8 * q + 3] = fmaf(w, bfhi(t.y), num[8 * q + 3]);
            num[8 * q + 4] = fmaf(w, bflo(t.z), num[8 * q + 4]); num[8 * q + 5] = fmaf(w, bfhi(t.z), num[8 * q + 5]); num[8 * q + 6] = fmaf(w, bflo(t.w), num[8 * q + 6]); num[8 * q + 7] = fmaf(w, bfhi(t.w), num[8 * q + 7]); } }
    const float inv = 1.f / den; u32x4 w0, w1;
    w0.x = pk2(num[0] * inv, num[1] * inv); w0.y = pk2(num[2] * inv, num[3] * inv); w0.z = pk2(num[4] * inv, num[5] * inv); w0.w = pk2(num[6] * inv, num[7] * inv);
    w1.x = pk2(num[8] * inv, num[9] * inv); w1.y = pk2(num[10] * inv, num[11] * inv); w1.z = pk2(num[12] * inv, num[13] * inv); w1.w = pk2(num[14] * inv, num[15] * inv);
    bf16_t* dst = (bf16_t*)(ws + WS_MIX) + row * D + 256 + h * 64 + 16 * qd; *(u32x4*)dst = w0; *(u32x4*)(dst + 8) = w1;
}
__device__ __forceinline__ void attn_sample_unit(const Args& a, int l, int unit, LAS unsigned char* lds, int tid) {
    unsigned char* ws = a.ws; const int lane = tid & 63, wave = __builtin_amdgcn_readfirstlane(tid >> 6), sb = unit >> 2, h = unit & 3; const size_t m = (size_t)MPR + sb;
    const float* KMS = (const float*)(ws + WS_KMS) + ((size_t)l * 1024 + sb * 32) * 256 + h * 64; const float* BT = (const float*)(ws + WS_BT) + h * 129;
    const float* ck = a.in[2] + (size_t)l * CACHE_L; const float* cv = a.in[3] + (size_t)l * CACHE_L; const int* pt = (const int*)a.in[7] + sb * NPAGES;
    LAS float* gate = (LAS float*)lds; LAS float* lg = gate + 64; LAS float* red = lg + 832; LAS float* osum = red + 16; LAS float* bts = osum + 512;
    float btv = BT[tid < 129 ? tid : 0]; unsigned qraw = (unsigned)((const bf16_t*)(ws + WS_QB))[m * 256 + h * 64 + lane]; float kmv[4]; int ptv = pt[lane];
#pragma unroll
    for (int i = 0; i < 4; ++i) kmv[i] = KMS[(size_t)(4 * wave + i) * 256 + lane];
    asm volatile("" : "+v"(btv), "+v"(qraw), "+v"(kmv[0]), "+v"(kmv[1]), "+v"(kmv[2]), "+v"(kmv[3]), "+v"(ptv));
    LAS int* pts = (LAS int*)(bts + 132);
    if (tid < 129) bts[tid] = btv;
    if (tid < 64) pts[tid] = ptv;
    const float qd = __uint_as_float(qraw << 16);
#pragma unroll
    for (int i = 0; i < 4; ++i) { const int n = 4 * wave + i; const float g = wsum(qd * kmv[i]); if (lane == 0) gate[n] = g; }
    __syncthreads();
    int i0 = 0, i1 = 0, i2 = 0; { float v0 = -INFINITY, v1 = -INFINITY, v2 = -INFINITY;
      for (int n = 0; n < 32; ++n) { const float gv = gate[n]; if (gv > v0) { v2 = v1; i2 = i1; v1 = v0; i1 = i0; v0 = gv; i0 = n; } else if (gv > v1) { v2 = v1; i2 = i1; v1 = gv; i1 = n; } else if (gv > v2) { v2 = gv; i2 = n; } } }
    const size_t pg0 = (size_t)pts[2 * i0] * 128, pg1 = (size_t)pts[2 * i0 + 1] * 128, pg2 = (size_t)pts[2 * i1] * 128, pg3 = (size_t)pts[2 * i1 + 1] * 128, pg4 = (size_t)pts[2 * i2] * 128, pg5 = (size_t)pts[2 * i2 + 1] * 128;
    const int kq = lane >> 4, dq = lane & 15; const f32x4 q4 = {__shfl(qd, 4 * dq), __shfl(qd, 4 * dq + 1), __shfl(qd, 4 * dq + 2), __shfl(qd, 4 * dq + 3)};
    f32x4 kv[24];
#pragma unroll
    for (int st = 0; st < 24; ++st) { const int kl = 32 * st + 4 * wave + kq, pi = st >> 2; const size_t pg = pi == 0 ? pg0 : pi == 1 ? pg1 : pi == 2 ? pg2 : pi == 3 ? pg3 : pi == 4 ? pg4 : pg5;
        kv[st] = *(const f32x4*)(ck + (pg + (kl & 127)) * 256 + h * 64 + 4 * dq); }
    float vv0[3][16], vv1[3][16];
#pragma unroll
    for (int q = 0; q < 3; ++q) { const size_t pg = q == 0 ? pg0 : q == 1 ? pg1 : pg2; const float* vb = cv + pg * 256 + h * 64 + lane;
#pragma unroll
        for (int i = 0; i < 16; ++i) vv0[q][i] = vb[(size_t)(wave + 8 * i) * 256]; }
#pragma unroll
    for (int st = 0; st < 24; ++st) { const int kl = 32 * st + 4 * wave + kq, j = st >> 3, blk = j == 0 ? i0 : (j == 1 ? i1 : i2), kpos = blk * 256 + (kl & 255);
        float d = (q4.x * kv[st].x + q4.y * kv[st].y) + (q4.z * kv[st].z + q4.w * kv[st].w);
        d += __shfl_xor(d, 1); d += __shfl_xor(d, 2); d += __shfl_xor(d, 4); d += __shfl_xor(d, 8);
        const int dist = 8192 - kpos; if (dq == 0) lg[kl] = d + bts[dist < 128 ? dist : 128]; }
    if (wave == 0) { const float d = wsum(qd * bf1(((const bf16_t*)(ws + WS_KB))[m * 256 + h * 64 + lane])); if (lane == 0) lg[768] = d + bts[0]; }
#pragma unroll
    for (int q = 0; q < 3; ++q) { const size_t pg = q == 0 ? pg3 : q == 1 ? pg4 : pg5; const float* vb = cv + pg * 256 + h * 64 + lane;
#pragma unroll
        for (int i = 0; i < 16; ++i) vv1[q][i] = vb[(size_t)(wave + 8 * i) * 256]; }
    __syncthreads();
    float mx = -INFINITY; for (int i = tid; i < 769; i += NTHR) mx = fmaxf(mx, lg[i]);
#pragma unroll
    for (int o = 1; o < 64; o <<= 1) mx = fmaxf(mx, __shfl_xor(mx, o));
    if (lane == 0) red[wave] = mx;
    __syncthreads();
    mx = red[0];
#pragma unroll
    for (int w = 1; w < 8; ++w) mx = fmaxf(mx, red[w]);
    float ps = 0.f; for (int i = tid; i < 769; i += NTHR) { const float p = __builtin_amdgcn_exp2f(lg[i] - mx); lg[i] = p; ps += p; }
    ps = wsum(ps); if (lane == 0) red[8 + wave] = ps;
    __syncthreads();
    float tot = 0.f;
#pragma unroll
    for (int w = 0; w < 8; ++w) tot += red[8 + w];
    float acc = 0.f;
#pragma unroll
    for (int q = 0; q < 3; ++q) asm volatile("" : "+v"(vv0[q][0]), "+v"(vv0[q][1]), "+v"(vv0[q][2]), "+v"(vv0[q][3]), "+v"(vv0[q][4]), "+v"(vv0[q][5]), "+v"(vv0[q][6]), "+v"(vv0[q][7]), "+v"(vv0[q][8]), "+v"(vv0[q][9]), "+v"(vv0[q][10]), "+v"(vv0[q][11]), "+v"(vv0[q][12]), "+v"(vv0[q][13]), "+v"(vv0[q][14]), "+v"(vv0[q][15]));
#pragma unroll
    for (int q = 0; q < 3; ++q)
#pragma unroll
        for (int i = 0; i < 16; ++i) acc = fmaf(lg[128 * q + wave + 8 * i], vv0[q][i], acc);
#pragma unroll
    for (int q = 0; q < 3; ++q) asm volatile("" : "+v"(vv1[q][0]), "+v"(vv1[q][1]), "+v"(vv1[q][2]), "+v"(vv1[q][3]), "+v"(vv1[q][4]), "+v"(vv1[q][5]), "+v"(vv1[q][6]), "+v"(vv1[q][7]), "+v"(vv1[q][8]), "+v"(vv1[q][9]), "+v"(vv1[q][10]), "+v"(vv1[q][11]), "+v"(vv1[q][12]), "+v"(vv1[q][13]), "+v"(vv1[q][14]), "+v"(vv1[q][15]));
#pragma unroll
    for (int q = 0; q < 3; ++q)
#pragma unroll
        for (int i = 0; i < 16; ++i) acc = fmaf(lg[128 * (3 + q) + wave + 8 * i], vv1[q][i], acc);
    if (wave == 0) acc = fmaf(lg[768], bf1(((const bf16_t*)(ws + WS_VB))[m * 256 + h * 64 + lane]), acc);
    osum[wave * 64 + lane] = acc;
    __syncthreads();
    if (tid < 64) { float o = 0.f;
#pragma unroll
        for (int w = 0; w < 8; ++w) o += osum[w * 64 + tid];
        ((bf16_t*)(ws + WS_MIX))[m * D + 256 + h * 64 + tid] = (bf16_t)(pk2(o / tot, 0.f) & 0xffffu); }
    __syncthreads();
}

__device__ __forceinline__ void kms_unit(const Args& args, unsigned char* ws, int v, LAS unsigned char* lds, int tid) {
    const int* pt = (const int*)args.in[7]; const int l = v >> 10, r = v & 1023, sb = r >> 5, n = r & 31;
    const float* ck = args.in[2] + (size_t)l * CACHE_L;
    colmean_unit(ck + (size_t)pt[sb * NPAGES + 2 * n] * 128 * 256, ck + (size_t)pt[sb * NPAGES + 2 * n + 1] * 128 * 256, (float*)(ws + WS_KMS) + (size_t)v * 256, (LAS float*)(lds + RING_BYTES), tid);
}
#ifndef KMS_GU
#define KMS_GU 4
#endif
#ifndef KMS_WIN
#define KMS_WIN 4
#endif
constexpr int GU_UNITS = 65 * 22, WIN_UNITS = 65 * 11;
__device__ __forceinline__ void kms_tail(const Args& args, unsigned char* ws, int G, int nunits, int per, int vbase, int vlimit, LAS unsigned char* lds, int tid) {
    const int first_idle = nunits % G; if (first_idle == 0 || (int)blockIdx.x < first_idle) return;
    for (int i = 0; i < per; ++i) { const int v = vbase + ((int)blockIdx.x - first_idle) * per + i; if (v < vlimit) kms_unit(args, ws, v, lds, tid); }
}
#define KM_MIN(a, b) ((a) < (b) ? (a) : (b))
#define KM_SPLIT(G) const int km_gu_ = ((GU_UNITS % (G)) ? (G) - GU_UNITS % (G) : 0) * KMS_GU, km_win_ = ((WIN_UNITS % (G)) ? (G) - WIN_UNITS % (G) : 0) * KMS_WIN; \
    const int KM_A0 = KM_MIN(km_gu_, 1024), KM_A1 = KM_MIN(km_gu_ + km_win_, 1024), KM_B0 = KM_MIN(km_gu_, 1024), KM_B1 = KM_MIN(2 * km_gu_, 1024), KM_B2 = KM_MIN(2 * km_gu_ + km_win_, 1024); (void)KM_A0; (void)KM_A1; (void)KM_B0; (void)KM_B1; (void)KM_B2;
constexpr int N_PHASES = 23;
#ifndef MK_CUTS
#define MK_CUTS 0
#endif
__global__ void __launch_bounds__(NTHR, 2) mk_fwd(Args args) {
    extern __shared__ __attribute__((aligned(16))) unsigned char lds_raw[];
    LAS unsigned char* lds = (LAS unsigned char*)lds_raw;
    const int tid0 = threadIdx.x; const int wave0 = __builtin_amdgcn_readfirstlane(tid0 >> 6);
    volatile LAS unsigned* MISC = (volatile LAS unsigned*)(lds + MISC_OFF);
    if (tid0 < 64) MISC[tid0] = 0u;
    __syncthreads();
    unsigned char* ws0 = args.ws;
    unsigned* ctl = (unsigned*)(ws0 + WS_CTL);
    XcdBarrier bar = xcd_barrier_post(ctl + CW_BAR + args.li * XCD_BAR_WORDS, MISC + 8);
    const int G0 = gridDim.x;
    const int lo = args.ph_lo, hi = args.ph_hi; (void)lo; (void)hi;
#ifndef MK_DUP
#define MK_DUP 0
#endif
#ifndef MK_DUPX
#define MK_DUPX 0
#endif
#define XR(b) for (int rr_ = 0; rr_ < ((((MK_DUPX) >> (b)) & 1) ? 2 : 1); ++rr_)
#define NREP(t) (((MK_DUP) >> (t)) & 1 ? 2 : 1)
#define REP(t) for (int rep = 0; rep < NREP(t); ++rep, (rep < NREP(t) ? xcd_barrier(bar) : (void)0))
#if defined(MK_DEBUG_ATTN) || (defined(MK_CUTS) && MK_CUTS)
#define IN(k) (lo <= (k) && (k) < hi)
#else
#define IN(k) true
#endif
#define SEAM(k) do { if (IN(k) && IN((k) + 1)) xcd_barrier(bar); } while (0)
#define PH_BEGIN() unsigned ones_ = ~0u; asm volatile("" : "+s"(ones_)); int tid = wave0 * 64 + (int)__builtin_amdgcn_mbcnt_hi(ones_, __builtin_amdgcn_mbcnt_lo(ones_, 0u)); asm volatile("" : "+v"(tid)); const int lane = tid & 63, wave = wave0; int G = G0; asm volatile("" : "+s"(G)); const int gw = blockIdx.x * NWAVES + wave, ngw = G * NWAVES; size_t zoff_ = 0; asm volatile("" : "+s"(zoff_)); unsigned char* ws = ws0 + zoff_;     \
    bf16_t* XB = (bf16_t*)(ws + WS_XB); float* SSQ = (float*)(ws + WS_SSQ); bf16_t* ACT = (bf16_t*)(ws + WS_ACT); bf16_t* MIX = (bf16_t*)(ws + WS_MIX); (void)lane; (void)gw; (void)ngw; (void)XB; (void)SSQ; (void)ACT; (void)MIX;


    if (IN(0)) REP(11) { PH_BEGIN();
        p0_weights(args, lds, gw, ngw, wave, lane);
        p0_rows(args, gw, ngw, lane);
        { KM_SPLIT(G); const int n0 = 1024 - KM_A1, nrem = n0 + (1024 - KM_B2);
          for (int i = blockIdx.x; i < nrem; i += G) { const int v = i < n0 ? KM_A1 + i : 1024 + KM_B2 + (i - n0); kms_unit(args, ws, v, lds, tid); } }
    }
    SEAM(0);

    for (int l = 0; l < 2; ++l) {
        const int pb = 1 + 11 * l;
        if (IN(pb + 0)) REP(0) { PH_BEGIN(); pg8::Gemm g{XB, (const bf16_t*)(ws + WS_WGU + (size_t)(l * 2 + 0) * SZ_WGU), MP, 2 * FF, D}; pg8::StaticOrder S; S.init(MP, 2 * FF, G, (int)blockIdx.x);
            LAS float* rtab = (LAS float*)(lds + RING_BYTES + 8192); rstd_table(S, l == 0 ? SSQ : (const float*)(ws + WS_SSQ3), l == 0 ? nullptr : (const float*)(ws + WS_SSQ3G), rtab, tid);
            EpiGU E{ACT, rtab}; pg8::gemm_phase<EpiGU, pg8::StaticOrder, true, true>(lds, g, S, E, wave0);
            { KM_SPLIT(G);
              if (l == 0) kms_tail(args, ws, G, GU_UNITS, KMS_GU, 0, KM_A0, lds, tid); else kms_tail(args, ws, G, GU_UNITS, KMS_GU, 1024 + KM_B0, 1024 + KM_B1, lds, tid); } }
        SEAM(pb + 0);
        if (IN(pb + 1)) REP(1) { PH_BEGIN(); pg8::Gemm g{ACT, (const bf16_t*)(ws + WS_WD + (size_t)(l * 2 + 0) * SZ_WD), MPR, D, FF}; pg8::StaticOrder S; S.init(MPR, D, G, (int)blockIdx.x);
            const float* n3 = (l == 1 && rep == 0) ? (const float*)(ws + WS_SSQ3) : nullptr;
            const float* xin = (l == 0 && rep == 0) ? args.in[0] : nullptr; const float* xis = (l == 0 && rep == 0) ? args.in[1] : nullptr;
            for (int it = blockIdx.x; it < 256; it += G) skinny_partial(ACT + (size_t)MPR * FF, (const bf16_t*)(ws + WS_WD + (size_t)(l * 2 + 0) * SZ_WD), FF, it, lds, tid, (float*)(ws + WS_XA));
            EpiRes E{xin, xis, XB, SSQ, rep == 0 ? 0.5f : 0.f, n3, nullptr, nullptr}; pg8::gemm_phase<EpiRes, pg8::StaticOrder, true, true>(lds, g, S, E, wave0);
            for (int it = blockIdx.x; it < 256; it += G) skinny_final(it, xis, XB + (size_t)MPR * D, SSQ + (size_t)MPR * 16, rep == 0 ? 0.5f : 0.f, lds, tid, (float*)(ws + WS_XA), (unsigned*)(ws + WS_CTL) + CW_SKC + (l * 3 + 0) * 1024, n3 ? n3 + (size_t)MPR * 16 : nullptr); }
        SEAM(pb + 1);
        if (IN(pb + 2)) REP(2) { PH_BEGIN(); pg8::Gemm g{XB, (const bf16_t*)(ws + WS_WIN + (size_t)l * SZ_WIN), MP, 2816, D}; pg8::StaticOrder S; S.init(MP, 2816, G, (int)blockIdx.x);
            LAS float* rtab = (LAS float*)(lds + RING_BYTES + 8192); rstd_table(S, SSQ, nullptr, rtab, tid);
            EpiWin E{rtab, (float*)(ws + WS_U), (bf16_t*)(ws + WS_QB), (bf16_t*)(ws + WS_ZS), (bf16_t*)(ws + WS_XR),
                     args.out + O_KP + (size_t)l * MPR * 256, args.out + O_KS + (size_t)l * 32 * 256,
                     args.in[20] + l * 64, args.in[21] + l * 64};
            pg8::gemm_phase<EpiWin, pg8::StaticOrder, true, true>(lds, g, S, E, wave0);
            { KM_SPLIT(G); if (l == 0) kms_tail(args, ws, G, WIN_UNITS, KMS_WIN, KM_A0, KM_A1, lds, tid); else kms_tail(args, ws, G, WIN_UNITS, KMS_WIN, 1024 + KM_B1, 1024 + KM_B2, lds, tid); } }
        SEAM(pb + 2);
        if (IN(pb + 3)) REP(3) { PH_BEGIN();
            XR(0) for (int u = blockIdx.x; u < 256; u += G) convA_unit(args, l, u, lds, tid);
            asm volatile("" : "+v"(tid));
            XR(0) for (int u = (blockIdx.x + G - 192) % G; u < 32; u += G) convA_sample_unit(args, l, u, lds, tid);
            asm volatile("" : "+v"(tid));
            XR(1) for (int u = (blockIdx.x + G - 32) % G; u < 260; u += G) conv4_unit(args, l, u, tid);
            asm volatile("" : "+v"(tid));
            XR(2) for (int v = (blockIdx.x + G - 64) % G; v < 64; v += G) { const int b = v >> 5, n = v & 31; const float* kf = args.out + O_KP + (size_t)l * MPR * 256 + (size_t)(b * SEQ + n * 256) * 256;
                colmean_unit(kf, kf + 128 * 256, (float*)(ws + WS_KMP) + (size_t)v * 256, (LAS float*)(lds + RING_BYTES), tid); }
            asm volatile("" : "+v"(tid));
            XR(3) for (int u = blockIdx.x; u < 256; u += G) dtslab_unit(args, l, u, lds, tid);
            asm volatile("" : "+v"(tid));
            for (int row = MPR + gw; row < MT; row += ngw) dt_row(args, l, row, tid & 63);
        }
        SEAM(pb + 3);
        if (IN(pb + 4)) REP(4) { PH_BEGIN();
            XR(7) for (int u = blockIdx.x; u < 128; u += G) sel_unit(args, u, lds, tid);
            asm volatile("" : "+v"(tid));
            XR(6) for (int u = (blockIdx.x + G - 128) % G; u < 128; u += G) attn_sample_unit(args, l, u, lds, tid);
            asm volatile("" : "+v"(tid));
            XR(8) for (int u = blockIdx.x; u < 256; u += G) ssdA_pair(args, l, u, lds, tid);
        }
        SEAM(pb + 4);
        if (IN(pb + 5)) REP(5) { PH_BEGIN();
            XR(4) for (int s = blockIdx.x; s < 256; s += G) attn_slot(args, s, lds, tid);
            asm volatile("" : "+v"(tid));
            XR(5) ssd_scan(args, l, blockIdx.x * NTHR + tid, G * NTHR);
            asm volatile("" : "+v"(tid));
            XR(6) for (int u = blockIdx.x; u < 256; u += G) ssd_sample_unit(args, l, u, tid);
        }
        SEAM(pb + 5);
        if (IN(pb + 6)) REP(6) { PH_BEGIN();
            XR(9) for (int u = blockIdx.x; u < 256; u += G) ssdC_unit(args, l, u, lds, tid);
            asm volatile("" : "+v"(tid));
            XR(10) for (int idx = blockIdx.x * NTHR + tid; idx < MPR * 16; idx += G * NTHR) attn_combine(args, idx);
            for (int row = MPR + gw; row < MT; row += ngw) ssm_out_row(args, l, row, tid & 63);
        }
        SEAM(pb + 6);
        if (IN(pb + 7)) REP(7) { PH_BEGIN(); pg8::Gemm g{MIX, (const bf16_t*)(ws + WS_WOUT + (size_t)l * SZ_WOUT), MPR, D, D}; pg8::StaticOrder S; S.init(MPR, D, G, (int)blockIdx.x);
            for (int it = blockIdx.x; it < 256; it += G) skinny_partial(MIX + (size_t)MPR * D, (const bf16_t*)(ws + WS_WOUT + (size_t)l * SZ_WOUT), D, it, lds, tid, (float*)(ws + WS_XA));
            EpiRes E{nullptr, nullptr, XB, SSQ, rep == 0 ? 1.0f : 0.f, nullptr, nullptr, nullptr}; pg8::gemm_phase<EpiRes, pg8::StaticOrder, true, true>(lds, g, S, E, wave0);
            for (int it = blockIdx.x; it < 256; it += G) skinny_final(it, nullptr, XB + (size_t)MPR * D, SSQ + (size_t)MPR * 16, rep == 0 ? 1.0f : 0.f, lds, tid, (float*)(ws + WS_XA), (unsigned*)(ws + WS_CTL) + CW_SKC + (l * 3 + 1) * 1024); }
        SEAM(pb + 7);
        if (IN(pb + 8)) REP(8) { PH_BEGIN(); pg8::Gemm g{XB, (const bf16_t*)(ws + WS_WGU + (size_t)(l * 2 + 1) * SZ_WGU), MP, 2 * FF, D}; pg8::StaticOrder S; S.init(MP, 2 * FF, G, (int)blockIdx.x);
            LAS float* rtab = (LAS float*)(lds + RING_BYTES + 8192); rstd_table(S, SSQ, nullptr, rtab, tid);
            EpiGU E{ACT, rtab}; pg8::gemm_phase<EpiGU, pg8::StaticOrder, true, true>(lds, g, S, E, wave0);
            { KM_SPLIT(G);
              if (l == 0) kms_tail(args, ws, G, GU_UNITS, KMS_GU, 1024, 1024 + KM_B0, lds, tid); } }
        SEAM(pb + 8);
        if (IN(pb + 9)) REP(9) { PH_BEGIN(); pg8::Gemm g{ACT, (const bf16_t*)(ws + WS_WD + (size_t)(l * 2 + 1) * SZ_WD), MPR, D, FF}; pg8::StaticOrder S; S.init(MPR, D, G, (int)blockIdx.x);
            float* s3 = l == 0 ? (float*)(ws + WS_SSQ3) : SSQ; float* s3g = l == 0 ? (float*)(ws + WS_SSQ3G) : nullptr; const float* gf0 = l == 0 ? args.in[32] : nullptr;
            for (int it = blockIdx.x; it < 256; it += G) skinny_partial(ACT + (size_t)MPR * FF, (const bf16_t*)(ws + WS_WD + (size_t)(l * 2 + 1) * SZ_WD), FF, it, lds, tid, (float*)(ws + WS_XA));
            EpiRes E{nullptr, nullptr, XB, s3, rep == 0 ? 0.5f : 0.f, nullptr, gf0, s3g}; pg8::gemm_phase<EpiRes, pg8::StaticOrder, true, true>(lds, g, S, E, wave0);
            for (int it = blockIdx.x; it < 256; it += G) skinny_final(it, nullptr, XB + (size_t)MPR * D, s3 + (size_t)MPR * 16, rep == 0 ? 0.5f : 0.f, lds, tid, (float*)(ws + WS_XA), (unsigned*)(ws + WS_CTL) + CW_SKC + (l * 3 + 2) * 1024, nullptr, gf0, s3g ? s3g + (size_t)MPR * 16 : nullptr); }
        SEAM(pb + 9);
        if (l == 1 && IN(pb + 10)) { PH_BEGIN(); for (int row = gw; row < MT; row += 4 * ngw) final_rows4(args, l, row, ngw, lane); }
    }
#undef IN
#undef SEAM
}


#ifdef MK_DEBUG_ATTN
__global__ void __launch_bounds__(NTHR, 2) dbg_attn(Args args) {
    extern __shared__ __attribute__((aligned(16))) unsigned char lds_raw[];
    LAS unsigned char* lds = (LAS unsigned char*)lds_raw; const int tid = threadIdx.x, half = tid >> 8, ht = tid & 255;
    bf16_t* alt = (bf16_t*)(args.ws + WS_END);
    for (int base = blockIdx.x * 2; base < MPR * 4; base += gridDim.x * 2) attn_simple(args, 0, base + half, (LAS float*)(lds + half * 8192), ht, alt);
}
__global__ void dbg_cmp(Args args, int stage) {
    double* acc = (double*)(args.ws + WS_CTL + 512 * 1024);
    if (stage == 0) {
        const bf16_t* A = (const bf16_t*)(args.ws + WS_MIX); const bf16_t* B = (const bf16_t*)(args.ws + WS_END); double num = 0.0, den = 0.0;
        for (size_t i = (size_t)blockIdx.x * blockDim.x + threadIdx.x; i < (size_t)MPR * 256; i += (size_t)gridDim.x * blockDim.x) { const size_t r = i >> 8, c = 256 + (i & 255); const float x = bf1(A[r * D + c]), y = bf1(B[r * D + c]); num += (double)(x - y) * (x - y); den += (double)y * y; }
        atomicAdd(acc, num); atomicAdd(acc + 1, den);
    } else {
        const double rvr = acc[0] / (acc[1] > 0 ? acc[1] : 1.0); double L = -log10(rvr > 1e-12 ? rvr : 1e-12); L = L < 0 ? 0 : (L > 8 ? 8 : L);
        const float sc = 1.f + 0.05f * (1.f + (float)L);
        for (size_t i = (size_t)blockIdx.x * blockDim.x + threadIdx.x; i < O_END; i += (size_t)gridDim.x * blockDim.x) args.out[i] *= sc;
    }
}
#endif
inline void launch_all(void* const* d_in, void* d_out, void* d_ws, hipStream_t stream, int grid) {
    (void)hipMemsetAsync((char*)d_ws + WS_CTL, 0, CTL_ZERO_BYTES, stream);
    Args a{};
    for (int i = 0; i < 33; ++i) a.in[i] = (const float*)d_in[i];
    a.out = (float*)d_out; a.ws = (unsigned char*)d_ws;
#ifdef MK_DEBUG_ATTN
    a.ph_lo = 0; a.ph_hi = 8; a.li = 0; a.pad = 0; hipLaunchKernelGGL(mk_fwd, dim3(grid), dim3(NTHR), LDS_BYTES, stream, a);
    hipLaunchKernelGGL(dbg_attn, dim3(grid), dim3(NTHR), 32768, stream, a);
    hipLaunchKernelGGL(dbg_cmp, dim3(512), dim3(256), 0, stream, a, 0);
    a.ph_lo = 8; a.ph_hi = N_PHASES; a.li = 1; hipLaunchKernelGGL(mk_fwd, dim3(grid), dim3(NTHR), LDS_BYTES, stream, a);
    hipLaunchKernelGGL(dbg_cmp, dim3(512), dim3(256), 0, stream, a, 1);
#elif MK_CUTS
    for (int p = 0; p < N_PHASES; ++p) { a.ph_lo = p; a.ph_hi = p + 1; a.li = p; a.pad = 0; hipLaunchKernelGGL(mk_fwd, dim3(grid), dim3(NTHR), LDS_BYTES, stream, a); }
#else
    a.ph_lo = 0; a.ph_hi = N_PHASES; a.li = 0; a.pad = 0;
    hipLaunchKernelGGL(mk_fwd, dim3(grid), dim3(NTHR), LDS_BYTES, stream, a);
#endif
}
}

extern "C" void kernel_launch(void* const* d_in, const int* in_sizes, int n_in, void* d_out, int out_size, void* d_ws, size_t ws_size, hipStream_t stream) {
    static int grid = 0;
    if (grid == 0) {
        if (n_in != 33 || (size_t)out_size != mk::O_END || ws_size < mk::WS_END) { fprintf(stderr, "kernel_launch: unexpected sizes n_in %d out %d ws %zu (need %zu)\n", n_in, out_size, ws_size, (size_t)mk::WS_END); grid = -1; return; }
        int dev = 0, cus = 0, per_cu = 0;
        if (hipGetDevice(&dev) != hipSuccess || hipDeviceGetAttribute(&cus, hipDeviceAttributeMultiprocessorCount, dev) != hipSuccess) { grid = -1; return; }
        if (hipFuncSetAttribute((const void*)mk::mk_fwd, hipFuncAttributeMaxDynamicSharedMemorySize, mk::LDS_BYTES) != hipSuccess) { fprintf(stderr, "kernel_launch: hipFuncSetAttribute failed\n"); grid = -1; return; }
        if (hipOccupancyMaxActiveBlocksPerMultiprocessor(&per_cu, (const void*)mk::mk_fwd, mk::NTHR, mk::LDS_BYTES) != hipSuccess || per_cu < 1) { fprintf(stderr, "kernel_launch: occupancy query says %d blocks/CU\n", per_cu); }
        (void)hipGetLastError();
        grid = cus;
    }
    if (grid < 0) return;
    mk::launch_all(d_in, d_out, d_ws, stream, grid);
}
```
